# Optimizing an MI355X kernel written in HIP

```python
import jax, jax.numpy as jnp
from jax import lax
import numpy as np

D_MODEL = 1024
BATCH = 2
SEQ = 8192
DEPTH = 1

HEAD_DIM = 64
N_Q_HEADS = D_MODEL // HEAD_DIM
N_KV_HEADS = N_Q_HEADS // 4
Q_PER_KV = N_Q_HEADS // N_KV_HEADS
ATTN_WIDTH = N_Q_HEADS * HEAD_DIM
KV_WIDTH = N_KV_HEADS * HEAD_DIM
WINDOW = 128
ATTN_BLOCK = 128
ROPE_THETA = 10000.0

CONV_WIDTH = D_MODEL
CONV_KERNEL = 3

N_BRANCH = 2
IN_WIDTH = ATTN_WIDTH + 2 * KV_WIDTH + 3 * CONV_WIDTH + N_BRANCH * D_MODEL

N_EXPERTS = 32
TOP_K = 4
D_FF = D_MODEL
SWIGLU_LIMIT = 7.0
SWIGLU_ALPHA = 1.702
MOE_BLOCK = 128

RMS_EPS = 1e-5

kernel_name = "hybrid_swa_shortconv_moe_block"


def rms_norm(x, g):
    xf = x.astype(jnp.float32)
    y = xf * lax.rsqrt(jnp.mean(xf * xf, axis=-1, keepdims=True) + RMS_EPS)
    return (y * g.astype(jnp.float32)).astype(x.dtype)


def split_points():
    widths = [ATTN_WIDTH, KV_WIDTH, KV_WIDTH, CONV_WIDTH, CONV_WIDTH, CONV_WIDTH, D_MODEL]
    pts, acc = [], 0
    for w in widths:
        acc += w
        pts.append(acc)
    return pts


def apply_rope(t, positions):
    half = HEAD_DIM // 2
    inv_freq = ROPE_THETA ** (-jnp.arange(half, dtype=jnp.float32) / half)
    ang = positions.astype(jnp.float32)[:, None] * inv_freq[None, :]
    cos = jnp.cos(ang)[None, :, None, :]
    sin = jnp.sin(ang)[None, :, None, :]
    t1 = t[..., :half].astype(jnp.float32)
    t2 = t[..., half:].astype(jnp.float32)
    out = jnp.concatenate([t1 * cos - t2 * sin, t2 * cos + t1 * sin], axis=-1)
    return out.astype(t.dtype)


def sliding_window_attention(q, k, v, sinks):
    B, S = q.shape[0], q.shape[1]
    nb = S // ATTN_BLOCK
    qb = q.reshape(B, nb, ATTN_BLOCK, N_KV_HEADS, Q_PER_KV, HEAD_DIM)

    def band(t):
        tp = jnp.pad(t, ((0, 0), (ATTN_BLOCK, 0), (0, 0), (0, 0)))
        tp = tp.reshape(B, nb + 1, ATTN_BLOCK, N_KV_HEADS, HEAD_DIM)
        return jnp.concatenate([tp[:, :-1], tp[:, 1:]], axis=2)

    kb, vb = band(k), band(v)
    scores = jnp.einsum('bnqkgd,bnskd->bnkgqs', qb, kb,
                        preferred_element_type=jnp.float32) * (HEAD_DIM ** -0.5)
    qi = jnp.arange(ATTN_BLOCK)[:, None]
    sj = jnp.arange(2 * ATTN_BLOCK)[None, :]
    dist = qi + ATTN_BLOCK - sj
    key_pos = jnp.arange(nb)[:, None, None] * ATTN_BLOCK - ATTN_BLOCK + sj[None]
    mask = (dist >= 0) & (dist < WINDOW) & (key_pos >= 0)
    scores = jnp.where(mask[None, :, None, None], scores, -jnp.inf)
    sink = sinks.astype(jnp.float32).reshape(N_KV_HEADS, Q_PER_KV)[None, None, :, :, None]
    m = jnp.maximum(scores.max(axis=-1), sink)
    p = jnp.exp(scores - m[..., None])
    denom = p.sum(axis=-1) + jnp.exp(sink - m)
    probs = (p / denom[..., None]).astype(v.dtype)
    out = jnp.einsum('bnkgqs,bnskd->bnqkgd', probs, vb)
    return out.reshape(B, S, ATTN_WIDTH)


def causal_short_conv(u, w):
    S = u.shape[1]
    up = jnp.pad(u, ((0, 0), (CONV_KERNEL - 1, 0), (0, 0)))
    y = w[0] * up[:, 0:S]
    for j in range(1, CONV_KERNEL):
        y = y + w[j] * up[:, j:j + S]
    return y


def moe_ffn(h, w_router, b_router, w_gate, b_gate, w_up, b_up, w_down, b_down):
    B, S, D = h.shape
    T = B * S
    xt = h.reshape(T, D)
    logits = (xt @ w_router).astype(jnp.float32) + b_router.astype(jnp.float32)
    top_logit, top_idx = lax.top_k(logits, TOP_K)
    top_w = jax.nn.softmax(top_logit, axis=-1).astype(h.dtype)
    A = T * TOP_K
    flat_e = top_idx.reshape(A)
    flat_tok = jnp.repeat(jnp.arange(T, dtype=jnp.int32), TOP_K)
    flat_w = top_w.reshape(A)
    order = jnp.argsort(flat_e)
    se, stok, sw = flat_e[order], flat_tok[order], flat_w[order]
    counts = jnp.bincount(flat_e, length=N_EXPERTS)
    padded = (counts + MOE_BLOCK - 1) // MOE_BLOCK * MOE_BLOCK
    start = jnp.cumsum(counts) - counts
    pad_end = jnp.cumsum(padded)
    pad_start = pad_end - padded
    dest = pad_start[se] + jnp.arange(A) - start[se]
    n_blocks = (A + MOE_BLOCK - 1) // MOE_BLOCK + N_EXPERTS
    P = n_blocks * MOE_BLOCK
    buf_tok = jnp.full((P,), T, jnp.int32).at[dest].set(stok)
    buf_w = jnp.zeros((P,), h.dtype).at[dest].set(sw)
    blk_e = jnp.minimum(
        jnp.searchsorted(pad_end, jnp.arange(n_blocks) * MOE_BLOCK, side='right'),
        N_EXPERTS - 1)
    x_pad = jnp.concatenate([xt, jnp.zeros((1, D), xt.dtype)], axis=0)
    xb = x_pad[buf_tok].reshape(n_blocks, MOE_BLOCK, D)

    def expert_block(args):
        xblk, e = args
        g = xblk @ w_gate[e] + b_gate[e]
        u = xblk @ w_up[e] + b_up[e]
        g = jnp.minimum(g, SWIGLU_LIMIT)
        u = jnp.clip(u, -SWIGLU_LIMIT, SWIGLU_LIMIT)
        a = g * jax.nn.sigmoid(SWIGLU_ALPHA * g) * (u + 1.0)
        return a @ w_down[e] + b_down[e]

    yb = lax.map(expert_block, (xb, blk_e))
    y = jnp.zeros((T + 1, D), h.dtype).at[buf_tok].add(yb.reshape(P, D) * buf_w[:, None])
    return y[:T].reshape(B, S, D)


def setup_inputs(seed: int = 0) -> dict:
    key = jax.random.key(seed)
    ks = jax.random.split(key, 20)
    f32 = jnp.float32
    nrm = lambda k, shape, s: jax.random.normal(k, shape, f32) * s
    L = DEPTH
    return {
        "x": nrm(ks[0], (BATCH, SEQ, D_MODEL), 1.0),
        "g_mix": 1.0 + nrm(ks[1], (L, D_MODEL), 0.02),
        "w_in": nrm(ks[2], (L, D_MODEL, IN_WIDTH), D_MODEL ** -0.5),
        "b_in": nrm(ks[3], (L, IN_WIDTH), 0.02),
        "sinks": nrm(ks[4], (L, N_Q_HEADS), 0.5),
        "w_conv": nrm(ks[5], (L, CONV_KERNEL, CONV_WIDTH), CONV_KERNEL ** -0.5),
        "w_attn_o": nrm(ks[6], (L, ATTN_WIDTH, D_MODEL), ATTN_WIDTH ** -0.5),
        "w_conv_o": nrm(ks[7], (L, CONV_WIDTH, D_MODEL), CONV_WIDTH ** -0.5),
        "w_out": nrm(ks[8], (L, D_MODEL, D_MODEL), D_MODEL ** -0.5),
        "g_ffn": 1.0 + nrm(ks[9], (L, D_MODEL), 0.02),
        "w_router": nrm(ks[10], (L, D_MODEL, N_EXPERTS), D_MODEL ** -0.5),
        "b_router": nrm(ks[11], (L, N_EXPERTS), 0.01),
        "w_gate": nrm(ks[12], (L, N_EXPERTS, D_MODEL, D_FF), D_MODEL ** -0.5),
        "b_gate": nrm(ks[13], (L, N_EXPERTS, D_FF), 0.02),
        "w_up": nrm(ks[14], (L, N_EXPERTS, D_MODEL, D_FF), D_MODEL ** -0.5),
        "b_up": nrm(ks[15], (L, N_EXPERTS, D_FF), 0.02),
        "w_down": nrm(ks[16], (L, N_EXPERTS, D_FF, D_MODEL), D_FF ** -0.5),
        "b_down": nrm(ks[17], (L, N_EXPERTS, D_MODEL), 0.02),
        "g_final": 1.0 + nrm(ks[18], (D_MODEL,), 0.02),
    }


def reference(x, g_mix, w_in, b_in, sinks, w_conv, w_attn_o, w_conv_o, w_out, g_ffn,
              w_router, b_router, w_gate, b_gate, w_up, b_up, w_down, b_down, g_final):
    B, S = x.shape[0], x.shape[1]
    positions = jnp.arange(S, dtype=jnp.int32)
    pts = split_points()
    for layer in range(DEPTH):
        h = rms_norm(x, g_mix[layer])
        proj = h @ w_in[layer] + b_in[layer]
        q, k, v, cb, cc, cx, ga, gc = jnp.split(proj, pts, axis=-1)
        q = apply_rope(q.reshape(B, S, N_Q_HEADS, HEAD_DIM), positions)
        k = apply_rope(k.reshape(B, S, N_KV_HEADS, HEAD_DIM), positions)
        v = v.reshape(B, S, N_KV_HEADS, HEAD_DIM)
        y_attn = sliding_window_attention(q, k, v, sinks[layer]) @ w_attn_o[layer]
        y_conv = (cb * causal_short_conv(cc * cx, w_conv[layer])) @ w_conv_o[layer]
        merged = jax.nn.sigmoid(ga) * y_attn + jax.nn.sigmoid(gc) * y_conv
        x = x + merged @ w_out[layer]
        h = rms_norm(x, g_ffn[layer])
        x = x + moe_ffn(h, w_router[layer], b_router[layer], w_gate[layer], b_gate[layer],
                        w_up[layer], b_up[layer], w_down[layer], b_down[layer])
    return rms_norm(x, g_final)
```

```cpp
#include <hip/hip_runtime.h>
#include <cstdio>
#include <cstdint>

#ifndef MK_N_LAUNCHES
#define MK_N_LAUNCHES 1
#endif

namespace pg8 {
#define PG8_LAS __attribute__((address_space(3)))
typedef unsigned short bf16_t;
typedef short bf16x8 __attribute__((ext_vector_type(8)));
typedef float f32x4 __attribute__((ext_vector_type(4)));
typedef unsigned u32x4 __attribute__((ext_vector_type(4)));
typedef unsigned u32x2 __attribute__((ext_vector_type(2)));
constexpr int BM = 256, BK = 64, HALF = 128, HTB = HALF * BK * 2  , STAGE_BYTES = 8 * HTB, NXCD = 8, WGM = 8;

__host__ __device__ __forceinline__ int lds_byte(int r, int c) { const int st = (r >> 4) * 2 + (c >> 5), rr = r & 15, cc = c & 31, ob = rr * 64 + cc * 2; return st * 1024 + (ob ^ (((ob >> 9) & 1) << 5)); }
__host__ __device__ __forceinline__ void stage_rc(int b, int& R, int& C) { const int st = b / 1024, sb = b % 1024, swz = sb ^ (((sb >> 9) & 1) << 5); R = (st >> 1) * 16 + swz / 64; C = (st & 1) * 32 + (swz % 64) / 2; }
__host__ __device__ __forceinline__ int perm32(int rho) { const int n = rho >> 4, i = rho & 15; return 8 * (i >> 2) + 4 * n + (i & 3); }

struct Unit { int pm, pn, e, aux; bool keep; const char* a; const char* b; };

__host__ __device__ __forceinline__ bool tile_of(long L, int nM, int nN, int& pm, int& pn) {
    const int nwg = nM * nN; if (L >= nwg) return false;
    int wgid = (int)L; { const int q = nwg / NXCD, r = nwg % NXCD, xcd = wgid % NXCD, off = wgid / NXCD; wgid = (xcd < r ? xcd * (q + 1) : r * (q + 1) + (xcd - r) * q) + off; }
    const int nig = WGM * nN, gid = wgid / nig, fm = gid * WGM, gsz = (nM - fm) < WGM ? (nM - fm) : WGM;
    pm = fm + ((wgid % nig) % gsz); pn = (wgid % nig) / gsz; return true;
}

__device__ __forceinline__ unsigned cvt_pk_bf16(float lo, float hi) { unsigned r; asm volatile("v_cvt_pk_bf16_f32 %0, %1, %2" : "=v"(r) : "v"(lo), "v"(hi)); return r; }
__device__ __forceinline__ float bf_lo(unsigned w) { return __uint_as_float(w << 16); }
__device__ __forceinline__ float bf_hi(unsigned w) { return __uint_as_float(w & 0xffff0000u); }
__device__ __forceinline__ float sigmoidf_(float x) { return 1.0f / (1.0f + __expf(-x)); }

template <class Epi, class Sched, bool ALIGN_EPI, bool GATHER>
__device__ __forceinline__ void gemm_phase(PG8_LAS unsigned char* lds, const int K, const Sched& S, const Epi& E) {
    const int tid = threadIdx.x, wid = __builtin_amdgcn_readfirstlane(tid >> 6), lane = tid & 63, wr = wid >> 2, wc = wid & 3, fr = lane & 15, fq = lane >> 4;
    const int nt = K / BK;
    unsigned voffA[2], voffB[2]; int RA[2]; unsigned CA2[2];
#pragma unroll
    for (int i = 0; i < 2; ++i) { int R, C; stage_rc(tid * 16 + i * 8192, R, C); const int Rb = Epi::PERM ? ((R & ~31) + perm32(R & 31)) : R;
        voffA[i] = (unsigned)(R * K + C) * 2u; voffB[i] = (unsigned)(Rb * K + C) * 2u; RA[i] = R; CA2[i] = (unsigned)C * 2u; }
    const size_t kstep = (size_t)(BK * 2);
    const size_t hstep = (size_t)HALF * K * 2;
    const unsigned ldsw = (unsigned)wid * 1024u;
    const int aoff = lds_byte(wr * 64 + fr, fq * 8), boff = lds_byte(wc * 32 + fr, fq * 8);
#define PG8_SA(b, h) (((b) * 2 + (h)) * HTB)
#define PG8_SB(b, h) ((4 + (b) * 2 + (h)) * HTB)
#define PG8_GLDS(src, dstoff) __builtin_amdgcn_global_load_lds((const unsigned*)(src), (PG8_LAS unsigned*)(lds + (dstoff)), 16, 0, 0)
#define PG8_STAGE_B(bufoff, gbase) do { PG8_GLDS((const char*)(gbase) + voffB[0], (bufoff) + ldsw); PG8_GLDS((const char*)(gbase) + voffB[1], (bufoff) + ldsw + 8192); } while (0)
#define PG8_STAGE_A(bufoff, gbase, h, o0, o1) do { \
        if constexpr (GATHER) { PG8_GLDS((const char*)(gbase) + (o0), (bufoff) + ldsw); PG8_GLDS((const char*)(gbase) + (o1), (bufoff) + ldsw + 8192); } \
        else { PG8_GLDS((const char*)(gbase) + (h) * hstep + voffA[0], (bufoff) + ldsw); PG8_GLDS((const char*)(gbase) + (h) * hstep + voffA[1], (bufoff) + ldsw + 8192); } } while (0)
#define PG8_LDA(dst, b, h) do { _Pragma("unroll") for (int m = 0; m < 4; ++m) _Pragma("unroll") for (int k = 0; k < 2; ++k) dst[m][k] = *(const PG8_LAS bf16x8*)(lds + PG8_SA(b, h) + aoff + m * 2048 + k * 1024); } while (0)
#define PG8_LDB(dst, b, h) do { _Pragma("unroll") for (int n = 0; n < 2; ++n) _Pragma("unroll") for (int k = 0; k < 2; ++k) dst[n][k] = *(const PG8_LAS bf16x8*)(lds + PG8_SB(b, h) + boff + n * 2048 + k * 1024); } while (0)
#define PG8_MMA(ai, bj, At, Bt) do { __builtin_amdgcn_s_setprio(1); _Pragma("unroll") for (int m = 0; m < 4; ++m) _Pragma("unroll") for (int n = 0; n < 2; ++n) _Pragma("unroll") for (int k = 0; k < 2; ++k) \
        acc[ai][bj][m][n] = __builtin_amdgcn_mfma_f32_16x16x32_bf16(Bt[n][k], At[m][k], acc[ai][bj][m][n], 0, 0, 0); __builtin_amdgcn_s_setprio(0); } while (0)
#define PG8_WAIT_V(n) asm volatile("s_waitcnt vmcnt(" #n ")" ::: "memory")
#define PG8_WAIT_L(n) asm volatile("s_waitcnt lgkmcnt(" #n ")" ::: "memory")
#define PG8_BAR __builtin_amdgcn_s_barrier()
#define PG8_SCHED __builtin_amdgcn_sched_barrier(0)
    Unit cur, nxt; int ui = 0;
    if (!S.next(0, cur)) return;
    f32x4 acc[2][2][4][2];
#pragma unroll
    for (int a = 0; a < 2; ++a)
#pragma unroll
        for (int b = 0; b < 2; ++b)
#pragma unroll
            for (int m = 0; m < 4; ++m)
#pragma unroll
                for (int n = 0; n < 2; ++n) acc[a][b][m][n] = (f32x4){0.f, 0.f, 0.f, 0.f};
    bf16x8 At[4][2], B0[2][2], B1[2][2];
    unsigned gA00 = 0, gA01 = 0, gA10 = 0, gA11 = 0, gN00 = 0, gN01 = 0, gN10 = 0, gN11 = 0;
    if constexpr (GATHER) { gA00 = S.tokoff(0, RA[0]) + CA2[0]; gA01 = S.tokoff(0, RA[1]) + CA2[1]; gA10 = S.tokoff(0, HALF + RA[0]) + CA2[0]; gA11 = S.tokoff(0, HALF + RA[1]) + CA2[1]; }
    const char* cA = cur.a; const char* cB = cur.b;
    PG8_STAGE_B(PG8_SB(0, 0), cB); PG8_STAGE_B(PG8_SB(0, 1), cB + hstep); PG8_STAGE_A(PG8_SA(0, 0), cA, 0, gA00, gA01); PG8_STAGE_A(PG8_SA(0, 1), cA, 1, gA10, gA11);
    if (wr == 1) PG8_BAR;
    PG8_WAIT_V(2); PG8_BAR;
    PG8_STAGE_B(PG8_SB(1, 0), cB + kstep); PG8_STAGE_A(PG8_SA(1, 0), cA + kstep, 0, gA00, gA01); PG8_STAGE_B(PG8_SB(1, 1), cB + hstep + kstep);
    PG8_WAIT_V(6); PG8_BAR;
    for (;;) {
        const bool has_next = S.next(ui + 1, nxt);
        if constexpr (GATHER) { if (has_next) { gN00 = S.tokoff(ui + 1, RA[0]) + CA2[0]; gN01 = S.tokoff(ui + 1, RA[1]) + CA2[1]; gN10 = S.tokoff(ui + 1, HALF + RA[0]) + CA2[0]; gN11 = S.tokoff(ui + 1, HALF + RA[1]) + CA2[1]; } }
        const char* nA = has_next ? nxt.a : cA; const char* nB = has_next ? nxt.b : cB;
        for (int t = 0; t < nt; t += 2) {
            const bool last = (t == nt - 2);
            const char* a1 = cA + (size_t)(t + 1) * kstep;
            const char* a2 = last ? nA : cA + (size_t)(t + 2) * kstep; const char* b2 = last ? nB : cB + (size_t)(t + 2) * kstep;
            const char* a3 = a2 + kstep; const char* b3 = b2 + kstep;
            unsigned s00 = gA00, s01 = gA01, s10 = gA10, s11 = gA11;
            if constexpr (GATHER) { if (last && has_next) { s00 = gN00; s01 = gN01; s10 = gN10; s11 = gN11; } }
            PG8_LDB(B0, 0, 0); PG8_LDB(B1, 0, 1); PG8_SCHED; PG8_LDA(At, 0, 0); PG8_STAGE_A(PG8_SA(1, 1), a1, 1, gA10, gA11);
            PG8_WAIT_V(8); PG8_WAIT_L(0); PG8_BAR; PG8_MMA(0, 0, At, B0); PG8_MMA(0, 1, At, B1); PG8_BAR; PG8_SCHED;
            PG8_LDA(At, 0, 1); PG8_STAGE_B(PG8_SB(0, 0), b2); PG8_STAGE_B(PG8_SB(0, 1), b2 + hstep); PG8_STAGE_A(PG8_SA(0, 0), a2, 0, s00, s01);
            PG8_WAIT_V(8); PG8_WAIT_L(0); PG8_BAR; PG8_MMA(1, 0, At, B0); PG8_MMA(1, 1, At, B1); PG8_BAR; PG8_SCHED;
            PG8_LDB(B0, 1, 0); PG8_LDB(B1, 1, 1); PG8_SCHED; PG8_LDA(At, 1, 0); PG8_STAGE_A(PG8_SA(0, 1), a2, 1, s10, s11);
            PG8_WAIT_V(8); PG8_WAIT_L(0); PG8_BAR; PG8_MMA(0, 0, At, B0); PG8_MMA(0, 1, At, B1); PG8_BAR; PG8_SCHED;
            PG8_LDA(At, 1, 1); PG8_STAGE_B(PG8_SB(1, 0), b3); PG8_STAGE_B(PG8_SB(1, 1), b3 + hstep); PG8_STAGE_A(PG8_SA(1, 0), a3, 0, s00, s01);
            PG8_WAIT_V(8); PG8_WAIT_L(0); PG8_BAR; PG8_MMA(1, 0, At, B0); PG8_MMA(1, 1, At, B1); PG8_BAR; PG8_SCHED;
        }
        if constexpr (ALIGN_EPI) { if (wr == 0) PG8_BAR; }
        E(acc, cur, wr, wc, fr, fq);
        if (!has_next) break;
        if (!cur.keep) {
#pragma unroll
            for (int a = 0; a < 2; ++a)
#pragma unroll
                for (int b = 0; b < 2; ++b)
#pragma unroll
                    for (int m = 0; m < 4; ++m)
#pragma unroll
                        for (int n = 0; n < 2; ++n) acc[a][b][m][n] = (f32x4){0.f, 0.f, 0.f, 0.f};
        }
        cur = nxt; cA = nA; cB = nB; ++ui;
        if constexpr (GATHER) { gA00 = gN00; gA01 = gN01; gA10 = gN10; gA11 = gN11; }
        if constexpr (ALIGN_EPI) { if (wr == 1) PG8_BAR; }
    }
    PG8_WAIT_V(0);
    if constexpr (!ALIGN_EPI) { if (wr == 0) PG8_BAR; }
    PG8_BAR;
#undef PG8_SA
#undef PG8_SB
#undef PG8_GLDS
#undef PG8_STAGE_A
#undef PG8_STAGE_B
#undef PG8_LDA
#undef PG8_LDB
#undef PG8_MMA
#undef PG8_WAIT_V
#undef PG8_WAIT_L
#undef PG8_BAR
#undef PG8_SCHED
}
}

constexpr int NWAVES = 8;
constexpr int N_LAUNCHES = MK_N_LAUNCHES;
constexpr int PER_PHASE = 9;
constexpr int BATCH = 2, SEQ = 8192, D = 1024, M = BATCH * SEQ, HD = 64, NQH = 16, NKVH = 4, KVW = 256;
constexpr int NIN = 6656, NEXP = 32, TOPK = 4, DFF = 1024;
constexpr float RMS_EPS = 1e-5f;
constexpr float QSCALE = 0.125f * 1.4426950408889634f;
constexpr float LOG2E = 1.4426950408889634f;
constexpr int MAXTILES = 288;
constexpr int SLOTCAP = 16384;
constexpr int MAXU = 16;

constexpr size_t MiB = 1u << 20;
constexpr size_t WS_CTL = 0, CTL_ZERO_BYTES = 1 * MiB;
constexpr size_t WS_BINP = 1 * MiB;
constexpr size_t WS_BGU = 1 * MiB + 64 * 1024;
constexpr size_t WS_COS = 2 * MiB, WS_SIN = 3 * MiB;
constexpr size_t WS_WIN = 4 * MiB;
constexpr size_t WS_WAO = 17 * MiB, WS_WCO = 19 * MiB, WS_WOUT = 21 * MiB;
constexpr size_t WS_XN = 24 * MiB;
constexpr size_t WS_Q = 56 * MiB, WS_K = 88 * MiB, WS_V = 96 * MiB, WS_CB = 104 * MiB, WS_MG = 136 * MiB, WS_U = 168 * MiB, WS_SA = 200 * MiB, WS_SC = 232 * MiB;
constexpr size_t WS_WGU = 264 * MiB;
constexpr size_t WS_WD = 392 * MiB;
constexpr size_t WS_TOKREL = 456 * MiB;
constexpr size_t WS_ROUTE = 458 * MiB;
constexpr size_t WS_ROUTEW = 459 * MiB;
constexpr size_t WS_ACT = 56 * MiB;
constexpr size_t WS_Y = 200 * MiB;
constexpr size_t WS_END = 460 * MiB;
static_assert(WS_ACT + (size_t)MAXTILES * 256 * 2048 <= WS_Y && WS_Y + (size_t)MAXTILES * 256 * 2048 <= WS_WD, "MoE overlays");
constexpr int CW_TMO = 0;
constexpr int CW_CURSOR = 1024;
constexpr int CW_BAR = 4096;
#define XCD_BAR_WORDS_C 3456
static_assert((CW_BAR + 3 * XCD_BAR_WORDS_C) * 4 <= (int)CTL_ZERO_BYTES, "CTL");

constexpr int RING_OFF = 0, RING_BYTES = 131072;
constexpr int LDSCTL_OFF = RING_BYTES, MISC_OFF = LDSCTL_OFF + 320;
constexpr int TAB_OFF = RING_BYTES + 512;
constexpr int TAB_CNT = TAB_OFF, TAB_TSTART = TAB_OFF + 128, TAB_TILEE = TAB_OFF + 128 + 160;
constexpr int TOK_OFF = TAB_OFF + 2048;
constexpr int LDS_BYTES = TOK_OFF + MAXU * 1024;
static_assert(TAB_TILEE + 320 * 4 <= TOK_OFF && LDS_BYTES <= 163840, "LDS map");

#define GAS __attribute__((address_space(1)))
#define LAS __attribute__((address_space(3)))
typedef unsigned short bf16;
typedef unsigned v4u __attribute__((ext_vector_type(4)));
typedef unsigned v2u __attribute__((ext_vector_type(2)));
typedef float f32x4 __attribute__((ext_vector_type(4)));
typedef float f32x16 __attribute__((ext_vector_type(16)));
typedef short bf16x8 __attribute__((ext_vector_type(8)));
typedef short s16x4 __attribute__((ext_vector_type(4)));
typedef GAS unsigned gu32;
#define RLX_AGENT __ATOMIC_RELAXED, __HIP_MEMORY_SCOPE_AGENT
#define LDS_WAIT() asm volatile("s_waitcnt lgkmcnt(0)" ::: "memory")
#define VM_WAIT() asm volatile("s_waitcnt vmcnt(0)" ::: "memory")
using pg8::cvt_pk_bf16; using pg8::bf_lo; using pg8::bf_hi;

#define XB_TMO      128
#define XB_XCNT(j)  (256  + 64 * (j))
#define XB_XSUB(j)  (1280 + 64 * (j))
#define XB_XGEN(j)  (2304 + 64 * (j))
#define XB_TOP      3328
#define XB_TOPGEN   3392
#define XCD_BAR_WORDS 3456
#define XB_SPIN_CAP (1u << 18)
static_assert(XCD_BAR_WORDS == XCD_BAR_WORDS_C, "bar words");

__device__ __forceinline__ unsigned xb_ld(unsigned* p)              { return __hip_atomic_load(p, __ATOMIC_RELAXED, __HIP_MEMORY_SCOPE_AGENT); }
__device__ __forceinline__ unsigned xb_add(unsigned* p, unsigned v) { return __hip_atomic_fetch_add(p, v, __ATOMIC_RELAXED, __HIP_MEMORY_SCOPE_AGENT); }
__device__ __forceinline__ unsigned xb_xcc_id() { return (unsigned)__builtin_amdgcn_s_getreg((3 << 11) | 20) & 0xFu; }
#define XB_SPIN(cond, bar) do { unsigned _sp = 0; while (cond) { __builtin_amdgcn_s_sleep(1); \
    if ((++_sp & 255u) == 0u) { if (xb_ld(&(bar)[XB_TMO])) break; if (_sp > XB_SPIN_CAP) { atomicAdd(&(bar)[XB_TMO], 1u); break; } } } } while (0)

struct XcdBarrier { unsigned* bar; unsigned x; volatile LAS unsigned* st; };

__device__ __forceinline__ XcdBarrier xcd_barrier_post(unsigned* bar, volatile LAS unsigned* st) {
    XcdBarrier b; b.bar = bar; b.x = xb_xcc_id(); b.st = st;
    if (threadIdx.x == 0) (void)xb_add(&bar[XB_XCNT(b.x)], 1u);
    return b;
}
__device__ __forceinline__ void xcd_barrier_complete(unsigned* bar, unsigned x, unsigned& nloc, unsigned& nx) {
    const unsigned G = gridDim.x * gridDim.y * gridDim.z;
    unsigned sum, cnt, mine, sp = 0u;
    for (;;) {
        sum = 0u; cnt = 0u; mine = 0u;
#pragma unroll
        for (unsigned j = 0; j < 16; ++j) { const unsigned c = xb_ld(&bar[XB_XCNT(j)]); sum += c; cnt += (c > 0u) ? 1u : 0u; mine = (j == x) ? c : mine; }
        if (sum == G) break;
        __builtin_amdgcn_s_sleep(1);
        if ((++sp & 255u) == 0u) { if (xb_ld(&bar[XB_TMO])) break; if (sp > XB_SPIN_CAP) { atomicAdd(&bar[XB_TMO], 1u); break; } }
    }
    nloc = mine > 0u ? mine : 1u; nx = cnt > 0u ? cnt : 1u;
}
__device__ __forceinline__ void xcd_barrier(const XcdBarrier& b) {
    asm volatile("s_waitcnt vmcnt(0)" ::: "memory");
    __syncthreads();
    if (threadIdx.x == 0) {
        unsigned* bar = b.bar;
        __builtin_amdgcn_s_waitcnt(0);
        unsigned nloc = b.st[0], nx = b.st[1];
        if (nloc == 0u) { xcd_barrier_complete(bar, b.x, nloc, nx); b.st[0] = nloc; b.st[1] = nx; }
        const unsigned old = xb_add(&bar[XB_XSUB(b.x)], 1u);
        const unsigned gen = old / nloc;
        if (old + 1u == (gen + 1u) * nloc) {
            __builtin_amdgcn_fence(__ATOMIC_RELEASE, "agent");
            asm volatile("s_waitcnt vmcnt(0)" ::: "memory");
            const unsigned og = xb_add(&bar[XB_TOP], 1u);
            const unsigned tg = og / nx;
            if (og + 1u == (tg + 1u) * nx) xb_add(&bar[XB_TOPGEN], 1u);
            else XB_SPIN(xb_ld(&bar[XB_TOPGEN]) == tg, bar);
            __builtin_amdgcn_fence(__ATOMIC_ACQUIRE, "agent");
            xb_add(&bar[XB_XGEN(b.x)], 1u);
            asm volatile("s_waitcnt vmcnt(0)" ::: "memory");
        } else {
            XB_SPIN(xb_ld(&bar[XB_XGEN(b.x)]) == gen, bar);
            __builtin_amdgcn_fence(__ATOMIC_ACQUIRE, "agent");
            asm volatile("s_waitcnt vmcnt(0)" ::: "memory");
        }
    }
    __syncthreads();
}

__device__ __forceinline__ float wave_sum(float v) {
#pragma unroll
    for (int o = 1; o < 64; o <<= 1) v += __shfl_xor(v, o);
    return v;
}
__device__ __forceinline__ float wave_max(float v) {
#pragma unroll
    for (int o = 1; o < 64; o <<= 1) v = fmaxf(v, __shfl_xor(v, o));
    return v;
}
__device__ __forceinline__ int wave_min_i(int v) {
#pragma unroll
    for (int o = 1; o < 64; o <<= 1) { const int w = __shfl_xor(v, o); v = w < v ? w : v; }
    return v;
}

__device__ __forceinline__ int win_dest(int c) {
    if (c < 1280) { const int h = c >> 6, d = c & 63, s = d >> 5, i = d & 31; return (h << 6) + 8 * (i >> 2) + 4 * s + (i & 3); }
    if (c < 2560) return c;
    if (c < 3584) { const int i = c - 2560; return 2560 + (i >> 2) * 8 + (i & 3); }
    if (c < 4608) { const int i = c - 3584; return 2560 + (i >> 2) * 8 + 4 + (i & 3); }
    return c;
}
__device__ __forceinline__ int map_dest(int mode, int n) {
    if (mode == 0) return n;
    if (mode == 1) return win_dest(n);
    if (mode == 2) return (n >> 2) * 8 + (n & 3);
    return (n >> 2) * 8 + 4 + (n & 3);
}

__device__ __forceinline__ void p0_transpose_item(const float* W, int K, int N, bf16* WT, int mode, LAS float* scr, int item, int lane) {
    const int nblk = N / 32, kb = item / nblk, nb = item % nblk, k0 = 64 * kb, n0 = 32 * nb;
#pragma unroll 8
    for (int i = 0; i < 32; ++i) { const int kk = 2 * i + (lane >> 5); scr[kk * 33 + (lane & 31)] = W[(size_t)(k0 + kk) * N + n0 + (lane & 31)]; }
    LDS_WAIT(); asm volatile("" ::: "memory");
    const int c = lane & 7;
#pragma unroll
    for (int j = 0; j < 4; ++j) { const int n = (lane >> 3) + 8 * j; const LAS float* s = scr + (8 * c) * 33 + n;
        v4u o; o.x = cvt_pk_bf16(s[0 * 33], s[1 * 33]); o.y = cvt_pk_bf16(s[2 * 33], s[3 * 33]); o.z = cvt_pk_bf16(s[4 * 33], s[5 * 33]); o.w = cvt_pk_bf16(s[6 * 33], s[7 * 33]);
        *(GAS v4u*)(WT + (size_t)map_dest(mode, n0 + n) * K + k0 + 8 * c) = o; }
    LDS_WAIT(); asm volatile("" ::: "memory");
}

__device__ __forceinline__ void rms_row_to_bf16(const float* xrow, const float* g, bf16* orow, int lane) {
    const GAS f32x4* xr = (const GAS f32x4*)xrow + lane; const GAS f32x4* gr = (const GAS f32x4*)g + lane;
    f32x4 v[4]; float s = 0.f;
#pragma unroll
    for (int j = 0; j < 4; ++j) { v[j] = xr[64 * j]; s += (v[j].x * v[j].x + v[j].y * v[j].y) + (v[j].z * v[j].z + v[j].w * v[j].w); }
    const float rstd = 1.f / sqrtf(wave_sum(s) * (1.f / D) + RMS_EPS);
    GAS v2u* o8 = (GAS v2u*)orow + lane;
#pragma unroll
    for (int j = 0; j < 4; ++j) { const f32x4 gg = gr[64 * j]; v2u w; w.x = cvt_pk_bf16(v[j].x * rstd * gg.x, v[j].y * rstd * gg.y); w.y = cvt_pk_bf16(v[j].z * rstd * gg.z, v[j].w * rstd * gg.w); o8[64 * j] = w; }
}

struct DenseOrder {
    int nM, nN, G, c, K; const char* A; const char* B;
    __device__ __forceinline__ bool next(int i, pg8::Unit& u) const {
        if (!pg8::tile_of((long)i * G + c, nM, nN, u.pm, u.pn)) return false;
        u.e = 0; u.aux = 1; u.keep = false; u.a = A + (size_t)u.pm * 256 * K * 2; u.b = B + (size_t)u.pn * 256 * K * 2; return true; }
    __device__ __forceinline__ unsigned tokoff(int, int) const { return 0u; }
};
struct MergeOrder {
    int nM, nN, G, c, K; const char* A0; const char* B0; const char* A1; const char* B1;
    __device__ __forceinline__ bool next(int i, pg8::Unit& u) const {
        if (!pg8::tile_of((long)(i >> 1) * G + c, nM, nN, u.pm, u.pn)) return false;
        const int br = i & 1; u.e = 0; u.aux = br; u.keep = (br == 0);
        u.a = (br ? A1 : A0) + (size_t)u.pm * 256 * K * 2; u.b = (br ? B1 : B0) + (size_t)u.pn * 256 * K * 2; return true; }
    __device__ __forceinline__ unsigned tokoff(int, int) const { return 0u; }
};
struct GroupOrder {
    int MT, nN, G, c, K; const char* A; const char* B; size_t strideE; bool gather; const LAS int* tile_e; const LAS unsigned* tok;
    __device__ __forceinline__ bool next(int i, pg8::Unit& u) const {
        if (!pg8::tile_of((long)i * G + c, MT, nN, u.pm, u.pn)) return false;
        const int e = __builtin_amdgcn_readfirstlane(tile_e[u.pm]);
        u.e = e; u.aux = 1; u.keep = false; u.a = gather ? A : A + (size_t)u.pm * 256 * K * 2; u.b = B + (size_t)e * strideE + (size_t)u.pn * 256 * K * 2; return true; }
    __device__ __forceinline__ unsigned tokoff(int i, int row) const { return tok[i * 256 + row]; }
};

using pg8::f32x4; using pg8::Unit;
struct EpiInProj {
    static constexpr bool PERM = true;
    bf16 *Q, *Kb, *Vb, *CB, *U, *SA, *SC; const float* bias; const float* cosT; const float* sinT;
    __device__ __forceinline__ void operator()(const f32x4 (&acc)[2][2][4][2], const Unit& u, int wr, int wc, int fr, int fq) const {
        const int pn = u.pn, row0 = u.pm * 256 + wr * 64 + fr, cl0 = wc * 32 + 8 * fq, bcol0 = pn * 256 + cl0;
        f32x4 bv[2][2];
#pragma unroll
        for (int bj = 0; bj < 2; ++bj)
#pragma unroll
            for (int n = 0; n < 2; ++n) bv[bj][n] = *(const f32x4*)(bias + bcol0 + bj * 128 + 4 * n);
        if (pn < 5) {
            bf16* base = pn < 4 ? Q : Kb; const int ld = pn < 4 ? 1024 : 256, colt = pn < 4 ? pn * 256 : 0; const float sc = pn < 4 ? QSCALE : 1.0f;
            const int i0 = 16 * (wc & 1) + 4 * fq;
#pragma unroll
            for (int ai = 0; ai < 2; ++ai)
#pragma unroll
                for (int m = 0; m < 4; ++m) { const int row = row0 + ai * 128 + m * 16, pos = row & (SEQ - 1);
                    const f32x4 c4 = *(const f32x4*)(cosT + pos * 32 + i0) * sc, s4 = *(const f32x4*)(sinT + pos * 32 + i0) * sc;
#pragma unroll
                    for (int bj = 0; bj < 2; ++bj) { const f32x4 t1 = acc[ai][bj][m][0] + bv[bj][0], t2 = acc[ai][bj][m][1] + bv[bj][1];
                        const f32x4 o1 = t1 * c4 - t2 * s4, o2 = t2 * c4 + t1 * s4;
                        v4u w; w.x = cvt_pk_bf16(o1[0], o1[1]); w.y = cvt_pk_bf16(o1[2], o1[3]); w.z = cvt_pk_bf16(o2[0], o2[1]); w.w = cvt_pk_bf16(o2[2], o2[3]);
                        *(v4u*)(base + (size_t)row * ld + colt + cl0 + bj * 128) = w; } }
        } else if (pn >= 10 && pn < 18) {
            const int colt = (pn - 10) * 128 + (cl0 >> 1);
#pragma unroll
            for (int ai = 0; ai < 2; ++ai)
#pragma unroll
                for (int m = 0; m < 4; ++m) { const int row = row0 + ai * 128 + m * 16;
#pragma unroll
                    for (int bj = 0; bj < 2; ++bj) { const f32x4 p = (acc[ai][bj][m][0] + bv[bj][0]) * (acc[ai][bj][m][1] + bv[bj][1]);
                        v2u w; w.x = cvt_pk_bf16(p[0], p[1]); w.y = cvt_pk_bf16(p[2], p[3]);
                        *(v2u*)(U + (size_t)row * 1024 + colt + bj * 64) = w; } }
        } else {
            bf16* base; int ld = 1024, colt; bool sg = false;
            if (pn == 5) { base = Vb; ld = 256; colt = 0; }
            else if (pn < 10) { base = CB; colt = (pn - 6) * 256; }
            else if (pn < 22) { base = SA; colt = (pn - 18) * 256; sg = true; }
            else { base = SC; colt = (pn - 22) * 256; sg = true; }
#pragma unroll
            for (int ai = 0; ai < 2; ++ai)
#pragma unroll
                for (int m = 0; m < 4; ++m) { const int row = row0 + ai * 128 + m * 16;
#pragma unroll
                    for (int bj = 0; bj < 2; ++bj) { f32x4 v0 = acc[ai][bj][m][0] + bv[bj][0], v1 = acc[ai][bj][m][1] + bv[bj][1];
                        if (sg) {
#pragma unroll
                            for (int q = 0; q < 4; ++q) { v0[q] = pg8::sigmoidf_(v0[q]); v1[q] = pg8::sigmoidf_(v1[q]); } }
                        v4u w; w.x = cvt_pk_bf16(v0[0], v0[1]); w.y = cvt_pk_bf16(v0[2], v0[3]); w.z = cvt_pk_bf16(v1[0], v1[1]); w.w = cvt_pk_bf16(v1[2], v1[3]);
                        *(v4u*)(base + (size_t)row * ld + colt + cl0 + bj * 128) = w; } }
        }
    }
};
struct EpiMerge {
    static constexpr bool PERM = true;
    const bf16 *SA, *SC; bf16* MG;
    __device__ __forceinline__ void operator()(f32x4 (&acc)[2][2][4][2], const Unit& u, int wr, int wc, int fr, int fq) const {
        const int row0 = u.pm * 256 + wr * 64 + fr, col0 = u.pn * 256 + wc * 32 + 8 * fq;
#pragma unroll
        for (int ai = 0; ai < 2; ++ai)
#pragma unroll
            for (int m = 0; m < 4; ++m) { const size_t ro = (size_t)(row0 + ai * 128 + m * 16) * 1024;
#pragma unroll
                for (int bj = 0; bj < 2; ++bj) { const size_t off = ro + col0 + bj * 128;
                    const v4u c = *(const v4u*)(SC + off);
                    f32x4 c0 = {bf_lo(c.x), bf_hi(c.x), bf_lo(c.y), bf_hi(c.y)}, c1 = {bf_lo(c.z), bf_hi(c.z), bf_lo(c.w), bf_hi(c.w)};
#pragma unroll
                    for (int q = 0; q < 4; ++q) { c0[q] = fmaxf(c0[q], 1e-20f); c1[q] = fmaxf(c1[q], 1e-20f); }
                    if (u.aux == 0) {
                        const v4u a = *(const v4u*)(SA + off);
                        const f32x4 a0 = {bf_lo(a.x), bf_hi(a.x), bf_lo(a.y), bf_hi(a.y)}, a1 = {bf_lo(a.z), bf_hi(a.z), bf_lo(a.w), bf_hi(a.w)};
                        acc[ai][bj][m][0] = acc[ai][bj][m][0] * (a0 / c0); acc[ai][bj][m][1] = acc[ai][bj][m][1] * (a1 / c1);
                    } else {
                        const f32x4 v0 = acc[ai][bj][m][0] * c0, v1 = acc[ai][bj][m][1] * c1;
                        v4u w; w.x = cvt_pk_bf16(v0[0], v0[1]); w.y = cvt_pk_bf16(v0[2], v0[3]); w.z = cvt_pk_bf16(v1[0], v1[1]); w.w = cvt_pk_bf16(v1[2], v1[3]);
                        *(v4u*)(MG + off) = w;
                    } } }
    }
};
struct EpiRes {
    static constexpr bool PERM = false;
    const float* base; float* out;
    __device__ __forceinline__ void operator()(const f32x4 (&acc)[2][2][4][2], const Unit& u, int wr, int wc, int fr, int fq) const {
        const int row0 = u.pm * 256 + wr * 64 + fr, col0 = u.pn * 256 + wc * 32 + 4 * fq;
#pragma unroll
        for (int ai = 0; ai < 2; ++ai)
#pragma unroll
            for (int m = 0; m < 4; ++m) { const size_t ro = (size_t)(row0 + ai * 128 + m * 16) * 1024 + col0;
#pragma unroll
                for (int bj = 0; bj < 2; ++bj)
#pragma unroll
                    for (int n = 0; n < 2; ++n) { const size_t off = ro + bj * 128 + n * 16; *(f32x4*)(out + off) = *(const f32x4*)(base + off) + acc[ai][bj][m][n]; } }
    }
};
struct EpiGU {
    static constexpr bool PERM = true;
    bf16* ACT; const float* bgu;
    __device__ __forceinline__ void operator()(const f32x4 (&acc)[2][2][4][2], const Unit& u, int wr, int wc, int fr, int fq) const {
        const int row0 = u.pm * 256 + wr * 64 + fr, cl0 = u.pn * 256 + wc * 32 + 8 * fq;
        const float* bb = bgu + (size_t)u.e * 2048 + cl0;
        f32x4 bv[2][2];
#pragma unroll
        for (int bj = 0; bj < 2; ++bj)
#pragma unroll
            for (int n = 0; n < 2; ++n) bv[bj][n] = *(const f32x4*)(bb + bj * 128 + 4 * n);
#pragma unroll
        for (int ai = 0; ai < 2; ++ai)
#pragma unroll
            for (int m = 0; m < 4; ++m) { bf16* rp = ACT + (size_t)(row0 + ai * 128 + m * 16) * 1024 + (cl0 >> 1);
#pragma unroll
                for (int bj = 0; bj < 2; ++bj) { const f32x4 g4 = acc[ai][bj][m][0] + bv[bj][0], u4 = acc[ai][bj][m][1] + bv[bj][1]; f32x4 o;
#pragma unroll
                    for (int q = 0; q < 4; ++q) { const float g = fminf(g4[q], 7.0f), uu = fminf(fmaxf(u4[q], -7.0f), 7.0f); o[q] = g * pg8::sigmoidf_(1.702f * g) * (uu + 1.0f); }
                    v2u w; w.x = cvt_pk_bf16(o[0], o[1]); w.y = cvt_pk_bf16(o[2], o[3]);
                    *(v2u*)(rp + bj * 64) = w; } }
    }
};
struct EpiDown {
    static constexpr bool PERM = true;
    bf16* Y; const float* bd;
    __device__ __forceinline__ void operator()(const f32x4 (&acc)[2][2][4][2], const Unit& u, int wr, int wc, int fr, int fq) const {
        const int row0 = u.pm * 256 + wr * 64 + fr, cl0 = u.pn * 256 + wc * 32 + 8 * fq;
        const float* bb = bd + (size_t)u.e * 1024 + cl0;
        f32x4 bv[2][2];
#pragma unroll
        for (int bj = 0; bj < 2; ++bj)
#pragma unroll
            for (int n = 0; n < 2; ++n) bv[bj][n] = *(const f32x4*)(bb + bj * 128 + 4 * n);
#pragma unroll
        for (int ai = 0; ai < 2; ++ai)
#pragma unroll
            for (int m = 0; m < 4; ++m) { bf16* rp = Y + (size_t)(row0 + ai * 128 + m * 16) * 1024 + cl0;
#pragma unroll
                for (int bj = 0; bj < 2; ++bj) { const f32x4 v0 = acc[ai][bj][m][0] + bv[bj][0], v1 = acc[ai][bj][m][1] + bv[bj][1];
                    v4u w; w.x = cvt_pk_bf16(v0[0], v0[1]); w.y = cvt_pk_bf16(v0[2], v0[3]); w.z = cvt_pk_bf16(v1[0], v1[1]); w.w = cvt_pk_bf16(v1[2], v1[3]);
                    *(v4u*)(rp + bj * 128) = w; } }
    }
};

namespace att {
constexpr int KS_STRIDE = 144, VT_STRIDE = 520;
constexpr int L_KS = 0, L_VT = 36864, L_ST = 70144, L_SC = 102912, L_END = 103936;
static_assert(L_VT == 256 * KS_STRIDE && L_ST == L_VT + 64 * VT_STRIDE && L_END <= RING_BYTES, "attention LDS map");
__device__ __forceinline__ int crow(int r, int hi) { return (r & 3) + 8 * (r >> 2) + 4 * hi; }

__device__ __forceinline__ void attn_unit(LAS unsigned char* lds, int b, int kvh, int n, const bf16* Q, const bf16* Kb, const bf16* Vb, bf16* O, const float* sinks) {
    const int tid = threadIdx.x, lane = tid & 63, r32 = lane & 31, hi = lane >> 5, wid = __builtin_amdgcn_readfirstlane(tid >> 6);
    const int tokbase = b * SEQ, r0 = 128 * (n - 1);
#pragma unroll
    for (int it = 0; it < 4; ++it) { const int p = tid + 512 * it, row = p >> 3, ch = p & 7; int pos = r0 + row; pos = pos < 0 ? 0 : pos;
        const v4u v = *(const v4u*)(Kb + (size_t)(tokbase + pos) * KVW + kvh * 64 + ch * 8);
        *(LAS v4u*)(lds + L_KS + row * KS_STRIDE + ch * 16) = v; }
#pragma unroll
    for (int it = 0; it < 4; ++it) { const int p = tid + 512 * it, key = p & 255, c = p >> 8; int pos = r0 + key; pos = pos < 0 ? 0 : pos;
        const v4u v = *(const v4u*)(Vb + (size_t)(tokbase + pos) * KVW + kvh * 64 + c * 8);
        LAS unsigned short* vt = (LAS unsigned short*)(lds + L_VT + (8 * c) * VT_STRIDE + key * 2);
        vt[0 * (VT_STRIDE / 2)] = (unsigned short)(v.x & 0xffffu); vt[1 * (VT_STRIDE / 2)] = (unsigned short)(v.x >> 16);
        vt[2 * (VT_STRIDE / 2)] = (unsigned short)(v.y & 0xffffu); vt[3 * (VT_STRIDE / 2)] = (unsigned short)(v.y >> 16);
        vt[4 * (VT_STRIDE / 2)] = (unsigned short)(v.z & 0xffffu); vt[5 * (VT_STRIDE / 2)] = (unsigned short)(v.z >> 16);
        vt[6 * (VT_STRIDE / 2)] = (unsigned short)(v.w & 0xffffu); vt[7 * (VT_STRIDE / 2)] = (unsigned short)(v.w >> 16); }
    __syncthreads();
    const int g = wid >> 1, hq = 4 * kvh + g;
    const float sinkv = sinks[hq] * LOG2E;
    LAS float* scr = (LAS float*)(lds + L_SC + wid * 128);
    LAS unsigned short* stg = (LAS unsigned short*)(lds + L_ST + wid * 4096);
#pragma unroll 1
    for (int sub = 0; sub < 2; ++sub) {
        const int q0 = 64 * (wid & 1) + 32 * sub, tb = q0 >> 5;
        const size_t qtok = (size_t)tokbase + 128 * n + q0;
        bf16x8 qf[4];
#pragma unroll
        for (int s = 0; s < 4; ++s) qf[s] = *(const bf16x8*)(Q + (qtok + r32) * 1024 + hq * 64 + 16 * s + 8 * hi);
        f32x16 sc[5];
#pragma unroll
        for (int i = 0; i < 5; ++i) { f32x16 a = {};
#pragma unroll
            for (int s = 0; s < 4; ++s) { const bf16x8 kf = *(const LAS bf16x8*)(lds + L_KS + (32 * (tb + i) + r32) * KS_STRIDE + (16 * s + 8 * hi) * 2);
                a = __builtin_amdgcn_mfma_f32_32x32x16_bf16(kf, qf[s], a, 0, 0, 0); }
            sc[i] = a; }
#pragma unroll
        for (int r = 0; r < 16; ++r) { const int kl = crow(r, hi);
            if (!(kl > r32)) sc[0][r] = -INFINITY;
            if (!(kl <= r32)) sc[4][r] = -INFINITY; }
        if (n == 0) {
#pragma unroll
            for (int i = 0; i < 4; ++i) if (tb + i < 4) {
#pragma unroll
                for (int r = 0; r < 16; ++r) sc[i][r] = -INFINITY; } }
        float mx = sinkv;
#pragma unroll
        for (int i = 0; i < 5; ++i)
#pragma unroll
            for (int r = 0; r < 16; ++r) mx = fmaxf(mx, sc[i][r]);
        mx = fmaxf(mx, __shfl_xor(mx, 32));
        float sum = 0.f;
#pragma unroll
        for (int i = 0; i < 5; ++i)
#pragma unroll
            for (int r = 0; r < 16; ++r) { const float p = __builtin_amdgcn_exp2f(sc[i][r] - mx); sc[i][r] = p; sum += p; }
        sum += __shfl_xor(sum, 32);
        const float denom = sum + __builtin_amdgcn_exp2f(sinkv - mx);
        if (hi == 0) scr[r32] = 1.0f / denom;
        f32x16 o[2]; o[0] = f32x16{}; o[1] = f32x16{};
#pragma unroll
        for (int i = 0; i < 5; ++i)
#pragma unroll
            for (int s2 = 0; s2 < 2; ++s2) {
                v4u pw; pw.x = cvt_pk_bf16(sc[i][8 * s2 + 0], sc[i][8 * s2 + 1]); pw.y = cvt_pk_bf16(sc[i][8 * s2 + 2], sc[i][8 * s2 + 3]);
                pw.z = cvt_pk_bf16(sc[i][8 * s2 + 4], sc[i][8 * s2 + 5]); pw.w = cvt_pk_bf16(sc[i][8 * s2 + 6], sc[i][8 * s2 + 7]);
                const bf16x8 pa = __builtin_bit_cast(bf16x8, pw);
                const int key0 = 32 * (tb + i) + 16 * s2 + 4 * hi;
#pragma unroll
                for (int dh = 0; dh < 2; ++dh) { const LAS unsigned char* vp = lds + L_VT + (32 * dh + r32) * VT_STRIDE + key0 * 2;
                    const s16x4 lo = *(const LAS s16x4*)vp, h4 = *(const LAS s16x4*)(vp + 16);
                    const bf16x8 vb = {lo[0], lo[1], lo[2], lo[3], h4[0], h4[1], h4[2], h4[3]};
                    o[dh] = __builtin_amdgcn_mfma_f32_32x32x16_bf16(pa, vb, o[dh], 0, 0, 0); } }
#pragma unroll
        for (int r = 0; r < 16; ++r) { const int orow = crow(r, hi); const float rl = scr[orow];
#pragma unroll
            for (int dh = 0; dh < 2; ++dh) stg[orow * 64 + dh * 32 + r32] = (unsigned short)(cvt_pk_bf16(o[dh][r] * rl, 0.f) & 0xffffu); }
        bf16* Ow = O + qtok * 1024 + hq * 64;
#pragma unroll
        for (int i = 0; i < 4; ++i) { const int row = i * 8 + (lane >> 3), ch = lane & 7; const v4u v = *(const LAS v4u*)(stg + row * 64 + ch * 8); *(v4u*)(Ow + (size_t)row * 1024 + ch * 8) = v; }
    }
    __syncthreads();
}
}

struct Args { const float* in[19]; float* out; unsigned char* ws; int ph_lo, ph_hi, li, pad; };

__global__ void __launch_bounds__(NWAVES * 64, 2) fwd_kernel(Args args) {
    extern __shared__ __attribute__((aligned(16))) unsigned char lds_raw[];
    LAS unsigned char* lds = (LAS unsigned char*)lds_raw;
    volatile LAS unsigned* MISC = (volatile LAS unsigned*)(lds + MISC_OFF);
    const int tid = threadIdx.x, lane = tid & 63, wave = __builtin_amdgcn_readfirstlane(tid >> 6);
    const int G = gridDim.x; const int bx = blockIdx.x; const int vcu = (G % 8 == 0) ? (bx % 8) * (G / 8) + bx / 8 : bx;
    unsigned char* ws = args.ws;
    gu32* ctl = (gu32*)(ws + WS_CTL);
    const float* x = args.in[0]; const float* g_mix = args.in[1]; const float* w_in = args.in[2]; const float* b_in = args.in[3]; const float* sinks = args.in[4];
    const float* w_conv = args.in[5]; const float* w_attn_o = args.in[6]; const float* w_conv_o = args.in[7]; const float* w_out = args.in[8]; const float* g_ffn = args.in[9];
    const float* w_router = args.in[10]; const float* b_router = args.in[11]; const float* w_gate = args.in[12]; const float* b_gate = args.in[13]; const float* w_up = args.in[14];
    const float* b_up = args.in[15]; const float* w_down = args.in[16]; const float* b_down = args.in[17]; const float* g_final = args.in[18];
    float* out = args.out;
    float* binp = (float*)(ws + WS_BINP); float* bgu = (float*)(ws + WS_BGU); float* cosT = (float*)(ws + WS_COS); float* sinT = (float*)(ws + WS_SIN);
    bf16* Win_t = (bf16*)(ws + WS_WIN); bf16* Wao_t = (bf16*)(ws + WS_WAO); bf16* Wco_t = (bf16*)(ws + WS_WCO); bf16* Wout_t = (bf16*)(ws + WS_WOUT);
    bf16* XN = (bf16*)(ws + WS_XN); bf16* Qb = (bf16*)(ws + WS_Q); bf16* Kb = (bf16*)(ws + WS_K); bf16* Vb = (bf16*)(ws + WS_V); bf16* CB = (bf16*)(ws + WS_CB);
    bf16* MG = (bf16*)(ws + WS_MG); bf16* Ub = (bf16*)(ws + WS_U); bf16* SA = (bf16*)(ws + WS_SA); bf16* SC = (bf16*)(ws + WS_SC);
    bf16* Wgu_t = (bf16*)(ws + WS_WGU); bf16* Wd_t = (bf16*)(ws + WS_WD);
    int* tokrel = (int*)(ws + WS_TOKREL); unsigned* route = (unsigned*)(ws + WS_ROUTE); float* routew = (float*)(ws + WS_ROUTEW);
    bf16* ACT = (bf16*)(ws + WS_ACT); bf16* Yb = (bf16*)(ws + WS_Y);

    for (int u = tid; u < (LDS_BYTES - LDSCTL_OFF) / 4; u += NWAVES * 64) ((LAS unsigned*)(lds + LDSCTL_OFF))[u] = 0u;
    __syncthreads();
    XcdBarrier bar; bar.bar = (unsigned*)(ctl + CW_BAR); bar.x = 0; bar.st = nullptr;
    if (N_LAUNCHES != PER_PHASE) bar = xcd_barrier_post((unsigned*)(ctl + CW_BAR), MISC + 8);
#define GRID_BAR(seam) do { if (N_LAUNCHES == PER_PHASE) { if (tid == 0) __hip_atomic_store(ctl + CW_TMO, 0xBADBA0u | (unsigned)(seam), RLX_AGENT); } else { xcd_barrier(bar); } } while (0)
    const int lo = args.ph_lo, hi = args.ph_hi;
#define IN(k) (lo <= (k) && (k) < hi)
#define BOTH(k) (IN(k) && IN((k) + 1))
    const int gw = vcu * NWAVES + wave, NGW = G * NWAVES;

    if (IN(0)) {
        LAS float* scr = (LAS float*)(lds + RING_OFF + wave * 16384);
        constexpr int I_IN = (D / 64) * (NIN / 32), I_SQ = (D / 64) * (D / 32);
        constexpr int NITEMS = I_IN + 3 * I_SQ + NEXP * 3 * I_SQ;
        for (int it = gw; it < NITEMS; it += NGW) {
            int r = it;
            if (r < I_IN) { p0_transpose_item(w_in, D, NIN, Win_t, 1, scr, r, lane); continue; } r -= I_IN;
            if (r < I_SQ) { p0_transpose_item(w_attn_o, D, D, Wao_t, 0, scr, r, lane); continue; } r -= I_SQ;
            if (r < I_SQ) { p0_transpose_item(w_conv_o, D, D, Wco_t, 0, scr, r, lane); continue; } r -= I_SQ;
            if (r < I_SQ) { p0_transpose_item(w_out, D, D, Wout_t, 0, scr, r, lane); continue; } r -= I_SQ;
            const int e = r / (3 * I_SQ), q = r % (3 * I_SQ), which = q / I_SQ, item = q % I_SQ;
            if (which == 0) p0_transpose_item(w_gate + (size_t)e * D * DFF, D, DFF, Wgu_t + (size_t)e * 2048 * 1024, 2, scr, item, lane);
            else if (which == 1) p0_transpose_item(w_up + (size_t)e * D * DFF, D, DFF, Wgu_t + (size_t)e * 2048 * 1024, 3, scr, item, lane);
            else p0_transpose_item(w_down + (size_t)e * DFF * D, DFF, D, Wd_t + (size_t)e * 1024 * 1024, 0, scr, item, lane);
        }
        const int gt = vcu * (NWAVES * 64) + tid, NGT = G * NWAVES * 64;
        for (int c = gt; c < NIN; c += NGT) binp[win_dest(c)] = b_in[c];
        for (int i = gt; i < NEXP * DFF; i += NGT) { const int e = i >> 10, c = i & 1023; bgu[e * 2048 + map_dest(2, c)] = b_gate[i]; bgu[e * 2048 + map_dest(3, c)] = b_up[i]; }
        for (int i = gt; i < SEQ * 32; i += NGT) { const int pos = i >> 5, f = i & 31;
            const double inv = exp2(-(double)f * (13.287712379549449 / 32.0));
            const double rev = (double)pos * inv * 0.15915494309189535; const float fr = (float)(rev - rint(rev));
            cosT[i] = __builtin_amdgcn_cosf(fr); sinT[i] = __builtin_amdgcn_sinf(fr); }
        for (int m = gw; m < M; m += NGW) rms_row_to_bf16(x + (size_t)m * D, g_mix, XN + (size_t)m * D, lane);
        if (BOTH(0)) GRID_BAR(0);
    }

    if (IN(1)) {
        DenseOrder S{M / 256, NIN / 256, G, bx, D, (const char*)XN, (const char*)Win_t};
        EpiInProj E{Qb, Kb, Vb, CB, Ub, SA, SC, binp, cosT, sinT};
        pg8::gemm_phase<EpiInProj, DenseOrder, true, false>(lds + RING_OFF, D, S, E);
        if (BOTH(1)) GRID_BAR(1);
    }

    if (IN(2)) {
        for (int uu = vcu; uu < BATCH * NKVH * (SEQ / 128); uu += G) { const int n = uu & 63, kvh = (uu >> 6) & 3, b = uu >> 8;
            att::attn_unit(lds + RING_OFF, b, kvh, n, Qb, Kb, Vb, Qb, sinks); }
        for (int ch = vcu; ch < M / 64; ch += G) {
            const int c0 = (tid & 127) * 8, row0 = ch * 64 + (tid >> 7) * 16, pos0 = row0 & (SEQ - 1);
            float w0[8], w1[8], w2[8];
#pragma unroll
            for (int q = 0; q < 8; ++q) { w0[q] = w_conv[c0 + q]; w1[q] = w_conv[1024 + c0 + q]; w2[q] = w_conv[2048 + c0 + q]; }
            v4u um2 = {0u, 0u, 0u, 0u}, um1 = {0u, 0u, 0u, 0u};
            if (pos0 >= 2) { um2 = *(const v4u*)(Ub + (size_t)(row0 - 2) * 1024 + c0); um1 = *(const v4u*)(Ub + (size_t)(row0 - 1) * 1024 + c0); }
#pragma unroll 4
            for (int r = 0; r < 16; ++r) { const size_t off = (size_t)(row0 + r) * 1024 + c0;
                const v4u u0 = *(const v4u*)(Ub + off), cb = *(const v4u*)(CB + off); v4u o;
#define CONV2(F, qa) cvt_pk_bf16(bf_lo(cb.F) * (w0[qa] * bf_lo(um2.F) + w1[qa] * bf_lo(um1.F) + w2[qa] * bf_lo(u0.F)), bf_hi(cb.F) * (w0[qa + 1] * bf_hi(um2.F) + w1[qa + 1] * bf_hi(um1.F) + w2[qa + 1] * bf_hi(u0.F)))
                o.x = CONV2(x, 0); o.y = CONV2(y, 2); o.z = CONV2(z, 4); o.w = CONV2(w, 6);
#undef CONV2
                *(v4u*)(CB + off) = o; um2 = um1; um1 = u0; }
        }
        if (BOTH(2)) GRID_BAR(2);
    }

    if (IN(3)) {
        MergeOrder S{M / 256, D / 256, G, bx, D, (const char*)Qb, (const char*)Wao_t, (const char*)CB, (const char*)Wco_t};
        EpiMerge E{SA, SC, MG};
        pg8::gemm_phase<EpiMerge, MergeOrder, true, false>(lds + RING_OFF, D, S, E);
        if (BOTH(3)) GRID_BAR(3);
    }

    if (IN(4)) {
        DenseOrder S{M / 256, D / 256, G, bx, D, (const char*)MG, (const char*)Wout_t};
        EpiRes E{x, out};
        pg8::gemm_phase<EpiRes, DenseOrder, false, false>(lds + RING_OFF, D, S, E);
        if (BOTH(4)) GRID_BAR(4);
    }

    if (IN(5)) {
        LAS float* wT = (LAS float*)(lds + RING_OFF);
        for (int k = 0; k < 16; ++k) { const int idx = tid + 512 * k, c = idx & 1023, e4 = idx >> 10; const f32x4 v = *(const f32x4*)(w_router + (size_t)c * 32 + e4 * 4);
            wT[(e4 * 4 + 0) * 1024 + c] = v.x; wT[(e4 * 4 + 1) * 1024 + c] = v.y; wT[(e4 * 4 + 2) * 1024 + c] = v.z; wT[(e4 * 4 + 3) * 1024 + c] = v.w; }
        LAS int* lcnt = (LAS int*)(lds + TOK_OFF); LAS int* lbase = lcnt + 32; LAS unsigned* ce = (LAS unsigned*)(lds + TOK_OFF + 256); LAS int* cr = (LAS int*)(lds + TOK_OFF + 256 + 1024); LAS float* cw = (LAS float*)(lds + TOK_OFF + 256 + 2048);
        const int EL = ((lane & 1) << 4) | ((lane & 2) << 2) | (lane & 4) | ((lane & 8) >> 2) | ((lane & 16) >> 4);
        const float brt = b_router[EL];
        f32x4 gf[4];
#pragma unroll
        for (int j = 0; j < 4; ++j) gf[j] = *(const f32x4*)(g_ffn + 4 * lane + 256 * j);
        for (int ch = vcu; ch < M / 64; ch += G) {
            if (tid < 32) lcnt[tid] = 0;
            __syncthreads();
#pragma unroll 1
            for (int rr = 0; rr < 8; ++rr) {
                const int tl = wave * 8 + rr, t = ch * 64 + tl;
                f32x4 h[4]; float s = 0.f;
#pragma unroll
                for (int j = 0; j < 4; ++j) { h[j] = *(const f32x4*)(out + (size_t)t * D + 4 * lane + 256 * j); s += (h[j].x * h[j].x + h[j].y * h[j].y) + (h[j].z * h[j].z + h[j].w * h[j].w); }
                const float rstd = 1.f / sqrtf(wave_sum(s) * (1.f / D) + RMS_EPS);
#pragma unroll
                for (int j = 0; j < 4; ++j) { h[j] = h[j] * rstd * gf[j]; v2u w; w.x = cvt_pk_bf16(h[j].x, h[j].y); w.y = cvt_pk_bf16(h[j].z, h[j].w); *(v2u*)(XN + (size_t)t * D + 4 * lane + 256 * j) = w; }
                float v[32];
#pragma unroll
                for (int e = 0; e < 32; ++e) { float a = 0.f;
#pragma unroll
                    for (int j = 0; j < 4; ++j) { const f32x4 w4 = *(const LAS f32x4*)(wT + e * 1024 + 4 * lane + 256 * j); a += (h[j].x * w4.x + h[j].y * w4.y) + (h[j].z * w4.z + h[j].w * w4.w); }
                    v[e] = a; }
#define BFLY(NV, MK) _Pragma("unroll") for (int i = 0; i < NV; ++i) { const bool up = (lane & MK) != 0; const float send = up ? v[i] : v[i + NV], keep = up ? v[i + NV] : v[i]; v[i] = keep + __shfl_xor(send, MK); }
                BFLY(16, 1) BFLY(8, 2) BFLY(4, 4) BFLY(2, 8) BFLY(1, 16)
#undef BFLY
                float lg = v[0] + __shfl_xor(v[0], 32) + brt;
                int te[4]; float tlg[4];
#pragma unroll
                for (int k = 0; k < 4; ++k) { const float mx = wave_max(lg); const int sel = wave_min_i(lg == mx ? EL : 64); te[k] = sel; tlg[k] = mx; if (EL == sel) lg = -INFINITY; }
                const float e1 = __expf(tlg[1] - tlg[0]), e2 = __expf(tlg[2] - tlg[0]), e3 = __expf(tlg[3] - tlg[0]), inv = 1.0f / (1.0f + e1 + e2 + e3);
                if (lane < 4) { const int ek = lane == 0 ? te[0] : lane == 1 ? te[1] : lane == 2 ? te[2] : te[3]; const float wk = (lane == 0 ? 1.0f : lane == 1 ? e1 : lane == 2 ? e2 : e3) * inv;
                    const int r = atomicAdd((int*)(lcnt + ek), 1); ce[tl * 4 + lane] = (unsigned)ek; cr[tl * 4 + lane] = r; cw[tl * 4 + lane] = wk; }
            }
            __syncthreads();
            if (tid < 32) lbase[tid] = (int)__hip_atomic_fetch_add(ctl + CW_CURSOR + 64 * tid, (unsigned)lcnt[tid], RLX_AGENT);
            __syncthreads();
            if (tid < 256) { const int t = ch * 64 + (tid >> 2); const unsigned e = ce[tid]; const int rel = lbase[e] + cr[tid];
                tokrel[e * SLOTCAP + rel] = t; route[t * 4 + (tid & 3)] = e | ((unsigned)rel << 8); routew[t * 4 + (tid & 3)] = cw[tid]; }
            __syncthreads();
        }
        if (BOTH(5)) GRID_BAR(5);
    }

    LAS int* t_cnt = (LAS int*)(lds + TAB_CNT); LAS int* t_start = (LAS int*)(lds + TAB_TSTART); LAS int* t_tile = (LAS int*)(lds + TAB_TILEE);
    if (IN(6) || IN(7) || IN(8)) {
        if (tid < 32) t_cnt[tid] = (int)__hip_atomic_load(ctl + CW_CURSOR + 64 * tid, RLX_AGENT);
        __syncthreads();
        if (tid == 0) { int s = 0; for (int e = 0; e < 32; ++e) { t_start[e] = s; s += (t_cnt[e] + 255) >> 8; } t_start[32] = s; }
        __syncthreads();
        for (int i = tid; i < 320; i += 512) { int e = 0; for (int k = 1; k < 32; ++k) if (i >= t_start[k]) e = k; t_tile[i] = e; }
        __syncthreads();
    }
    const int MT = (IN(6) || IN(7) || IN(8)) ? t_start[32] : 0;

    if (IN(6)) {
        LAS unsigned* tokt = (LAS unsigned*)(lds + TOK_OFF);
        GroupOrder S{MT, 2048 / 256, G, bx, D, (const char*)XN, (const char*)Wgu_t, (size_t)2048 * 1024 * 2, true, t_tile, tokt};
        for (int i0 = 0; i0 < MAXU; i0 += 2) { const int i = i0 + (tid >> 8), r = tid & 255; pg8::Unit u;
            if (i < MAXU && S.next(i, u)) { const int e = u.e, rel = (u.pm - t_start[e]) * 256 + r; const int tok = rel < t_cnt[e] ? tokrel[e * SLOTCAP + rel] : 0; tokt[i * 256 + r] = (unsigned)tok * 2048u; } }
        __syncthreads();
        EpiGU E{ACT, bgu};
        pg8::gemm_phase<EpiGU, GroupOrder, true, true>(lds + RING_OFF, D, S, E);
        if (BOTH(6)) GRID_BAR(6);
    }

    if (IN(7)) {
        GroupOrder S{MT, 1024 / 256, G, bx, DFF, (const char*)ACT, (const char*)Wd_t, (size_t)1024 * 1024 * 2, false, t_tile, (const LAS unsigned*)(lds + TOK_OFF)};
        EpiDown E{Yb, b_down};
        pg8::gemm_phase<EpiDown, GroupOrder, true, false>(lds + RING_OFF, DFF, S, E);
        if (BOTH(7)) GRID_BAR(7);
    }

    if (IN(8)) {
        f32x4 gf[4];
#pragma unroll
        for (int j = 0; j < 4; ++j) gf[j] = *(const f32x4*)(g_final + 4 * lane + 256 * j);
        for (int t = gw; t < M; t += NGW) {
            f32x4 a[4];
#pragma unroll
            for (int j = 0; j < 4; ++j) a[j] = *(const f32x4*)(out + (size_t)t * D + 4 * lane + 256 * j);
#pragma unroll
            for (int k = 0; k < 4; ++k) { const unsigned rt = route[t * 4 + k]; const float w = routew[t * 4 + k]; const int e = rt & 255u, rel = rt >> 8;
                const bf16* yr = Yb + ((size_t)t_start[e] * 256 + rel) * 1024 + 4 * lane;
#pragma unroll
                for (int j = 0; j < 4; ++j) { const v2u y = *(const v2u*)(yr + 256 * j); a[j].x += w * bf_lo(y.x); a[j].y += w * bf_hi(y.x); a[j].z += w * bf_lo(y.y); a[j].w += w * bf_hi(y.y); } }
            float s = 0.f;
#pragma unroll
            for (int j = 0; j < 4; ++j) s += (a[j].x * a[j].x + a[j].y * a[j].y) + (a[j].z * a[j].z + a[j].w * a[j].w);
            const float rstd = 1.f / sqrtf(wave_sum(s) * (1.f / D) + RMS_EPS);
#pragma unroll
            for (int j = 0; j < 4; ++j) *(f32x4*)(out + (size_t)t * D + 4 * lane + 256 * j) = a[j] * rstd * gf[j];
        }
    }
#undef IN
#undef BOTH
#undef GRID_BAR
}

extern "C" void kernel_launch(void* const* d_in, const int* in_sizes, int n_in, void* d_out, int out_size, void* d_ws, size_t ws_size, hipStream_t stream) {
    static int grid = 0;
    if (grid == 0) {
        if (n_in != 19 || in_sizes[0] != M * D || out_size != M * D || ws_size < WS_END) { fprintf(stderr, "kernel_launch: unexpected shapes (n_in %d, in0 %d, out %d, ws %zu)\n", n_in, n_in > 0 ? in_sizes[0] : -1, out_size, ws_size); grid = -1; return; }
        int dev = 0, cus = 0, per_cu = 0;
        if (hipGetDevice(&dev) != hipSuccess || hipDeviceGetAttribute(&cus, hipDeviceAttributeMultiprocessorCount, dev) != hipSuccess) { grid = -1; return; }
        if (hipFuncSetAttribute((const void*)fwd_kernel, hipFuncAttributeMaxDynamicSharedMemorySize, LDS_BYTES) != hipSuccess) { fprintf(stderr, "kernel_launch: hipFuncSetAttribute failed\n"); grid = -1; return; }
        if (hipOccupancyMaxActiveBlocksPerMultiprocessor(&per_cu, (const void*)fwd_kernel, NWAVES * 64, LDS_BYTES) != hipSuccess || per_cu < 1)
            fprintf(stderr, "kernel_launch: note: occupancy query reports %d workgroups per CU\n", per_cu);
        (void)hipGetLastError();
        grid = cus;
    }
    if (grid < 0) return;
    if (hipMemsetAsync((char*)d_ws + WS_CTL, 0, CTL_ZERO_BYTES, stream) != hipSuccess) { fprintf(stderr, "kernel_launch: hipMemsetAsync failed\n"); return; }
    Args a{};
    for (int i = 0; i < 19; ++i) a.in[i] = (const float*)d_in[i];
    a.out = (float*)d_out; a.ws = (unsigned char*)d_ws;
    for (int li = 0; li < N_LAUNCHES; ++li) {
        a.ph_lo = (N_LAUNCHES == PER_PHASE) ? li : 0; a.ph_hi = (N_LAUNCHES == PER_PHASE) ? li + 1 : PER_PHASE; a.li = li;
        hipLaunchKernelGGL(fwd_kernel, dim3(grid), dim3(NWAVES * 64), LDS_BYTES, stream, a);
        const hipError_t le = hipPeekAtLastError();
        if (le != hipSuccess) { fprintf(stderr, "kernel_launch: launch %d failed: %s\n", li, hipGetErrorName(le)); break; }
    }
}
```

```cpp
#include <hip/hip_runtime.h>
#include <cstdio>
#include <cstdint>

#ifndef MK_N_LAUNCHES
#define MK_N_LAUNCHES 1
#endif

#ifndef MOE_MERGED
#define MOE_MERGED 0
#endif
#ifndef RELAX_POST_EPI
#define RELAX_POST_EPI 0
#endif
#ifndef STAGGER_US
#define STAGGER_US 0
#endif
#ifndef P7_REVERSE
#define P7_REVERSE 0
#endif
#ifndef KEEP_WD
#define KEEP_WD 0
#endif
#ifndef P5_MFMA
#define P5_MFMA 1
#endif
#ifndef PF_P6
#define PF_P6 0
#endif
#ifndef PF_P7
#define PF_P7 0
#endif
#ifndef KV_PREFETCH
#define KV_PREFETCH 0
#endif
#ifndef CONV_INLINE
#define CONV_INLINE 1
#endif
#ifndef HALF_TAIL
#define HALF_TAIL 1
#endif
#ifndef DBG_TIME_PH
#define DBG_TIME_PH (-1)
#endif
#ifndef DBG_KLOOP_PH
#define DBG_KLOOP_PH (-1)
#endif
#ifndef DBG_RVR_PH
#define DBG_RVR_PH (-1)
#endif
namespace pg8 {
#define PG8_LAS __attribute__((address_space(3)))
typedef unsigned short bf16_t;
typedef short bf16x8 __attribute__((ext_vector_type(8)));
typedef float f32x4 __attribute__((ext_vector_type(4)));
typedef unsigned u32x4 __attribute__((ext_vector_type(4)));
typedef unsigned u32x2 __attribute__((ext_vector_type(2)));
constexpr int BM = 256, BK = 64, HALF = 128, HTB = HALF * BK * 2  , STAGE_BYTES = 8 * HTB, NXCD = 8;
constexpr int PFD = 6;
constexpr int PF_LDS_OFF = 150016 + 4096;
constexpr int BIAS_LDS_OFF = 150016;

__host__ __device__ __forceinline__ int lds_byte(int r, int c) { const int st = (r >> 4) * 2 + (c >> 5), rr = r & 15, cc = c & 31, ob = rr * 64 + cc * 2; return st * 1024 + (ob ^ (((ob >> 9) & 1) << 5)); }
__host__ __device__ __forceinline__ void stage_rc(int b, int& R, int& C) { const int st = b / 1024, sb = b % 1024, swz = sb ^ (((sb >> 9) & 1) << 5); R = (st >> 1) * 16 + swz / 64; C = (st & 1) * 32 + (swz % 64) / 2; }
__host__ __device__ __forceinline__ int perm32(int rho) { const int n = rho >> 4, i = rho & 15; return 8 * (i >> 2) + 4 * n + (i & 3); }

struct Unit { int pm, pn, e, aux; bool keep; const char* a; const char* b; int rofs; };

#ifndef WGM_DENSE
#define WGM_DENSE 4
#endif
#ifndef WGM_MOE
#define WGM_MOE 4
#endif
#ifndef WGM_MOE2
#define WGM_MOE2 4
#endif
__host__ __device__ __forceinline__ bool tile_of(long L, int nM, int nN, int& pm, int& pn, const int WGM = WGM_DENSE) {
    const int nwg = nM * nN; if (L >= nwg) return false;
    int wgid = (int)L; { const int q = nwg / NXCD, r = nwg % NXCD, xcd = wgid % NXCD, off = wgid / NXCD; wgid = (xcd < r ? xcd * (q + 1) : r * (q + 1) + (xcd - r) * q) + off; }
    const int nig = WGM * nN, gid = wgid / nig, fm = gid * WGM, gsz = (nM - fm) < WGM ? (nM - fm) : WGM;
    pm = fm + ((wgid % nig) % gsz); pn = (wgid % nig) / gsz; return true;
}

__device__ __forceinline__ unsigned cvt_pk_bf16(float lo, float hi) { unsigned r; asm volatile("v_cvt_pk_bf16_f32 %0, %1, %2" : "=v"(r) : "v"(lo), "v"(hi)); return r; }
__device__ __forceinline__ float bf_lo(unsigned w) { return __uint_as_float(w << 16); }
__device__ __forceinline__ float bf_hi(unsigned w) { return __uint_as_float(w & 0xffff0000u); }
__device__ __forceinline__ float sigmoidf_(float x) { return __builtin_amdgcn_rcpf(1.0f + __builtin_amdgcn_exp2f(x * -1.4426950408889634f)); }

template <class Epi, class Sched, bool ALIGN_EPI, bool GATHER, bool HALFM = false, bool PF = false>
__device__ __forceinline__ void gemm_phase(PG8_LAS unsigned char* lds, const int K, const Sched& S, const Epi& E, unsigned* dbg = nullptr) {
    const int tid = threadIdx.x, wid = __builtin_amdgcn_readfirstlane(tid >> 6), lane = tid & 63, wr = wid >> 2, wc = wid & 3, fr = lane & 15, fq = lane >> 4;
    const int nt = K / BK;
    unsigned voffA[2], voffB[2]; int RA[2]; unsigned CA2[2];
#pragma unroll
    for (int i = 0; i < 2; ++i) { int R, C; stage_rc(tid * 16 + i * 8192, R, C); const int Rb = Epi::PERM ? ((R & ~31) + perm32(R & 31)) : R;
        voffA[i] = (unsigned)(R * K + C) * 2u; voffB[i] = (unsigned)(Rb * K + C) * 2u; RA[i] = R; CA2[i] = (unsigned)C * 2u; }
    const size_t kstep = (size_t)(BK * 2);
    const size_t hstep = (size_t)HALF * K * 2;
    const unsigned ldsw = (unsigned)wid * 1024u;
    const int aoff = lds_byte(wr * 64 + fr, fq * 8), boff = lds_byte(wc * 32 + fr, fq * 8);
#define PG8_SA(b, h) (((b) * 2 + (h)) * HTB)
#define PG8_SB(b, h) ((4 + (b) * 2 + (h)) * HTB)
#define PG8_GLDS(src, dstoff) __builtin_amdgcn_global_load_lds((const unsigned*)(src), (PG8_LAS unsigned*)(lds + (dstoff)), 16, 0, 0)
#define PG8_STAGE_B(bufoff, gbase) do { PG8_GLDS((const char*)(gbase) + voffB[0], (bufoff) + ldsw); PG8_GLDS((const char*)(gbase) + voffB[1], (bufoff) + ldsw + 8192); } while (0)
#define PG8_STAGE_A(bufoff, gbase, h, o0, o1) do { \
        if constexpr (GATHER) { PG8_GLDS((const char*)(gbase) + (o0), (bufoff) + ldsw); PG8_GLDS((const char*)(gbase) + (o1), (bufoff) + ldsw + 8192); } \
        else { PG8_GLDS((const char*)(gbase) + (h) * hstep + voffA[0], (bufoff) + ldsw); PG8_GLDS((const char*)(gbase) + (h) * hstep + voffA[1], (bufoff) + ldsw + 8192); } } while (0)
#define PG8_LDA(dst, b, h) do { _Pragma("unroll") for (int m = 0; m < 4; ++m) _Pragma("unroll") for (int k = 0; k < 2; ++k) dst[m][k] = *(const PG8_LAS bf16x8*)(lds + PG8_SA(b, h) + aoff + m * 2048 + k * 1024); } while (0)
#define PG8_LDB(dst, b, h) do { _Pragma("unroll") for (int n = 0; n < 2; ++n) _Pragma("unroll") for (int k = 0; k < 2; ++k) dst[n][k] = *(const PG8_LAS bf16x8*)(lds + PG8_SB(b, h) + boff + n * 2048 + k * 1024); } while (0)
#define PG8_MMA(ai, bj, At, Bt) do { __builtin_amdgcn_s_setprio(1); _Pragma("unroll") for (int m = 0; m < 4; ++m) _Pragma("unroll") for (int n = 0; n < 2; ++n) _Pragma("unroll") for (int k = 0; k < 2; ++k) \
        acc[ai][bj][m][n] = __builtin_amdgcn_mfma_f32_16x16x32_bf16(Bt[n][k], At[m][k], acc[ai][bj][m][n], 0, 0, 0); __builtin_amdgcn_s_setprio(0); } while (0)
#define PG8_WAIT_V(n) asm volatile("s_waitcnt vmcnt(" #n ")" ::: "memory")
#define PG8_WAIT_VK do { if constexpr (PF) PG8_WAIT_V(9); else PG8_WAIT_V(8); } while (0)
#define PG8_WAIT_L(n) asm volatile("s_waitcnt lgkmcnt(" #n ")" ::: "memory")
#define PG8_BAR __builtin_amdgcn_s_barrier()
#define PG8_SCHED __builtin_amdgcn_sched_barrier(0)
#define PG8_BIAS_STAGE(u_, par_) do { const float* bp_ = wid < 4 ? E.bias_row(u_) : E.aux_row(u_); if (bp_ != nullptr) \
        __builtin_amdgcn_global_load_lds((const unsigned*)(bp_ + (wid & 3) * 64 + lane), (PG8_LAS unsigned*)(lds + BIAS_LDS_OFF + (par_) * 2048 + wid * 256), 4, 0, 0); } while (0)
    Unit cur, nxt, prv; int ui = 0; unsigned dbg_acc = 0;
    if (!S.next(0, cur)) return;
    prv = cur;
    f32x4 acc[2][2][4][2];
#pragma unroll
    for (int a = 0; a < 2; ++a)
#pragma unroll
        for (int b = 0; b < 2; ++b)
#pragma unroll
            for (int m = 0; m < 4; ++m)
#pragma unroll
                for (int n = 0; n < 2; ++n) acc[a][b][m][n] = (f32x4){0.f, 0.f, 0.f, 0.f};
    bf16x8 At[4][2], B0[2][2], B1[2][2];
    unsigned gA00 = 0, gA01 = 0, gA10 = 0, gA11 = 0, gN00 = 0, gN01 = 0, gN10 = 0, gN11 = 0;
    if constexpr (GATHER) { gA00 = S.tokoff(0, RA[0]) + CA2[0]; gA01 = S.tokoff(0, RA[1]) + CA2[1]; gA10 = S.tokoff(0, HALF + RA[0]) + CA2[0]; gA11 = S.tokoff(0, HALF + RA[1]) + CA2[1]; }
    const char* cA = cur.a; const char* cB = cur.b;
    const int pfrow = wid * 32 + (lane & 31);
#define PG8_PFPTR(u_, ui_) ((lane < 32) ? (u_).b + (size_t)pfrow * K * 2 : (GATHER ? (u_).a + S.tokoff((ui_), pfrow) : (u_).a + (size_t)pfrow * K * 2))
#define PG8_PF(kt_) do { if constexpr (PF) { const int k_ = (kt_); const char* p_ = k_ < nt ? pfc + (size_t)k_ * kstep : pfn + (size_t)(k_ - nt) * kstep; \
        __builtin_amdgcn_global_load_lds((const unsigned*)p_, (PG8_LAS unsigned*)(lds + PF_LDS_OFF + wid * 256), 4, 0, 0); } } while (0)
    const char* pfc = nullptr; const char* pfn = nullptr;
    if constexpr (PF) { pfc = PG8_PFPTR(cur, 0); pfn = pfc; }
    S.a_ready(cur);
    PG8_BIAS_STAGE(cur, 0);
    PG8_STAGE_B(PG8_SB(0, 0), cB); PG8_STAGE_B(PG8_SB(0, 1), cB + hstep); PG8_STAGE_A(PG8_SA(0, 0), cA, 0, gA00, gA01); PG8_STAGE_A(PG8_SA(0, 1), cA, 1, gA10, gA11);
    if (wr == 1) PG8_BAR;
    PG8_WAIT_V(2); PG8_BAR;
    PG8_STAGE_B(PG8_SB(1, 0), cB + kstep); PG8_STAGE_A(PG8_SA(1, 0), cA + kstep, 0, gA00, gA01); PG8_STAGE_B(PG8_SB(1, 1), cB + hstep + kstep);
    PG8_WAIT_V(6); PG8_BAR;
    PG8_PF(PFD);
    for (;;) {
        const bool has_next = S.next(ui + 1, nxt);
        if constexpr (GATHER) { if (has_next) { gN00 = S.tokoff(ui + 1, RA[0]) + CA2[0]; gN01 = S.tokoff(ui + 1, RA[1]) + CA2[1]; gN10 = S.tokoff(ui + 1, HALF + RA[0]) + CA2[0]; gN11 = S.tokoff(ui + 1, HALF + RA[1]) + CA2[1]; } }
        const char* nA = has_next ? nxt.a : cA; const char* nB = has_next ? nxt.b : cB;
        if constexpr (PF) { pfn = has_next ? PG8_PFPTR(nxt, ui + 1) : pfc; }
        unsigned dbg_t0 = 0; if (DBG_KLOOP_PH >= 0 && dbg) dbg_t0 = (unsigned)__builtin_amdgcn_s_memrealtime();
        for (int t = 0; t < nt; t += 2) {
            const bool last = (t == nt - 2);
            const char* a1 = cA + (size_t)(t + 1) * kstep;
            const char* a2 = last ? nA : cA + (size_t)(t + 2) * kstep; const char* b2 = last ? nB : cB + (size_t)(t + 2) * kstep;
            const char* a3 = a2 + kstep; const char* b3 = b2 + kstep;
            unsigned s00 = gA00, s01 = gA01, s10 = gA10, s11 = gA11;
            if constexpr (GATHER) { if (last && has_next) { s00 = gN00; s01 = gN01; s10 = gN10; s11 = gN11; } }
            if (last && has_next) S.a_ready(nxt);
            PG8_LDB(B0, 0, 0); PG8_LDB(B1, 0, 1); PG8_SCHED; PG8_LDA(At, 0, 0); PG8_STAGE_A(PG8_SA(1, 1), a1, 1, gA10, gA11);
            PG8_WAIT_VK; PG8_WAIT_L(0); PG8_BAR; PG8_MMA(0, 0, At, B0); PG8_MMA(0, 1, At, B1); PG8_BAR; PG8_SCHED;
            if constexpr (!HALFM) PG8_LDA(At, 0, 1);
            PG8_STAGE_B(PG8_SB(0, 0), b2); PG8_STAGE_B(PG8_SB(0, 1), b2 + hstep); PG8_STAGE_A(PG8_SA(0, 0), a2, 0, s00, s01); PG8_PF(t + 1 + PFD);
            PG8_WAIT_VK; PG8_WAIT_L(0); PG8_BAR; if constexpr (!HALFM) { PG8_MMA(1, 0, At, B0); PG8_MMA(1, 1, At, B1); } PG8_BAR; PG8_SCHED;
            PG8_LDB(B0, 1, 0); PG8_LDB(B1, 1, 1); PG8_SCHED; PG8_LDA(At, 1, 0); PG8_STAGE_A(PG8_SA(0, 1), a2, 1, s10, s11);
            PG8_WAIT_VK; PG8_WAIT_L(0); PG8_BAR; PG8_MMA(0, 0, At, B0); PG8_MMA(0, 1, At, B1); PG8_BAR; PG8_SCHED;
            if constexpr (!HALFM) PG8_LDA(At, 1, 1);
            PG8_STAGE_B(PG8_SB(1, 0), b3); PG8_STAGE_B(PG8_SB(1, 1), b3 + hstep); PG8_STAGE_A(PG8_SA(1, 0), a3, 0, s00, s01); PG8_PF(t + 2 + PFD);
            PG8_WAIT_VK; PG8_WAIT_L(0); PG8_BAR; if constexpr (!HALFM) { PG8_MMA(1, 0, At, B0); PG8_MMA(1, 1, At, B1); } PG8_BAR; PG8_SCHED;
        }
        if (DBG_KLOOP_PH >= 0 && dbg) { dbg_acc += (unsigned)__builtin_amdgcn_s_memrealtime() - dbg_t0; }
        if constexpr (ALIGN_EPI) { if (wr == 0) PG8_BAR; }
        if (MOE_MERGED && ui > 0) S.done(prv);
        E(acc, cur, wr, wc, fr, fq, (const PG8_LAS float*)(lds + BIAS_LDS_OFF + (ui & 1) * 2048));
        if (has_next) PG8_BIAS_STAGE(nxt, (ui + 1) & 1);
        if (MOE_MERGED) prv = cur;
        if (!has_next) break;
        if (!cur.keep) {
#pragma unroll
            for (int a = 0; a < 2; ++a)
#pragma unroll
                for (int b = 0; b < 2; ++b)
#pragma unroll
                    for (int m = 0; m < 4; ++m)
#pragma unroll
                        for (int n = 0; n < 2; ++n) acc[a][b][m][n] = (f32x4){0.f, 0.f, 0.f, 0.f};
        }
        cur = nxt; cA = nA; cB = nB; ++ui; if constexpr (PF) pfc = pfn;
        if constexpr (GATHER) { gA00 = gN00; gA01 = gN01; gA10 = gN10; gA11 = gN11; }
        if constexpr (ALIGN_EPI) { if (wr == 1) PG8_BAR; }
    }
    PG8_WAIT_V(0);
    if (DBG_KLOOP_PH >= 0 && dbg && threadIdx.x == 0) { dbg[0] = 0u; dbg[1] = dbg_acc; }
    if (MOE_MERGED) S.done(prv);
    if constexpr (!ALIGN_EPI) { if (wr == 0) PG8_BAR; }
    PG8_BAR;
#undef PG8_BIAS_STAGE
#undef PG8_PFPTR
#undef PG8_PF
#undef PG8_WAIT_VK
#undef PG8_SA
#undef PG8_SB
#undef PG8_GLDS
#undef PG8_STAGE_A
#undef PG8_STAGE_B
#undef PG8_LDA
#undef PG8_LDB
#undef PG8_MMA
#undef PG8_WAIT_V
#undef PG8_WAIT_L
#undef PG8_BAR
#undef PG8_SCHED
}
}

constexpr int NWAVES = 8;
constexpr int N_LAUNCHES = MK_N_LAUNCHES;
constexpr int PER_PHASE = 9;
constexpr int BATCH = 2, SEQ = 8192, D = 1024, M = BATCH * SEQ, HD = 64, NQH = 16, NKVH = 4, KVW = 256;
constexpr int NIN = 6656, NEXP = 32, TOPK = 4, DFF = 1024;
constexpr float RMS_EPS = 1e-5f;
constexpr float QSCALE = 0.125f * 1.4426950408889634f;
constexpr float LOG2E = 1.4426950408889634f;
constexpr int MAXTILES = 288;
constexpr int SLOTCAP = 16384;
constexpr int HELPER_CUS = 0;
constexpr int MAXU = 16;

constexpr size_t MiB = 1u << 20;
constexpr size_t WS_CTL = 0, CTL_ZERO_BYTES = MOE_MERGED ? 1 * MiB : 64 * 1024;
constexpr size_t WS_BINP = 1 * MiB;
constexpr size_t WS_BGU = 1 * MiB + 64 * 1024;
constexpr size_t WS_COS = 2 * MiB, WS_SIN = 3 * MiB;
constexpr size_t WS_WIN = 4 * MiB;
constexpr size_t WS_WAO = 17 * MiB, WS_WCO = 19 * MiB, WS_WOUT = 21 * MiB;
constexpr size_t WS_XN = 24 * MiB;
constexpr size_t WS_Q = 56 * MiB, WS_K = 88 * MiB, WS_V = 96 * MiB, WS_CB = 104 * MiB, WS_MG = 136 * MiB, WS_U = 168 * MiB, WS_SA = 200 * MiB, WS_SC = 232 * MiB;
constexpr size_t WS_WGU = 264 * MiB;
constexpr size_t WS_WD = 392 * MiB;
constexpr size_t WS_TOKREL = 456 * MiB;
constexpr size_t WS_ROUTE = 458 * MiB;
constexpr size_t WS_ROUTEW = 459 * MiB;
constexpr size_t WS_ACT = 56 * MiB;
constexpr size_t WS_Y = 200 * MiB;
constexpr size_t WS_RSTDREL = 460 * MiB;
constexpr size_t WS_DL = 464 * MiB;
constexpr size_t WS_END = 496 * MiB;
static_assert(WS_ACT + (size_t)MAXTILES * 256 * 2048 <= WS_Y && WS_Y + (size_t)MAXTILES * 256 * 2048 <= WS_WD, "MoE overlays");
constexpr int CW_TMO = 0;
constexpr int CW_TS = 512;
constexpr int CW_CURSOR = 1024;
constexpr int CW_BAR = 4096;
constexpr int CW_MT = 16384;
#define XCD_BAR_WORDS_C 3456
static_assert(CW_BAR + 3 * XCD_BAR_WORDS_C <= CW_MT && (CW_BAR + 3 * XCD_BAR_WORDS_C) * 4 <= 64 * 1024 && (!MOE_MERGED || (CW_MT + 64 * MAXTILES) * 4 <= (int)CTL_ZERO_BYTES), "CTL");

constexpr int RING_OFF = 0, RING_BYTES = 131072;
constexpr int LDSCTL_OFF = RING_BYTES, MISC_OFF = LDSCTL_OFF + 320;
constexpr int TAB_OFF = RING_BYTES + 512;
constexpr int TAB_CNT = TAB_OFF, TAB_TSTART = TAB_OFF + 128, TAB_TILEE = TAB_OFF + 128 + 160;
constexpr int TOK_OFF = TAB_OFF + 2048;
constexpr int BIAS_OFF = TOK_OFF + MAXU * 1024;
constexpr int LDS_BYTES = BIAS_OFF + 4096 + 2048;
static_assert(TAB_TILEE + 320 * 4 <= TOK_OFF && LDS_BYTES <= 163840 && BIAS_OFF == pg8::BIAS_LDS_OFF + RING_OFF, "LDS map");

#define GAS __attribute__((address_space(1)))
#define LAS __attribute__((address_space(3)))
typedef unsigned short bf16;
typedef unsigned v4u __attribute__((ext_vector_type(4)));
typedef unsigned v2u __attribute__((ext_vector_type(2)));
typedef float f32x4 __attribute__((ext_vector_type(4)));
typedef float f32x16 __attribute__((ext_vector_type(16)));
typedef float f32x2 __attribute__((ext_vector_type(2)));
typedef short bf16x8 __attribute__((ext_vector_type(8)));
typedef short s16x4 __attribute__((ext_vector_type(4)));
typedef GAS unsigned gu32;
#define RLX_AGENT __ATOMIC_RELAXED, __HIP_MEMORY_SCOPE_AGENT
#define LDS_WAIT() asm volatile("s_waitcnt lgkmcnt(0)" ::: "memory")
#define VM_WAIT() asm volatile("s_waitcnt vmcnt(0)" ::: "memory")
using pg8::cvt_pk_bf16; using pg8::bf_lo; using pg8::bf_hi;

#define XB_TMO      128
#define XB_XCNT(j)  (256  + 64 * (j))
#define XB_XSUB(j)  (1280 + 64 * (j))
#define XB_XGEN(j)  (2304 + 64 * (j))
#define XB_TOP      3328
#define XB_TOPGEN   3392
#define XCD_BAR_WORDS 3456
#define XB_SPIN_CAP (1u << 18)
static_assert(XCD_BAR_WORDS == XCD_BAR_WORDS_C, "bar words");

__device__ __forceinline__ unsigned xb_ld(unsigned* p)              { return __hip_atomic_load(p, __ATOMIC_RELAXED, __HIP_MEMORY_SCOPE_AGENT); }
__device__ __forceinline__ unsigned xb_add(unsigned* p, unsigned v) { return __hip_atomic_fetch_add(p, v, __ATOMIC_RELAXED, __HIP_MEMORY_SCOPE_AGENT); }
__device__ __forceinline__ unsigned xb_xcc_id() { return (unsigned)__builtin_amdgcn_s_getreg((3 << 11) | 20) & 0xFu; }
#define XB_SPIN(cond, bar) do { unsigned _sp = 0; while (cond) { __builtin_amdgcn_s_sleep(1); \
    if ((++_sp & 255u) == 0u) { if (xb_ld(&(bar)[XB_TMO])) break; if (_sp > XB_SPIN_CAP) { atomicAdd(&(bar)[XB_TMO], 1u); break; } } } } while (0)

struct XcdBarrier { unsigned* bar; unsigned x; volatile LAS unsigned* st; };

__device__ __forceinline__ XcdBarrier xcd_barrier_post(unsigned* bar, volatile LAS unsigned* st) {
    XcdBarrier b; b.bar = bar; b.x = xb_xcc_id(); b.st = st;
    if (threadIdx.x == 0) (void)xb_add(&bar[XB_XCNT(b.x)], 1u);
    return b;
}
__device__ __forceinline__ void xcd_barrier_complete(unsigned* bar, unsigned x, unsigned& nloc, unsigned& nx) {
    const unsigned G = gridDim.x * gridDim.y * gridDim.z;
    unsigned sum, cnt, mine, sp = 0u;
    for (;;) {
        sum = 0u; cnt = 0u; mine = 0u;
#pragma unroll
        for (unsigned j = 0; j < 16; ++j) { const unsigned c = xb_ld(&bar[XB_XCNT(j)]); sum += c; cnt += (c > 0u) ? 1u : 0u; mine = (j == x) ? c : mine; }
        if (sum == G) break;
        __builtin_amdgcn_s_sleep(1);
        if ((++sp & 255u) == 0u) { if (xb_ld(&bar[XB_TMO])) break; if (sp > XB_SPIN_CAP) { atomicAdd(&bar[XB_TMO], 1u); break; } }
    }
    nloc = mine > 0u ? mine : 1u; nx = cnt > 0u ? cnt : 1u;
}
__device__ __forceinline__ void xcd_barrier(const XcdBarrier& b) {
    asm volatile("s_waitcnt vmcnt(0)" ::: "memory");
    __syncthreads();
    if (threadIdx.x == 0) {
        unsigned* bar = b.bar;
        __builtin_amdgcn_s_waitcnt(0);
        unsigned nloc = b.st[0], nx = b.st[1];
        if (nloc == 0u) { xcd_barrier_complete(bar, b.x, nloc, nx); b.st[0] = nloc; b.st[1] = nx; }
        const unsigned old = xb_add(&bar[XB_XSUB(b.x)], 1u);
        const unsigned gen = old / nloc;
        if (old + 1u == (gen + 1u) * nloc) {
            __builtin_amdgcn_fence(__ATOMIC_RELEASE, "agent");
            asm volatile("s_waitcnt vmcnt(0)" ::: "memory");
            const unsigned og = xb_add(&bar[XB_TOP], 1u);
            const unsigned tg = og / nx;
            if (og + 1u == (tg + 1u) * nx) xb_add(&bar[XB_TOPGEN], 1u);
            else XB_SPIN(xb_ld(&bar[XB_TOPGEN]) == tg, bar);
            __builtin_amdgcn_fence(__ATOMIC_ACQUIRE, "agent");
            xb_add(&bar[XB_XGEN(b.x)], 1u);
            asm volatile("s_waitcnt vmcnt(0)" ::: "memory");
        } else {
            XB_SPIN(xb_ld(&bar[XB_XGEN(b.x)]) == gen, bar);
            __builtin_amdgcn_fence(__ATOMIC_ACQUIRE, "agent");
            asm volatile("s_waitcnt vmcnt(0)" ::: "memory");
        }
    }
    __syncthreads();
}

__device__ __forceinline__ float wave_sum(float v) {
#pragma unroll
    for (int o = 1; o < 64; o <<= 1) v += __shfl_xor(v, o);
    return v;
}
__device__ __forceinline__ float wave_max(float v) {
#pragma unroll
    for (int o = 1; o < 64; o <<= 1) v = fmaxf(v, __shfl_xor(v, o));
    return v;
}
__device__ __forceinline__ int wave_min_i(int v) {
#pragma unroll
    for (int o = 1; o < 64; o <<= 1) { const int w = __shfl_xor(v, o); v = w < v ? w : v; }
    return v;
}

template <int CTRL> __device__ __forceinline__ float dpp_f(float v) { return __builtin_bit_cast(float, __builtin_amdgcn_update_dpp(0, __builtin_bit_cast(int, v), CTRL, 0xF, 0xF, false)); }
__device__ __forceinline__ float rl_f(float v, int l) { return __builtin_bit_cast(float, __builtin_amdgcn_readlane(__builtin_bit_cast(int, v), l)); }
__device__ __forceinline__ float wave_sum_dpp(float v) { v += dpp_f<0xB1>(v); v += dpp_f<0x4E>(v); v += dpp_f<0x141>(v); v += dpp_f<0x140>(v); return (rl_f(v, 0) + rl_f(v, 16)) + (rl_f(v, 32) + rl_f(v, 48)); }
__device__ __forceinline__ float half_max_dpp(float v) { v = fmaxf(v, dpp_f<0xB1>(v)); v = fmaxf(v, dpp_f<0x4E>(v)); v = fmaxf(v, dpp_f<0x141>(v)); v = fmaxf(v, dpp_f<0x140>(v)); return fmaxf(rl_f(v, 0), rl_f(v, 16)); }

__device__ __forceinline__ int win_dest(int c) {
    if (c < 1280) { const int h = c >> 6, d = c & 63, s = d >> 5, i = d & 31; return (h << 6) + 8 * (i >> 2) + 4 * s + (i & 3); }
    if (c < 2560) return c;
    if (c < 3584) { const int i = c - 2560; return 2560 + (i >> 2) * 8 + (i & 3); }
    if (c < 4608) { const int i = c - 3584; return 2560 + (i >> 2) * 8 + 4 + (i & 3); }
    if (c < 5632) { const int i = c - 4608; return 4608 + (i >> 2) * 8 + (i & 3); }
    { const int i = c - 5632; return 4608 + (i >> 2) * 8 + 4 + (i & 3); }
}
__device__ __forceinline__ int map_dest(int mode, int n) {
    if (mode == 0) return n;
    if (mode == 1) return win_dest(n);
    if (mode == 2) return (n >> 2) * 8 + (n & 3);
    return (n >> 2) * 8 + 4 + (n & 3);
}

constexpr int NWAVES_C = 8;
struct CvtItem { const GAS float* W; GAS bf16* WT; int K, N, mode, k0, n0, keep; };
__device__ __forceinline__ void cvt_load(f32x4 (&v)[16], const CvtItem& it, int lane) {
    const GAS float* p = it.W + (size_t)(it.k0 + 4 * (lane >> 4)) * it.N + it.n0 + 4 * (lane & 15);
#pragma unroll
    for (int j = 0; j < 4; ++j)
#pragma unroll
        for (int r = 0; r < 4; ++r) v[j * 4 + r] = __builtin_nontemporal_load((const GAS f32x4*)(p + (size_t)(16 * j + r) * it.N));
}
__device__ __forceinline__ void cvt_store(const f32x4 (&v)[16], const CvtItem& it, LAS unsigned char* scr, int lane) {
    const int kq = lane >> 4, nl = 4 * (lane & 15);
#pragma unroll
    for (int j = 0; j < 4; ++j)
#pragma unroll
        for (int i = 0; i < 4; ++i) { v2u w; w.x = cvt_pk_bf16(v[j * 4 + 0][i], v[j * 4 + 1][i]); w.y = cvt_pk_bf16(v[j * 4 + 2][i], v[j * 4 + 3][i]);
            *(LAS v2u*)(scr + (nl + i) * 136 + (16 * j + 4 * kq) * 2) = w; }
    LDS_WAIT(); asm volatile("" ::: "memory");
#pragma unroll
    for (int jj = 0; jj < 8; ++jj) { const int n = (lane >> 3) + 8 * jj, c = lane & 7;
        const v2u a = *(const LAS v2u*)(scr + n * 136 + c * 16), b = *(const LAS v2u*)(scr + n * 136 + c * 16 + 8);
        v4u o; o.x = a.x; o.y = a.y; o.z = b.x; o.w = b.y;
        GAS v4u* dp = (GAS v4u*)(it.WT + (size_t)map_dest(it.mode, it.n0 + n) * it.K + it.k0 + 8 * c);
        if (it.keep) *dp = o; else __builtin_nontemporal_store(o, dp); }
    LDS_WAIT(); asm volatile("" ::: "memory");
}
struct CvtSrc { const float* w_in; bf16* Win_t; const LAS unsigned long long* ptab; };
constexpr int CVT_IN_ITEMS = (1024 / 64) * (6656 / 64);
constexpr int CVT_SQ_ITEMS = 256;
constexpr int CVT_REST_ITEMS = (3 + 32 * 3) * CVT_SQ_ITEMS;
#ifndef SLACK_CVT
#define SLACK_CVT 1
#endif
constexpr int SLACK_P1_ITEMS = SLACK_CVT ? 8192 : 0;
constexpr int SLACK_P6_ITEMS = SLACK_CVT ? 8192 : 0;

__device__ __forceinline__ CvtItem cvt_item_in(const CvtSrc& S, int id) { CvtItem it; it.keep = 0; it.W = (const GAS float*)S.w_in; it.WT = (GAS bf16*)S.Win_t; it.K = 1024; it.N = 6656; it.mode = 1; it.k0 = 64 * (id / 104); it.n0 = 64 * (id % 104); return it; }
__device__ __forceinline__ CvtItem cvt_item_rest(const CvtSrc& S, int id) {
    CvtItem it; it.keep = (KEEP_WD && (id >> 8) >= 67) ? 1 : 0; it.K = 1024; it.N = 1024; const int mat = id >> 8, r = id & 255; it.k0 = 64 * (r >> 4); it.n0 = 64 * (r & 15);
    int si = mat, e = 0, which = 2;
    if (mat >= 67) { e = mat - 67; which = 2; si = 5; }
    else if (mat >= 3) { const int q = mat - 3; e = q >> 1; which = q & 1; si = 3 + which; }
    const unsigned long long ps = S.ptab[si], pd = S.ptab[6 + si];
    const unsigned long long psu = ((unsigned long long)__builtin_amdgcn_readfirstlane((unsigned)(ps >> 32)) << 32) | (unsigned)__builtin_amdgcn_readfirstlane((unsigned)ps);
    const unsigned long long pdu = ((unsigned long long)__builtin_amdgcn_readfirstlane((unsigned)(pd >> 32)) << 32) | (unsigned)__builtin_amdgcn_readfirstlane((unsigned)pd);
    it.W = (const GAS float*)psu + (size_t)e * 1048576; it.WT = (GAS bf16*)pdu + (size_t)e * (which < 2 ? 2097152 : 1048576);
    it.mode = mat < 3 ? 0 : (which == 0 ? 2 : which == 1 ? 3 : 0);
    return it;
}
template <int SET> __device__ __forceinline__ void cvt_run(const CvtSrc& S, int first, int stride, int n_items, LAS unsigned char* scr, int lane, int base = 0) {
    f32x4 r0[16], r1[16]; CvtItem i0, i1;
    int id = first; if (id >= n_items) return;
    i0 = SET == 0 ? cvt_item_in(S, id) : cvt_item_rest(S, base + id); cvt_load(r0, i0, lane);
    for (;;) {
        const int idn = id + stride;
        if (idn >= n_items) { cvt_store(r0, i0, scr, lane); break; }
        i1 = SET == 0 ? cvt_item_in(S, idn) : cvt_item_rest(S, base + idn); cvt_load(r1, i1, lane); cvt_store(r0, i0, scr, lane);
        id = idn + stride;
        if (id >= n_items) { cvt_store(r1, i1, scr, lane); break; }
        i0 = SET == 0 ? cvt_item_in(S, id) : cvt_item_rest(S, base + id); cvt_load(r0, i0, lane); cvt_store(r1, i1, scr, lane);
    }
}

__device__ __forceinline__ void slack_convert(const CvtSrc& S, int U, int G, int c, int base, int n_items, LAS unsigned char* scr, int wave, int lane) {
    if (n_items <= 0) return;
    int rem = U % G; if (G - rem < G / 4) rem = 0;
    const int ncv = G - rem;
    if (c < rem) return;
    cvt_run<1>(S, (c - rem) * NWAVES_C + wave, ncv * NWAVES_C, n_items, scr, lane, base);
}

__device__ __forceinline__ void rms_row_to_bf16(const float* xrow, const float* g, bf16* orow, int lane) {
    const GAS f32x4* xr = (const GAS f32x4*)xrow + lane; const GAS f32x4* gr = (const GAS f32x4*)g + lane;
    f32x4 v[4]; float s = 0.f;
#pragma unroll
    for (int j = 0; j < 4; ++j) { v[j] = __builtin_nontemporal_load(xr + 64 * j); s += (v[j].x * v[j].x + v[j].y * v[j].y) + (v[j].z * v[j].z + v[j].w * v[j].w); }
    const float rstd = 1.f / sqrtf(wave_sum(s) * (1.f / D) + RMS_EPS);
    GAS v2u* o8 = (GAS v2u*)orow + lane;
#pragma unroll
    for (int j = 0; j < 4; ++j) { const f32x4 gg = gr[64 * j]; v2u w; w.x = cvt_pk_bf16(v[j].x * rstd * gg.x, v[j].y * rstd * gg.y); w.y = cvt_pk_bf16(v[j].z * rstd * gg.z, v[j].w * rstd * gg.w); o8[64 * j] = w; }
}

struct DenseOrder {
    int nM, nN, G, c, K; const char* A; const char* B;
    __device__ __forceinline__ bool next(int i, pg8::Unit& u) const {
        if (!pg8::tile_of((long)i * G + c, nM, nN, u.pm, u.pn)) return false;
        u.e = 0; u.aux = 1; u.keep = false; u.rofs = 0; u.a = A + (size_t)u.pm * 256 * K * 2; u.b = B + (size_t)u.pn * 256 * K * 2; return true; }
    __device__ __forceinline__ unsigned tokoff(int, int) const { return 0u; }
    __device__ __forceinline__ void a_ready(const pg8::Unit&) const {}
    __device__ __forceinline__ void done(const pg8::Unit&) const {}
};
struct MergeOrder {
    int nM, nN, G, c, K; const char* A0; const char* B0; const char* A1; const char* B1;
    __device__ __forceinline__ bool next(int i, pg8::Unit& u) const {
        if (!pg8::tile_of((long)(i >> 1) * G + c, nM, nN, u.pm, u.pn)) return false;
        const int br = i & 1; u.e = 0; u.aux = br; u.keep = (br == 0); u.rofs = 0;
        u.a = (br ? A1 : A0) + (size_t)u.pm * 256 * K * 2; u.b = (br ? B1 : B0) + (size_t)u.pn * 256 * K * 2; return true; }
    __device__ __forceinline__ unsigned tokoff(int, int) const { return 0u; }
    __device__ __forceinline__ void a_ready(const pg8::Unit&) const {}
    __device__ __forceinline__ void done(const pg8::Unit&) const {}
};
struct MoeOrder {
    int MT, G, c; const char* XNb; const char* ACTb; const char* Wgu; const char* Wd; const LAS int* tile_e; const LAS unsigned* tok; unsigned* ready; unsigned* tmo; int part; int ulim;
    __device__ __forceinline__ bool next(int i, pg8::Unit& u) const {
        const long U1 = (long)MT * 8; const long L = (long)i * G + c + (part == 2 ? U1 : 0);
        if (part == 1 && L >= U1) return false;
        if (part == 2 && L - U1 >= ulim) return false;
        if (L < U1) { pg8::tile_of(L, MT, 8, u.pm, u.pn, WGM_MOE); const int e = __builtin_amdgcn_readfirstlane(tile_e[u.pm]);
            u.e = e; u.aux = 2; u.keep = false; u.rofs = 0; u.a = XNb; u.b = Wgu + (size_t)e * (2048 * 1024 * 2) + (size_t)u.pn * (256 * 1024 * 2); return true; }
        if (!pg8::tile_of(L - U1, MT, 4, u.pm, u.pn, WGM_MOE2)) return false;
        if (P7_REVERSE && part == 2) u.pm = MT - 1 - u.pm;
        const int e = __builtin_amdgcn_readfirstlane(tile_e[u.pm]);
        u.e = e; u.aux = 3; u.keep = false; u.rofs = 0; u.a = ACTb + (size_t)u.pm * (256 * 1024 * 2); u.b = Wd + (size_t)e * (1024 * 1024 * 2) + (size_t)u.pn * (256 * 1024 * 2); return true; }
    __device__ __forceinline__ unsigned tokoff(int i, int row) const { return (part != 2 && (long)i * G + c < (long)MT * 8) ? tok[i * 256 + row] : (unsigned)row * 2048u; }
    __device__ __forceinline__ void a_ready(const pg8::Unit& u) const {
        if (u.aux != 3 || part != 0) return;
        if (threadIdx.x < 64) {
            const unsigned long long t0 = __builtin_amdgcn_s_memrealtime(); unsigned polls = 0;
            while ((unsigned)__builtin_amdgcn_readfirstlane(__hip_atomic_load(ready + 64 * u.pm, __ATOMIC_RELAXED, __HIP_MEMORY_SCOPE_AGENT)) < 64u) {
                if ((++polls & 255u) == 0u && __builtin_amdgcn_readfirstlane(__hip_atomic_load(tmo, __ATOMIC_RELAXED, __HIP_MEMORY_SCOPE_AGENT)) != 0u) break;
                if (__builtin_amdgcn_s_memrealtime() - t0 > 2000000ull) { if (threadIdx.x == 0) __hip_atomic_store(tmo, 1u, __ATOMIC_RELAXED, __HIP_MEMORY_SCOPE_AGENT); break; }
                __builtin_amdgcn_s_sleep(2); }
            __builtin_amdgcn_fence(__ATOMIC_ACQUIRE, "agent");
            asm volatile("s_waitcnt vmcnt(0)" ::: "memory");
        }
        asm volatile("" ::: "memory"); __builtin_amdgcn_s_barrier(); asm volatile("" ::: "memory");
    }
    __device__ __forceinline__ void done(const pg8::Unit& u) const {
        if (u.aux != 2 || part != 0) return;
        asm volatile("s_waitcnt vmcnt(0)" ::: "memory");
        if ((threadIdx.x & 63) == 0) __hip_atomic_fetch_add(ready + 64 * u.pm, 1u, __ATOMIC_RELAXED, __HIP_MEMORY_SCOPE_AGENT);
    }
};

struct TailOrder {
    int MT, ubase, c; const char* ACTb; const char* Wd; const LAS int* tile_e;
    __device__ __forceinline__ bool next(int i, pg8::Unit& u) const {
        if (i != 0 || !pg8::tile_of((long)ubase + (c >> 1), MT, 4, u.pm, u.pn, WGM_MOE2)) return false;
        const int e = __builtin_amdgcn_readfirstlane(tile_e[u.pm]);
        u.e = e; u.aux = 4; u.keep = false; u.rofs = 128 * (c & 1); u.a = ACTb + ((size_t)u.pm * 256 + 128 * (c & 1)) * (1024 * 2);     u.b = Wd + (size_t)e * (1024 * 1024 * 2) + (size_t)u.pn * (256 * 1024 * 2); return true; }
    __device__ __forceinline__ unsigned tokoff(int, int row) const { return (unsigned)(128 * (c & 1) + (row & 127)) * 2048u; }
    __device__ __forceinline__ void a_ready(const pg8::Unit&) const {}
    __device__ __forceinline__ void done(const pg8::Unit&) const {}
};

using pg8::f32x4; using pg8::Unit;
struct EpiInProj {
    static constexpr bool PERM = true;
    __device__ static __forceinline__ int nstores(const Unit&) { return 16; }
    bf16 *Q, *Kb, *Vb, *CB, *U, *SA, *SC; const float* bias; const float* cosT; const float* sinT;
    __device__ __forceinline__ const float* bias_row(const Unit& u) const { return bias + u.pn * 256; }
    __device__ __forceinline__ const float* aux_row(const Unit&) const { return nullptr; }
    __device__ __forceinline__ void operator()(const f32x4 (&acc)[2][2][4][2], const Unit& u, int wr, int wc, int fr, int fq, const LAS float* bl) const {
        const int pn = u.pn, row0 = u.pm * 256 + wr * 64 + fr, cl0 = wc * 32 + 8 * fq;
        f32x4 bv[2][2];
#pragma unroll
        for (int bj = 0; bj < 2; ++bj)
#pragma unroll
            for (int n = 0; n < 2; ++n) bv[bj][n] = *(const LAS f32x4*)(bl + cl0 + bj * 128 + 4 * n);
        if (pn < 5) {
            bf16* base = pn < 4 ? Q : Kb; const int ld = pn < 4 ? 1024 : 256, colt = pn < 4 ? pn * 256 : 0; const float sc = pn < 4 ? QSCALE : 1.0f;
            const int i0 = 16 * (wc & 1) + 4 * fq;
#pragma unroll
            for (int ai = 0; ai < 2; ++ai)
#pragma unroll
                for (int m = 0; m < 4; ++m) { const int row = row0 + ai * 128 + m * 16, pos = row & (SEQ - 1);
                    const f32x4 c4 = *(const f32x4*)(cosT + pos * 32 + i0) * sc, s4 = *(const f32x4*)(sinT + pos * 32 + i0) * sc;
#pragma unroll
                    for (int bj = 0; bj < 2; ++bj) { const f32x4 t1 = acc[ai][bj][m][0] + bv[bj][0], t2 = acc[ai][bj][m][1] + bv[bj][1];
                        const f32x4 o1 = t1 * c4 - t2 * s4, o2 = t2 * c4 + t1 * s4;
                        v4u w; w.x = cvt_pk_bf16(o1[0], o1[1]); w.y = cvt_pk_bf16(o1[2], o1[3]); w.z = cvt_pk_bf16(o2[0], o2[1]); w.w = cvt_pk_bf16(o2[2], o2[3]);
                        *(v4u*)(base + (size_t)row * ld + colt + cl0 + bj * 128) = w; } }
        } else if (pn >= 10 && pn < 18) {
            const int colt = (pn - 10) * 128 + (cl0 >> 1);
#pragma unroll
            for (int ai = 0; ai < 2; ++ai)
#pragma unroll
                for (int m = 0; m < 4; ++m) { const int row = row0 + ai * 128 + m * 16;
#pragma unroll
                    for (int bj = 0; bj < 2; ++bj) { const f32x4 p = (acc[ai][bj][m][0] + bv[bj][0]) * (acc[ai][bj][m][1] + bv[bj][1]);
                        v2u w; w.x = cvt_pk_bf16(p[0], p[1]); w.y = cvt_pk_bf16(p[2], p[3]);
                        *(v2u*)(U + (size_t)row * 1024 + colt + bj * 64) = w; } }
        } else if (pn >= 18) {
            const int colt = (pn - 18) * 128 + (cl0 >> 1);
#pragma unroll
            for (int ai = 0; ai < 2; ++ai)
#pragma unroll
                for (int m = 0; m < 4; ++m) { const int row = row0 + ai * 128 + m * 16;
#pragma unroll
                    for (int bj = 0; bj < 2; ++bj) { const f32x4 a4 = acc[ai][bj][m][0] + bv[bj][0], c4 = acc[ai][bj][m][1] + bv[bj][1]; f32x4 r4, s4;
#pragma unroll
                        for (int q = 0; q < 4; ++q) { const float ea = __builtin_amdgcn_exp2f(a4[q] * -1.4426950408889634f), ec = __builtin_amdgcn_exp2f(c4[q] * -1.4426950408889634f);
                            s4[q] = fmaxf(__builtin_amdgcn_rcpf(1.0f + ec), 1e-20f); r4[q] = (1.0f + ec) * __builtin_amdgcn_rcpf(1.0f + ea); r4[q] = fminf(r4[q], 1e20f); }
                        v2u wr_, ws_; wr_.x = cvt_pk_bf16(r4[0], r4[1]); wr_.y = cvt_pk_bf16(r4[2], r4[3]); ws_.x = cvt_pk_bf16(s4[0], s4[1]); ws_.y = cvt_pk_bf16(s4[2], s4[3]);
                        *(v2u*)(SA + (size_t)row * 1024 + colt + bj * 64) = wr_; *(v2u*)(SC + (size_t)row * 1024 + colt + bj * 64) = ws_; } }
        } else {
            bf16* base; int ld = 1024, colt; const bool sg = false;
            if (pn == 5) { base = Vb; ld = 256; colt = 0; }
            else { base = CB; colt = (pn - 6) * 256; }
#pragma unroll
            for (int ai = 0; ai < 2; ++ai)
#pragma unroll
                for (int m = 0; m < 4; ++m) { const int row = row0 + ai * 128 + m * 16;
#pragma unroll
                    for (int bj = 0; bj < 2; ++bj) { f32x4 v0 = acc[ai][bj][m][0] + bv[bj][0], v1 = acc[ai][bj][m][1] + bv[bj][1];
                        if (sg) {
#pragma unroll
                            for (int q = 0; q < 4; ++q) { v0[q] = pg8::sigmoidf_(v0[q]); v1[q] = pg8::sigmoidf_(v1[q]); } }
                        v4u w; w.x = cvt_pk_bf16(v0[0], v0[1]); w.y = cvt_pk_bf16(v0[2], v0[3]); w.z = cvt_pk_bf16(v1[0], v1[1]); w.w = cvt_pk_bf16(v1[2], v1[3]);
                        *(v4u*)(base + (size_t)row * ld + colt + cl0 + bj * 128) = w; } }
        }
    }
};
struct EpiMerge {
    static constexpr bool PERM = true;
    __device__ static __forceinline__ int nstores(const Unit& u) { return u.aux == 0 ? 0 : 16; }
    const bf16 *SA, *SC; bf16* MG;
    __device__ __forceinline__ const float* bias_row(const Unit&) const { return nullptr; }
    __device__ __forceinline__ const float* aux_row(const Unit&) const { return nullptr; }
    __device__ __forceinline__ void operator()(f32x4 (&acc)[2][2][4][2], const Unit& u, int wr, int wc, int fr, int fq, const LAS float*) const {
        const int row0 = u.pm * 256 + wr * 64 + fr, col0 = u.pn * 256 + wc * 32 + 8 * fq;
        const bf16* G = u.aux == 0 ? SA : SC;
        v4u gv[2][4][2];
#pragma unroll
        for (int ai = 0; ai < 2; ++ai)
#pragma unroll
            for (int m = 0; m < 4; ++m)
#pragma unroll
                for (int bj = 0; bj < 2; ++bj) gv[ai][m][bj] = *(const v4u*)(G + (size_t)(row0 + ai * 128 + m * 16) * 1024 + col0 + bj * 128);
#pragma unroll
        for (int ai = 0; ai < 2; ++ai)
#pragma unroll
            for (int m = 0; m < 4; ++m)
#pragma unroll
                for (int bj = 0; bj < 2; ++bj) { const v4u c = gv[ai][m][bj];
                    const f32x4 c0 = {bf_lo(c.x), bf_hi(c.x), bf_lo(c.y), bf_hi(c.y)}, c1 = {bf_lo(c.z), bf_hi(c.z), bf_lo(c.w), bf_hi(c.w)};
                    const f32x4 v0 = acc[ai][bj][m][0] * c0, v1 = acc[ai][bj][m][1] * c1;
                    if (u.aux == 0) { acc[ai][bj][m][0] = v0; acc[ai][bj][m][1] = v1; }
                    else { v4u w; w.x = cvt_pk_bf16(v0[0], v0[1]); w.y = cvt_pk_bf16(v0[2], v0[3]); w.z = cvt_pk_bf16(v1[0], v1[1]); w.w = cvt_pk_bf16(v1[2], v1[3]);
                        *(v4u*)(MG + (size_t)(row0 + ai * 128 + m * 16) * 1024 + col0 + bj * 128) = w; } }
    }
};
struct EpiRes {
    static constexpr bool PERM = true;
    __device__ static __forceinline__ int nstores(const Unit&) { return 16; }
    bf16* DL;
    __device__ __forceinline__ const float* bias_row(const Unit&) const { return nullptr; }
    __device__ __forceinline__ const float* aux_row(const Unit&) const { return nullptr; }
    __device__ __forceinline__ void operator()(const f32x4 (&acc)[2][2][4][2], const Unit& u, int wr, int wc, int fr, int fq, const LAS float*) const {
        const int row0 = u.pm * 256 + wr * 64 + fr, col0 = u.pn * 256 + wc * 32 + 8 * fq;
#pragma unroll
        for (int ai = 0; ai < 2; ++ai)
#pragma unroll
            for (int m = 0; m < 4; ++m) { bf16* rp = DL + (size_t)(row0 + ai * 128 + m * 16) * 1024 + col0;
#pragma unroll
                for (int bj = 0; bj < 2; ++bj) { const f32x4 v0 = acc[ai][bj][m][0], v1 = acc[ai][bj][m][1];
                    v4u w; w.x = cvt_pk_bf16(v0[0], v0[1]); w.y = cvt_pk_bf16(v0[2], v0[3]); w.z = cvt_pk_bf16(v1[0], v1[1]); w.w = cvt_pk_bf16(v1[2], v1[3]);
                    *(v4u*)(rp + bj * 128) = w; } }
    }
};
struct EpiGU {
    static constexpr bool PERM = true;
    __device__ static __forceinline__ int nstores(const Unit&) { return 16; }
    bf16* ACT; const float* bgu; const float* rstdrel; const LAS int* tst;
    __device__ __forceinline__ const float* bias_row(const Unit& u) const { return bgu + (size_t)u.e * 2048 + u.pn * 256; }
    __device__ __forceinline__ const float* aux_row(const Unit& u) const { return P5_MFMA ? rstdrel + (size_t)u.e * SLOTCAP + (u.pm - tst[u.e]) * 256 : nullptr; }
    __device__ __forceinline__ void operator()(const f32x4 (&acc)[2][2][4][2], const Unit& u, int wr, int wc, int fr, int fq, const LAS float* bl) const {
        const int row0 = u.pm * 256 + wr * 64 + fr, cl0 = u.pn * 256 + wc * 32 + 8 * fq;
        const LAS float* bb = bl + wc * 32 + 8 * fq;
        f32x4 bv[2][2];
#pragma unroll
        for (int bj = 0; bj < 2; ++bj)
#pragma unroll
            for (int n = 0; n < 2; ++n) bv[bj][n] = *(const LAS f32x4*)(bb + bj * 128 + 4 * n);
#pragma unroll
        for (int ai = 0; ai < 2; ++ai)
#pragma unroll
            for (int m = 0; m < 4; ++m) { bf16* rp = ACT + (size_t)(row0 + ai * 128 + m * 16) * 1024 + (cl0 >> 1);
                const float rs = P5_MFMA ? bl[256 + wr * 64 + fr + ai * 128 + m * 16] : 1.0f;
#pragma unroll
                for (int bj = 0; bj < 2; ++bj) { const f32x4 g4 = acc[ai][bj][m][0] * rs + bv[bj][0], u4 = acc[ai][bj][m][1] * rs + bv[bj][1]; f32x4 o;
#pragma unroll
                    for (int q = 0; q < 4; ++q) { const float g = __builtin_amdgcn_fmed3f(g4[q], -3.0e38f, 7.0f), uu = __builtin_amdgcn_fmed3f(u4[q], -7.0f, 7.0f);
                        o[q] = g * __builtin_amdgcn_rcpf(1.0f + __builtin_amdgcn_exp2f(g * -2.4554669595930157f)) * (uu + 1.0f); }
                    if (MOE_MERGED) { const unsigned long long w = (unsigned long long)cvt_pk_bf16(o[0], o[1]) | ((unsigned long long)cvt_pk_bf16(o[2], o[3]) << 32);
                        __hip_atomic_store((unsigned long long*)(rp + bj * 64), w, __ATOMIC_RELAXED, __HIP_MEMORY_SCOPE_AGENT); }
                    else { v2u w; w.x = cvt_pk_bf16(o[0], o[1]); w.y = cvt_pk_bf16(o[2], o[3]); *(v2u*)(rp + bj * 64) = w; } } }
    }
};
struct EpiDown {
    static constexpr bool PERM = true;
    __device__ static __forceinline__ int nstores(const Unit&) { return 16; }
    bf16* Y; const float* bd;
    __device__ __forceinline__ const float* bias_row(const Unit& u) const { return bd + (size_t)u.e * 1024 + u.pn * 256; }
    __device__ __forceinline__ const float* aux_row(const Unit&) const { return nullptr; }
    __device__ __forceinline__ void operator()(const f32x4 (&acc)[2][2][4][2], const Unit& u, int wr, int wc, int fr, int fq, const LAS float* bl) const {
        const int row0 = u.pm * 256 + wr * 64 + fr, cl0 = u.pn * 256 + wc * 32 + 8 * fq;
        const LAS float* bb = bl + wc * 32 + 8 * fq;
        f32x4 bv[2][2];
#pragma unroll
        for (int bj = 0; bj < 2; ++bj)
#pragma unroll
            for (int n = 0; n < 2; ++n) bv[bj][n] = *(const LAS f32x4*)(bb + bj * 128 + 4 * n);
#pragma unroll
        for (int ai = 0; ai < 2; ++ai)
#pragma unroll
            for (int m = 0; m < 4; ++m) { bf16* rp = Y + (size_t)(row0 + ai * 128 + m * 16) * 1024 + cl0;
#pragma unroll
                for (int bj = 0; bj < 2; ++bj) { const f32x4 v0 = acc[ai][bj][m][0] + bv[bj][0], v1 = acc[ai][bj][m][1] + bv[bj][1];
                    v4u w; w.x = cvt_pk_bf16(v0[0], v0[1]); w.y = cvt_pk_bf16(v0[2], v0[3]); w.z = cvt_pk_bf16(v1[0], v1[1]); w.w = cvt_pk_bf16(v1[2], v1[3]);
                    *(v4u*)(rp + bj * 128) = w; } }
    }
    __device__ __forceinline__ void half(const f32x4 (&acc)[2][2][4][2], const Unit& u, int wr, int wc, int fr, int fq, const LAS float* bl) const {
        const int row0 = u.pm * 256 + u.rofs + wr * 64 + fr, cl0 = u.pn * 256 + wc * 32 + 8 * fq;
        const LAS float* bb = bl + wc * 32 + 8 * fq;
        f32x4 bv[2][2];
#pragma unroll
        for (int bj = 0; bj < 2; ++bj)
#pragma unroll
            for (int n = 0; n < 2; ++n) bv[bj][n] = *(const LAS f32x4*)(bb + bj * 128 + 4 * n);
#pragma unroll
        for (int m = 0; m < 4; ++m) { bf16* rp = Y + (size_t)(row0 + m * 16) * 1024 + cl0;
#pragma unroll
            for (int bj = 0; bj < 2; ++bj) { const f32x4 v0 = acc[0][bj][m][0] + bv[bj][0], v1 = acc[0][bj][m][1] + bv[bj][1];
                v4u w; w.x = cvt_pk_bf16(v0[0], v0[1]); w.y = cvt_pk_bf16(v0[2], v0[3]); w.z = cvt_pk_bf16(v1[0], v1[1]); w.w = cvt_pk_bf16(v1[2], v1[3]);
                *(v4u*)(rp + bj * 128) = w; } }
    }
};
struct EpiDownX {
    static constexpr bool PERM = true;
    __device__ static __forceinline__ int nstores(const Unit&) { return 0; }
    EpiDown dn;
    __device__ __forceinline__ const float* bias_row(const Unit& u) const { return dn.bias_row(u); }
    __device__ __forceinline__ const float* aux_row(const Unit&) const { return nullptr; }
    __device__ __forceinline__ void operator()(const f32x4 (&acc)[2][2][4][2], const Unit& u, int wr, int wc, int fr, int fq, const LAS float* bl) const { if (u.aux == 4) dn.half(acc, u, wr, wc, fr, fq, bl); else dn(acc, u, wr, wc, fr, fq, bl); }
};
struct EpiMoe {
    static constexpr bool PERM = true;
    __device__ static __forceinline__ int nstores(const Unit&) { return MOE_MERGED ? 0 : 16; }
    EpiGU gu; EpiDown dn;
    __device__ __forceinline__ const float* bias_row(const Unit& u) const { return u.aux == 2 ? gu.bias_row(u) : dn.bias_row(u); }
    __device__ __forceinline__ const float* aux_row(const Unit& u) const { return u.aux == 2 ? gu.aux_row(u) : nullptr; }
    __device__ __forceinline__ void operator()(const f32x4 (&acc)[2][2][4][2], const Unit& u, int wr, int wc, int fr, int fq, const LAS float* bl) const { if (u.aux == 2) gu(acc, u, wr, wc, fr, fq, bl); else if (u.aux == 4) dn.half(acc, u, wr, wc, fr, fq, bl); else dn(acc, u, wr, wc, fr, fq, bl); }
};

namespace att {
constexpr int KS_STRIDE = 144, VT_STRIDE = 520;
constexpr int L_KS = 0, L_VT = 36864, L_ST = 70144, L_SC = 102912, L_END = 103936;
static_assert(L_VT == 256 * KS_STRIDE && L_ST == L_VT + 64 * VT_STRIDE && L_END <= RING_BYTES, "attention LDS map");
__device__ __forceinline__ int crow(int r, int hi) { return (r & 3) + 8 * (r >> 2) + 4 * hi; }

struct KVRegs { v4u k[4], v[4]; };
__device__ __forceinline__ void attn_load(KVRegs& R, int uu, const bf16* Kb, const bf16* Vb) {
    const int tid = threadIdx.x, n = uu & 63, kvh = (uu >> 6) & 3, b = uu >> 8, tokbase = b * SEQ, r0 = 128 * (n - 1);
#pragma unroll
    for (int it = 0; it < 4; ++it) { const int p = tid + 512 * it, row = p >> 3, ch = p & 7; int pos = r0 + row; pos = pos < 0 ? 0 : pos;
        R.k[it] = *(const v4u*)(Kb + (size_t)(tokbase + pos) * KVW + kvh * 64 + ch * 8); }
#pragma unroll
    for (int it = 0; it < 4; ++it) { const int p = tid + 512 * it, key = p & 255, c = p >> 8; int pos = r0 + key; pos = pos < 0 ? 0 : pos;
        R.v[it] = *(const v4u*)(Vb + (size_t)(tokbase + pos) * KVW + kvh * 64 + c * 8); }
}
__device__ __forceinline__ void attn_store(const KVRegs& R, LAS unsigned char* lds) {
    const int tid = threadIdx.x;
#pragma unroll
    for (int it = 0; it < 4; ++it) { const int p = tid + 512 * it, row = p >> 3, ch = p & 7; *(LAS v4u*)(lds + L_KS + row * KS_STRIDE + ch * 16) = R.k[it]; }
#pragma unroll
    for (int it = 0; it < 4; ++it) { const int p = tid + 512 * it, key = p & 255, c = p >> 8; const v4u v = R.v[it];
        LAS unsigned short* vt = (LAS unsigned short*)(lds + L_VT + (8 * c) * VT_STRIDE + key * 2);
        vt[0 * (VT_STRIDE / 2)] = (unsigned short)(v.x & 0xffffu); vt[1 * (VT_STRIDE / 2)] = (unsigned short)(v.x >> 16);
        vt[2 * (VT_STRIDE / 2)] = (unsigned short)(v.y & 0xffffu); vt[3 * (VT_STRIDE / 2)] = (unsigned short)(v.y >> 16);
        vt[4 * (VT_STRIDE / 2)] = (unsigned short)(v.z & 0xffffu); vt[5 * (VT_STRIDE / 2)] = (unsigned short)(v.z >> 16);
        vt[6 * (VT_STRIDE / 2)] = (unsigned short)(v.w & 0xffffu); vt[7 * (VT_STRIDE / 2)] = (unsigned short)(v.w >> 16); }
}
struct ConvCtx { const bf16* Ub; bf16* CB; const LAS float* w; int c0, row; bool on; v4u um2, um1; };
struct ConvB { v4u u[4], cb[4]; };
__device__ __forceinline__ void conv_issue(ConvB& B, const ConvCtx& C) {
#pragma unroll
    for (int r = 0; r < 4; ++r) { const size_t off = (size_t)(C.row + r) * 1024 + C.c0; B.u[r] = *(const v4u*)(C.Ub + off); B.cb[r] = *(const v4u*)(C.CB + off); }
}
__device__ __forceinline__ void conv_finish(const ConvB& B, ConvCtx& C) {
    float w0[8], w1[8], w2[8];
    { const f32x4 a0 = *(const LAS f32x4*)(C.w + C.c0), a1 = *(const LAS f32x4*)(C.w + C.c0 + 4), b0 = *(const LAS f32x4*)(C.w + 1024 + C.c0), b1 = *(const LAS f32x4*)(C.w + 1024 + C.c0 + 4),
                  c0_ = *(const LAS f32x4*)(C.w + 2048 + C.c0), c1_ = *(const LAS f32x4*)(C.w + 2048 + C.c0 + 4);
#pragma unroll
      for (int q = 0; q < 4; ++q) { w0[q] = a0[q]; w0[q + 4] = a1[q]; w1[q] = b0[q]; w1[q + 4] = b1[q]; w2[q] = c0_[q]; w2[q + 4] = c1_[q]; } }
#pragma unroll
    for (int r = 0; r < 4; ++r) { const v4u u0 = B.u[r], cb = B.cb[r], um2 = C.um2, um1 = C.um1; v4u o;
#define CONV2(F, qa) cvt_pk_bf16(bf_lo(cb.F) * (w0[qa] * bf_lo(um2.F) + w1[qa] * bf_lo(um1.F) + w2[qa] * bf_lo(u0.F)), bf_hi(cb.F) * (w0[qa + 1] * bf_hi(um2.F) + w1[qa + 1] * bf_hi(um1.F) + w2[qa + 1] * bf_hi(u0.F)))
        o.x = CONV2(x, 0); o.y = CONV2(y, 2); o.z = CONV2(z, 4); o.w = CONV2(w, 6);
#undef CONV2
        if (C.on) { *(v4u*)(C.CB + (size_t)(C.row + r) * 1024 + C.c0) = o; C.um2 = um1; C.um1 = u0; } }
    if (C.on) C.row += 4;
}
template <int SUB> __device__ __forceinline__ void attn_sub(LAS unsigned char* lds, int uu, int un, KVRegs& R, const bf16* Q, const bf16* Kb, const bf16* Vb, bf16* O, float sinkv, int hq, ConvCtx& CV) {
    const int tid = threadIdx.x, lane = tid & 63, r32 = lane & 31, hi = lane >> 5, wid = __builtin_amdgcn_readfirstlane(tid >> 6);
    const int n = uu & 63, b = uu >> 8, tokbase = b * SEQ;
    LAS float* scr = (LAS float*)(lds + L_SC + wid * 128);
    LAS unsigned short* stg = (LAS unsigned short*)(lds + L_ST + wid * 4096);
    {
        const int q0 = 64 * (wid & 1) + 32 * SUB, tb = q0 >> 5;
        const size_t qtok = (size_t)tokbase + 128 * n + q0;
        bf16x8 qf[4];
#pragma unroll
        for (int s = 0; s < 4; ++s) qf[s] = *(const bf16x8*)(Q + (qtok + r32) * 1024 + hq * 64 + 16 * s + 8 * hi);
        if constexpr (SUB == 0) { if (KV_PREFETCH) attn_load(R, un, Kb, Vb); }
        ConvB CBt; conv_issue(CBt, CV);
        f32x16 sc[5];
#pragma unroll
        for (int i = 0; i < 5; ++i) { f32x16 a = {};
#pragma unroll
            for (int s = 0; s < 4; ++s) { const bf16x8 kf = *(const LAS bf16x8*)(lds + L_KS + (32 * (tb + i) + r32) * KS_STRIDE + (16 * s + 8 * hi) * 2);
                a = __builtin_amdgcn_mfma_f32_32x32x16_bf16(kf, qf[s], a, 0, 0, 0); }
            sc[i] = a; }
#pragma unroll
        for (int r = 0; r < 16; ++r) { const int kl = crow(r, hi);
            if (!(kl > r32)) sc[0][r] = -INFINITY;
            if (!(kl <= r32)) sc[4][r] = -INFINITY; }
        if (n == 0) {
#pragma unroll
            for (int i = 0; i < 4; ++i) if (tb + i < 4) {
#pragma unroll
                for (int r = 0; r < 16; ++r) sc[i][r] = -INFINITY; } }
        float mx = sinkv;
#pragma unroll
        for (int i = 0; i < 5; ++i)
#pragma unroll
            for (int r = 0; r < 16; ++r) mx = fmaxf(mx, sc[i][r]);
        mx = fmaxf(mx, __shfl_xor(mx, 32));
        float sum = 0.f;
#pragma unroll
        for (int i = 0; i < 5; ++i)
#pragma unroll
            for (int r = 0; r < 16; ++r) { const float p = __builtin_amdgcn_exp2f(sc[i][r] - mx); sc[i][r] = p; sum += p; }
        sum += __shfl_xor(sum, 32);
        const float denom = sum + __builtin_amdgcn_exp2f(sinkv - mx);
        if (hi == 0) scr[r32] = __builtin_amdgcn_rcpf(denom);
        f32x16 o[2]; o[0] = f32x16{}; o[1] = f32x16{};
#pragma unroll
        for (int i = 0; i < 5; ++i)
#pragma unroll
            for (int s2 = 0; s2 < 2; ++s2) {
                v4u pw; pw.x = cvt_pk_bf16(sc[i][8 * s2 + 0], sc[i][8 * s2 + 1]); pw.y = cvt_pk_bf16(sc[i][8 * s2 + 2], sc[i][8 * s2 + 3]);
                pw.z = cvt_pk_bf16(sc[i][8 * s2 + 4], sc[i][8 * s2 + 5]); pw.w = cvt_pk_bf16(sc[i][8 * s2 + 6], sc[i][8 * s2 + 7]);
                const bf16x8 pa = __builtin_bit_cast(bf16x8, pw);
                const int key0 = 32 * (tb + i) + 16 * s2 + 4 * hi;
#pragma unroll
                for (int dh = 0; dh < 2; ++dh) { const LAS unsigned char* vp = lds + L_VT + (32 * dh + r32) * VT_STRIDE + key0 * 2;
                    const s16x4 lo = *(const LAS s16x4*)vp, h4 = *(const LAS s16x4*)(vp + 16);
                    const bf16x8 vb = {lo[0], lo[1], lo[2], lo[3], h4[0], h4[1], h4[2], h4[3]};
                    o[dh] = __builtin_amdgcn_mfma_f32_32x32x16_bf16(pa, vb, o[dh], 0, 0, 0); } }
#pragma unroll
        for (int r = 0; r < 16; ++r) { const int orow = crow(r, hi); const float rl = scr[orow];
#pragma unroll
            for (int dh = 0; dh < 2; ++dh) stg[orow * 64 + dh * 32 + r32] = (unsigned short)(cvt_pk_bf16(o[dh][r] * rl, 0.f) & 0xffffu); }
        bf16* Ow = O + qtok * 1024 + hq * 64;
#pragma unroll
        for (int i = 0; i < 4; ++i) { const int row = i * 8 + (lane >> 3), ch = lane & 7; const v4u v = *(const LAS v4u*)(stg + row * 64 + ch * 8); *(v4u*)(Ow + (size_t)row * 1024 + ch * 8) = v; }
        conv_finish(CBt, CV);
    }
}
__device__ __forceinline__ void attn_compute(LAS unsigned char* lds, int uu, int un, KVRegs& R, const bf16* Q, const bf16* Kb, const bf16* Vb, bf16* O, const float* sinks, ConvCtx& CV) {
    const int wid = __builtin_amdgcn_readfirstlane(threadIdx.x >> 6), kvh = (uu >> 6) & 3, hq = 4 * kvh + (wid >> 1);
    const float sinkv = sinks[hq] * LOG2E;
    attn_sub<0>(lds, uu, un, R, Q, Kb, Vb, O, sinkv, hq, CV);
    attn_sub<1>(lds, uu, un, R, Q, Kb, Vb, O, sinkv, hq, CV);
    __syncthreads();
}
}

struct Args { const float* in[19]; float* out; unsigned char* ws; int ph_lo, ph_hi, li, pad; };

__global__ void __launch_bounds__(NWAVES * 64, 2) fwd_kernel(Args args) {
    extern __shared__ __attribute__((aligned(16))) unsigned char lds_raw[];
    LAS unsigned char* lds = (LAS unsigned char*)lds_raw;
    volatile LAS unsigned* MISC = (volatile LAS unsigned*)(lds + MISC_OFF);
    const int tid = threadIdx.x, lane = tid & 63, wave = __builtin_amdgcn_readfirstlane(tid >> 6);
    const int G = gridDim.x; const int bx = blockIdx.x; const int vcu = (G % 8 == 0) ? (bx % 8) * (G / 8) + bx / 8 : bx;
    unsigned char* ws = args.ws;
    gu32* ctl = (gu32*)(ws + WS_CTL);
    const float* x = args.in[0]; const float* g_mix = args.in[1]; const float* w_in = args.in[2]; const float* b_in = args.in[3]; const float* sinks = args.in[4];
    const float* w_conv = args.in[5]; const float* w_attn_o = args.in[6]; const float* w_conv_o = args.in[7]; const float* w_out = args.in[8]; const float* g_ffn = args.in[9];
    const float* w_router = args.in[10]; const float* b_router = args.in[11]; const float* w_gate = args.in[12]; const float* b_gate = args.in[13]; const float* w_up = args.in[14];
    const float* b_up = args.in[15]; const float* w_down = args.in[16]; const float* b_down = args.in[17]; const float* g_final = args.in[18];
    float* out = args.out;
    float* binp = (float*)(ws + WS_BINP); float* bgu = (float*)(ws + WS_BGU); float* cosT = (float*)(ws + WS_COS); float* sinT = (float*)(ws + WS_SIN);
    bf16* Win_t = (bf16*)(ws + WS_WIN); bf16* Wao_t = (bf16*)(ws + WS_WAO); bf16* Wco_t = (bf16*)(ws + WS_WCO); bf16* Wout_t = (bf16*)(ws + WS_WOUT);
    bf16* XN = (bf16*)(ws + WS_XN); bf16* Qb = (bf16*)(ws + WS_Q); bf16* Kb = (bf16*)(ws + WS_K); bf16* Vb = (bf16*)(ws + WS_V); bf16* CB = (bf16*)(ws + WS_CB);
    bf16* MG = (bf16*)(ws + WS_MG); bf16* Ub = (bf16*)(ws + WS_U); bf16* SA = (bf16*)(ws + WS_SA); bf16* SC = (bf16*)(ws + WS_SC);
    bf16* Wgu_t = (bf16*)(ws + WS_WGU); bf16* Wd_t = (bf16*)(ws + WS_WD);
    int* tokrel = (int*)(ws + WS_TOKREL); float* rstdrel = (float*)(ws + WS_RSTDREL); unsigned* route = (unsigned*)(ws + WS_ROUTE); float* routew = (float*)(ws + WS_ROUTEW);
    bf16* ACT = (bf16*)(ws + WS_ACT); bf16* Yb = (bf16*)(ws + WS_Y); bf16* DLb = (bf16*)(ws + WS_DL);

    for (int u = tid; u < (LDS_BYTES - LDSCTL_OFF) / 4; u += NWAVES * 64) ((LAS unsigned*)(lds + LDSCTL_OFF))[u] = 0u;
    __syncthreads();
    XcdBarrier bar; bar.bar = (unsigned*)(ctl + CW_BAR); bar.x = 0; bar.st = nullptr;
    if (N_LAUNCHES != PER_PHASE) bar = xcd_barrier_post((unsigned*)(ctl + CW_BAR), MISC + 8);
#define GRID_BAR(seam) do { if (N_LAUNCHES == PER_PHASE) { if (tid == 0) __hip_atomic_store(ctl + CW_TMO, 0xBADBA0u | (unsigned)(seam), RLX_AGENT); } else { xcd_barrier(bar); } } while (0)
    const int lo = args.ph_lo, hi = args.ph_hi;
#define IN(k) (lo <= (k) && (k) < hi)
#define BOTH(k) (IN(k) && IN((k) + 1))
    const int gw = vcu * NWAVES + wave, NGW = G * NWAVES;
#define STAMP(k) do { if ((DBG_TIME_PH >= 0 || DBG_RVR_PH >= 0) && (k) < 16 && bx == 0 && tid == 0) __hip_atomic_store(ctl + CW_TS + (k), (unsigned)__builtin_amdgcn_s_memrealtime(), RLX_AGENT); } while (0)
    STAMP(0);

    LAS unsigned long long* ptab = (LAS unsigned long long*)(lds + TAB_OFF + 1600);
    if (tid == 0) { ptab[0] = (unsigned long long)w_attn_o; ptab[1] = (unsigned long long)w_conv_o; ptab[2] = (unsigned long long)w_out; ptab[3] = (unsigned long long)w_gate; ptab[4] = (unsigned long long)w_up; ptab[5] = (unsigned long long)w_down;
        ptab[6] = (unsigned long long)Wao_t; ptab[7] = (unsigned long long)Wco_t; ptab[8] = (unsigned long long)Wout_t; ptab[9] = (unsigned long long)Wgu_t; ptab[10] = (unsigned long long)Wgu_t; ptab[11] = (unsigned long long)Wd_t; }
    __syncthreads();
    const CvtSrc CS{w_in, Win_t, ptab};
    const int HELP = (HELPER_CUS > 0 && G == 256 && N_LAUNCHES == 1) ? HELPER_CUS : 0;
    if (IN(0)) {
        LAS unsigned char* scr = lds + RING_OFF + wave * 8704;
        cvt_run<0>(CS, gw, NGW, CVT_IN_ITEMS, scr, lane);
        if (HELP == 0) cvt_run<1>(CS, gw, NGW, CVT_REST_ITEMS - SLACK_P1_ITEMS - SLACK_P6_ITEMS, scr, lane);
        const int gt = vcu * (NWAVES * 64) + tid, NGT = G * NWAVES * 64;
        for (int c = gt; c < NIN; c += NGT) binp[win_dest(c)] = b_in[c];
        for (int i = gt; i < NEXP * DFF; i += NGT) { const int e = i >> 10, c = i & 1023; bgu[e * 2048 + map_dest(2, c)] = b_gate[i]; bgu[e * 2048 + map_dest(3, c)] = b_up[i]; }
        for (int i = gt; i < SEQ * 32; i += NGT) { const int pos = i >> 5, f = i & 31;
            const double inv = exp2(-(double)f * (13.287712379549449 / 32.0));
            const double rev = (double)pos * inv * 0.15915494309189535; const float fr = (float)(rev - rint(rev));
            cosT[i] = __builtin_amdgcn_cosf(fr); sinT[i] = __builtin_amdgcn_sinf(fr); }
        for (int m = gw; m < M; m += NGW) rms_row_to_bf16(x + (size_t)m * D, g_mix, XN + (size_t)m * D, lane);
        if (BOTH(0)) GRID_BAR(0); STAMP(1);
    }

#define STAGGER(S_, total_units) do { if (STAGGER_US > 0) { int nu_ = 0; pg8::Unit u_; while (S_.next(nu_, u_)) ++nu_; const int mx_ = ((total_units) + G - 1) / G; \
        if (nu_ < mx_) { const unsigned long long t0_ = __builtin_amdgcn_s_memrealtime(); while (__builtin_amdgcn_s_memrealtime() - t0_ < (unsigned long long)(STAGGER_US * 100)) __builtin_amdgcn_s_sleep(16); } } } while (0)
    if (IN(1)) {
        if (bx < G - HELP) {
            DenseOrder S{M / 256, NIN / 256, G - HELP, bx, D, (const char*)XN, (const char*)Win_t};
            EpiInProj E{Qb, Kb, Vb, CB, Ub, SA, SC, binp, cosT, sinT};
            if (HELP == 0) STAGGER(S, (M / 256) * (NIN / 256));
            if (HELP == 0) slack_convert(CS, (M / 256) * (NIN / 256), G, bx, CVT_REST_ITEMS - SLACK_P1_ITEMS - SLACK_P6_ITEMS, SLACK_P1_ITEMS, lds + RING_OFF + wave * 8704, wave, lane);
            __syncthreads();
            pg8::gemm_phase<EpiInProj, DenseOrder, true, false>(lds + RING_OFF, D, S, E, (DBG_KLOOP_PH == 1 && bx == 0) ? (unsigned*)(ctl + CW_TS + 16) : nullptr);
        } else {
            cvt_run<1>(CS, (bx - (G - HELP)) * NWAVES + wave, HELP * NWAVES, CVT_REST_ITEMS, lds + RING_OFF + wave * 8704, lane);
        }
        if (BOTH(1)) GRID_BAR(1); STAMP(2);
    }

    if (IN(2)) {
        const bool cinl = CONV_INLINE && G == 256 && BATCH * NKVH * (SEQ / 128) == 512;
        { constexpr int NU = BATCH * NKVH * (SEQ / 128); att::KVRegs R; int uu = vcu;
            LAS float* wcl = (LAS float*)(lds + RING_OFF + 104448);
            for (int i = tid; i < 768; i += 512) *(LAS f32x4*)(wcl + 4 * i) = *(const f32x4*)(w_conv + 4 * i);
            __syncthreads();
            att::ConvCtx CV; CV.Ub = Ub; CV.CB = CB; CV.w = wcl; CV.c0 = (tid & 127) * 8; CV.row = (cinl ? vcu : 0) * 64 + (tid >> 7) * 16; CV.on = cinl; CV.um2 = (v4u){0u, 0u, 0u, 0u}; CV.um1 = (v4u){0u, 0u, 0u, 0u};
            if (cinl && (CV.row & (SEQ - 1)) >= 2) { CV.um2 = *(const v4u*)(Ub + (size_t)(CV.row - 2) * 1024 + CV.c0); CV.um1 = *(const v4u*)(Ub + (size_t)(CV.row - 1) * 1024 + CV.c0); }
            if (KV_PREFETCH && uu < NU) att::attn_load(R, uu, Kb, Vb);
            while (uu < NU) { if (!KV_PREFETCH) att::attn_load(R, uu, Kb, Vb); att::attn_store(R, lds + RING_OFF); __syncthreads(); const int un = uu + G < NU ? uu + G : uu;
                att::attn_compute(lds + RING_OFF, uu, un, R, Qb, Kb, Vb, Qb, sinks, CV); uu += G; } }
        if (!cinl)
        for (int ch = vcu; ch < M / 64; ch += G) {
            const int c0 = (tid & 127) * 8, row0 = ch * 64 + (tid >> 7) * 16, pos0 = row0 & (SEQ - 1);
            float w0[8], w1[8], w2[8];
#pragma unroll
            for (int q = 0; q < 8; ++q) { w0[q] = w_conv[c0 + q]; w1[q] = w_conv[1024 + c0 + q]; w2[q] = w_conv[2048 + c0 + q]; }
            v4u um2 = {0u, 0u, 0u, 0u}, um1 = {0u, 0u, 0u, 0u};
            if (pos0 >= 2) { um2 = *(const v4u*)(Ub + (size_t)(row0 - 2) * 1024 + c0); um1 = *(const v4u*)(Ub + (size_t)(row0 - 1) * 1024 + c0); }
#pragma unroll 4
            for (int r = 0; r < 16; ++r) { const size_t off = (size_t)(row0 + r) * 1024 + c0;
                const v4u u0 = *(const v4u*)(Ub + off), cb = *(const v4u*)(CB + off); v4u o;
#define CONV2(F, qa) cvt_pk_bf16(bf_lo(cb.F) * (w0[qa] * bf_lo(um2.F) + w1[qa] * bf_lo(um1.F) + w2[qa] * bf_lo(u0.F)), bf_hi(cb.F) * (w0[qa + 1] * bf_hi(um2.F) + w1[qa + 1] * bf_hi(um1.F) + w2[qa + 1] * bf_hi(u0.F)))
                o.x = CONV2(x, 0); o.y = CONV2(y, 2); o.z = CONV2(z, 4); o.w = CONV2(w, 6);
#undef CONV2
                *(v4u*)(CB + off) = o; um2 = um1; um1 = u0; }
        }
        if (BOTH(2)) GRID_BAR(2); STAMP(3);
    }

    if (IN(3)) {
        MergeOrder S{M / 256, D / 256, G, bx, D, (const char*)Qb, (const char*)Wao_t, (const char*)CB, (const char*)Wco_t};
        EpiMerge E{SA, SC, MG};
        pg8::gemm_phase<EpiMerge, MergeOrder, true, false>(lds + RING_OFF, D, S, E, (DBG_KLOOP_PH == 3 && bx == 0) ? (unsigned*)(ctl + CW_TS + 16) : nullptr);
        if (BOTH(3)) GRID_BAR(3); STAMP(4);
    }

    if (IN(4)) {
        DenseOrder S{M / 256, D / 256, G, bx, D, (const char*)MG, (const char*)Wout_t};
        EpiRes E{DLb};
        pg8::gemm_phase<EpiRes, DenseOrder, false, false>(lds + RING_OFF, D, S, E, (DBG_KLOOP_PH == 4 && bx == 0) ? (unsigned*)(ctl + CW_TS + 16) : nullptr);
        if (BOTH(4)) GRID_BAR(4); STAMP(5);
    }

#if P5_MFMA
    if (IN(5)) {
        LAS float* GL = (LAS float*)(lds + RING_OFF);
        LAS float* PL = (LAS float*)(lds + RING_OFF + 4096);
        LAS float* PS = (LAS float*)(lds + RING_OFF + 4096 + 65536);
        LAS int* lcnt = (LAS int*)(lds + TOK_OFF); LAS int* lbase = lcnt + 32; LAS unsigned* ce = (LAS unsigned*)(lds + TOK_OFF + 256); LAS int* cr = (LAS int*)(lds + TOK_OFF + 256 + 1024); LAS float* cw = (LAS float*)(lds + TOK_OFF + 256 + 2048);
        LAS float* crs = (LAS float*)(lds + TOK_OFF + 256 + 3072);
        for (int i = tid; i < 256; i += 512) *(LAS f32x4*)(GL + 4 * i) = *(const f32x4*)(g_ffn + 4 * i);
        __syncthreads();
        const int r32 = lane & 31, kh = lane >> 5, kb = 128 * wave;
        const float brt = b_router[r32];
        bf16x8 Bh[8], Bl[8];
#pragma unroll
        for (int f = 0; f < 8; ++f) { const int k0 = kb + 32 * (f >> 1) + 16 * kh + 8 * (f & 1);
            const f32x4 g0 = *(const LAS f32x4*)(GL + k0), g1 = *(const LAS f32x4*)(GL + k0 + 4);
            float wv[8];
#pragma unroll
            for (int j = 0; j < 8; ++j) wv[j] = w_router[(size_t)(k0 + j) * 32 + r32] * (j < 4 ? g0[j] : g1[j - 4]);
            v4u hw, lw;
#define SPLIT2(dsth, dstl, a_, b_) do { const unsigned h_ = cvt_pk_bf16(a_, b_); dsth = h_; dstl = cvt_pk_bf16((a_) - bf_lo(h_), (b_) - bf_hi(h_)); } while (0)
            SPLIT2(hw.x, lw.x, wv[0], wv[1]); SPLIT2(hw.y, lw.y, wv[2], wv[3]); SPLIT2(hw.z, lw.z, wv[4], wv[5]); SPLIT2(hw.w, lw.w, wv[6], wv[7]);
            Bh[f] = __builtin_bit_cast(bf16x8, hw); Bl[f] = __builtin_bit_cast(bf16x8, lw); }
        for (int ch = vcu; ch < M / 64; ch += G) {
            if (tid < 32) lcnt[tid] = 0;
            f32x16 acc[2]; acc[0] = f32x16{}; acc[1] = f32x16{}; float ss[2] = {0.f, 0.f};
#define P5M_LOADG(XQ, DQ, mt_, sp_) do { const size_t ro_ = (size_t)(ch * 64 + 32 * (mt_) + r32) * D + kb + 16 * kh + 64 * (sp_); \
                _Pragma("unroll") for (int S_ = 0; S_ < 2; ++S_) { _Pragma("unroll") for (int q = 0; q < 4; ++q) XQ[S_][q] = *(const f32x4*)(x + ro_ + 32 * S_ + 4 * q); \
                    DQ[S_][0] = *(const v4u*)(DLb + ro_ + 32 * S_); DQ[S_][1] = *(const v4u*)(DLb + ro_ + 32 * S_ + 8); } } while (0)
#define P5M_PROC(XQ, DQ, mt_, sp_) do { const size_t ro_ = (size_t)(ch * 64 + 32 * (mt_) + r32) * D + kb + 16 * kh + 64 * (sp_); \
                _Pragma("unroll") for (int S_ = 0; S_ < 2; ++S_) { const int S = 2 * (sp_) + S_; float x1[16]; \
                    _Pragma("unroll") for (int q = 0; q < 4; ++q) { x1[4 * q] = XQ[S_][q].x; x1[4 * q + 1] = XQ[S_][q].y; x1[4 * q + 2] = XQ[S_][q].z; x1[4 * q + 3] = XQ[S_][q].w; } \
                    _Pragma("unroll") for (int h = 0; h < 2; ++h) { const v4u d = DQ[S_][h]; \
                        x1[8 * h + 0] += bf_lo(d.x); x1[8 * h + 1] += bf_hi(d.x); x1[8 * h + 2] += bf_lo(d.y); x1[8 * h + 3] += bf_hi(d.y); \
                        x1[8 * h + 4] += bf_lo(d.z); x1[8 * h + 5] += bf_hi(d.z); x1[8 * h + 6] += bf_lo(d.w); x1[8 * h + 7] += bf_hi(d.w); } \
                    float s_ = 0.f; \
                    _Pragma("unroll") for (int j = 0; j < 16; ++j) s_ += x1[j] * x1[j]; \
                    ss[mt_] += s_; \
                    const int kk = kb + 32 * S + 16 * kh; v4u o0, o1; \
                    { const f32x4 g0 = *(const LAS f32x4*)(GL + kk), g1 = *(const LAS f32x4*)(GL + kk + 4), g2 = *(const LAS f32x4*)(GL + kk + 8), g3 = *(const LAS f32x4*)(GL + kk + 12); \
                      o0.x = cvt_pk_bf16(x1[0] * g0.x, x1[1] * g0.y); o0.y = cvt_pk_bf16(x1[2] * g0.z, x1[3] * g0.w); o0.z = cvt_pk_bf16(x1[4] * g1.x, x1[5] * g1.y); o0.w = cvt_pk_bf16(x1[6] * g1.z, x1[7] * g1.w); \
                      o1.x = cvt_pk_bf16(x1[8] * g2.x, x1[9] * g2.y); o1.y = cvt_pk_bf16(x1[10] * g2.z, x1[11] * g2.w); o1.z = cvt_pk_bf16(x1[12] * g3.x, x1[13] * g3.y); o1.w = cvt_pk_bf16(x1[14] * g3.z, x1[15] * g3.w); } \
                    *(v4u*)(XN + ro_ + 32 * S_) = o0; *(v4u*)(XN + ro_ + 32 * S_ + 8) = o1; \
                    _Pragma("unroll") for (int q = 0; q < 2; ++q) { v4u hw, lw; \
                        SPLIT2(hw.x, lw.x, x1[8 * q + 0], x1[8 * q + 1]); SPLIT2(hw.y, lw.y, x1[8 * q + 2], x1[8 * q + 3]); SPLIT2(hw.z, lw.z, x1[8 * q + 4], x1[8 * q + 5]); SPLIT2(hw.w, lw.w, x1[8 * q + 6], x1[8 * q + 7]); \
                        const bf16x8 Ah = __builtin_bit_cast(bf16x8, hw), Al = __builtin_bit_cast(bf16x8, lw); \
                        acc[mt_] = __builtin_amdgcn_mfma_f32_32x32x16_bf16(Ah, Bh[2 * S + q], acc[mt_], 0, 0, 0); \
                        acc[mt_] = __builtin_amdgcn_mfma_f32_32x32x16_bf16(Al, Bh[2 * S + q], acc[mt_], 0, 0, 0); \
                        acc[mt_] = __builtin_amdgcn_mfma_f32_32x32x16_bf16(Ah, Bl[2 * S + q], acc[mt_], 0, 0, 0); } } } while (0)
            { f32x4 xa_[2][4], xb_[2][4]; v4u da_[2][2], db_[2][2];
              P5M_LOADG(xa_, da_, 0, 0); P5M_LOADG(xb_, db_, 0, 1);
              P5M_PROC(xa_, da_, 0, 0); P5M_LOADG(xa_, da_, 1, 0);
              P5M_PROC(xb_, db_, 0, 1); P5M_LOADG(xb_, db_, 1, 1);
              P5M_PROC(xa_, da_, 1, 0); P5M_PROC(xb_, db_, 1, 1); }
#undef P5M_LOADG
#undef P5M_PROC
#undef SPLIT2
#pragma unroll
            for (int mt = 0; mt < 2; ++mt) { const float st = ss[mt] + __shfl_xor(ss[mt], 32); if (kh == 0) PS[wave * 64 + 32 * mt + r32] = st;
#pragma unroll
                for (int r = 0; r < 16; ++r) PL[(wave * 64 + 32 * mt + ((r & 3) + 8 * (r >> 2) + 4 * kh)) * 32 + r32] = acc[mt][r]; }
            __syncthreads();
#define P5_ROWPOST(lgin, tl_) do { float lg = lgin; int te[4]; float tlg[4]; \
                _Pragma("unroll") for (int k = 0; k < 4; ++k) { const float mx = half_max_dpp(lg); const unsigned long long bm = __ballot(lg == mx); const int sel = __builtin_ctzll(bm); te[k] = sel; tlg[k] = mx; if ((lane & 31) == sel) lg = -INFINITY; } \
                const float e1 = __expf(tlg[1] - tlg[0]), e2 = __expf(tlg[2] - tlg[0]), e3 = __expf(tlg[3] - tlg[0]), inv = 1.0f / (1.0f + e1 + e2 + e3); \
                if (lane < 4) { const int ek = lane == 0 ? te[0] : lane == 1 ? te[1] : lane == 2 ? te[2] : te[3]; const float wk = (lane == 0 ? 1.0f : lane == 1 ? e1 : lane == 2 ? e2 : e3) * inv; \
                    const int r = atomicAdd((int*)(lcnt + ek), 1); ce[(tl_) * 4 + lane] = (unsigned)ek; cr[(tl_) * 4 + lane] = r; cw[(tl_) * 4 + lane] = wk; } } while (0)
#pragma unroll 1
            for (int rr = 0; rr < 8; ++rr) { const int tl = wave * 8 + rr; float lgs = 0.f, sq = 0.f;
#pragma unroll
                for (int w2 = 0; w2 < 8; ++w2) { lgs += PL[(w2 * 64 + tl) * 32 + r32]; sq += PS[w2 * 64 + tl]; }
                const float rstd = 1.f / sqrtf(sq * (1.f / D) + RMS_EPS);
                if (lane == 0) crs[tl] = rstd;
                P5_ROWPOST(lgs * rstd + brt, tl); }
#undef P5_ROWPOST
            __syncthreads();
            if (tid < 32) lbase[tid] = (int)__hip_atomic_fetch_add(ctl + CW_CURSOR + 64 * tid, (unsigned)lcnt[tid], RLX_AGENT);
            __syncthreads();
            if (tid < 256) { const int t = ch * 64 + (tid >> 2); const unsigned e = ce[tid]; const int rel = lbase[e] + cr[tid];
                tokrel[e * SLOTCAP + rel] = t; rstdrel[e * SLOTCAP + rel] = crs[tid >> 2]; route[t * 4 + (tid & 3)] = e | ((unsigned)rel << 8); routew[t * 4 + (tid & 3)] = cw[tid]; }
            __syncthreads();
        }
        if (BOTH(5)) GRID_BAR(5); STAMP(6);
    }
#else
    if (IN(5)) {
        LAS float* wT = (LAS float*)(lds + RING_OFF);
        { f32x4 wv[16];
#pragma unroll
          for (int k = 0; k < 16; ++k) { const int idx = tid + 512 * k, c = idx & 1023, e4 = idx >> 10; wv[k] = *(const f32x4*)(w_router + (size_t)c * 32 + e4 * 4); }
#pragma unroll
          for (int k = 0; k < 16; ++k) { const int idx = tid + 512 * k, c = idx & 1023, e4 = idx >> 10;
            wT[(e4 * 4 + 0) * 1024 + c] = wv[k].x; wT[(e4 * 4 + 1) * 1024 + c] = wv[k].y; wT[(e4 * 4 + 2) * 1024 + c] = wv[k].z; wT[(e4 * 4 + 3) * 1024 + c] = wv[k].w; } }
        LAS int* lcnt = (LAS int*)(lds + TOK_OFF); LAS int* lbase = lcnt + 32; LAS unsigned* ce = (LAS unsigned*)(lds + TOK_OFF + 256); LAS int* cr = (LAS int*)(lds + TOK_OFF + 256 + 1024); LAS float* cw = (LAS float*)(lds + TOK_OFF + 256 + 2048);
        const int psrc = 4 * ((lane & 48) | ((lane & 1) << 3) | ((lane & 2) << 1) | ((lane & 4) >> 1) | ((lane & 8) >> 3));
        const float brt = b_router[lane & 31];
        f32x4 gf[4];
#pragma unroll
        for (int j = 0; j < 4; ++j) gf[j] = *(const f32x4*)(g_ffn + 4 * lane + 256 * j);
        for (int ch = vcu; ch < M / 64; ch += G) {
            if (tid < 32) lcnt[tid] = 0;
            __syncthreads();
#define P5_LOADROW(dst, dd, t_) _Pragma("unroll") for (int j = 0; j < 4; ++j) { dst[j] = *(const f32x4*)(x + (size_t)(t_) * D + 4 * lane + 256 * j); dd[j] = *(const v2u*)(DLb + (size_t)(t_) * D + 4 * lane + 256 * j); }
#define P5_ADDD(dst, dd) _Pragma("unroll") for (int j = 0; j < 4; ++j) { dst[j].x += bf_lo(dd[j].x); dst[j].y += bf_hi(dd[j].x); dst[j].z += bf_lo(dd[j].y); dst[j].w += bf_hi(dd[j].y); }
#define P5_BFLY(v, NV, MK) _Pragma("unroll") for (int i = 0; i < NV; ++i) { const bool up = (lane & MK) != 0; const float send = up ? v[i] : v[i + NV], keep = up ? v[i + NV] : v[i]; v[i] = keep + __shfl_xor(send, MK); }
#define P5_ROWPOST(lgin, tl_) do { float lg = __builtin_bit_cast(float, __builtin_amdgcn_ds_bpermute(psrc, __builtin_bit_cast(int, lgin))) + brt; int te[4]; float tlg[4];     \
                _Pragma("unroll") for (int k = 0; k < 4; ++k) { const float mx = half_max_dpp(lg); const unsigned long long bm = __ballot(lg == mx); const int sel = __builtin_ctzll(bm); te[k] = sel; tlg[k] = mx; if ((lane & 31) == sel) lg = -INFINITY; } \
                const float e1 = __expf(tlg[1] - tlg[0]), e2 = __expf(tlg[2] - tlg[0]), e3 = __expf(tlg[3] - tlg[0]), inv = 1.0f / (1.0f + e1 + e2 + e3); \
                if (lane < 4) { const int ek = lane == 0 ? te[0] : lane == 1 ? te[1] : lane == 2 ? te[2] : te[3]; const float wk = (lane == 0 ? 1.0f : lane == 1 ? e1 : lane == 2 ? e2 : e3) * inv; \
                    const int r = atomicAdd((int*)(lcnt + ek), 1); ce[(tl_) * 4 + lane] = (unsigned)ek; cr[(tl_) * 4 + lane] = r; cw[(tl_) * 4 + lane] = wk; } } while (0)
            f32x4 xa[4], xb[4]; v2u da[4], db[4];
            P5_LOADROW(xa, da, ch * 64 + wave * 8); P5_LOADROW(xb, db, ch * 64 + wave * 8 + 1);
#pragma unroll 1
            for (int pp = 0; pp < 4; ++pp) {
                const int tl = wave * 8 + 2 * pp, t = ch * 64 + tl, tn = pp < 3 ? t + 2 : t;
                f32x4 na[4], nb[4]; v2u nda[4], ndb[4];
                P5_LOADROW(na, nda, tn); P5_LOADROW(nb, ndb, tn + 1);
                P5_ADDD(xa, da); P5_ADDD(xb, db);
                float sa = 0.f, sb = 0.f;
#pragma unroll
                for (int j = 0; j < 4; ++j) { sa += (xa[j].x * xa[j].x + xa[j].y * xa[j].y) + (xa[j].z * xa[j].z + xa[j].w * xa[j].w); sb += (xb[j].x * xb[j].x + xb[j].y * xb[j].y) + (xb[j].z * xb[j].z + xb[j].w * xb[j].w); }
                const float rstda = 1.f / sqrtf(wave_sum_dpp(sa) * (1.f / D) + RMS_EPS), rstdb = 1.f / sqrtf(wave_sum_dpp(sb) * (1.f / D) + RMS_EPS);
#pragma unroll
                for (int j = 0; j < 4; ++j) { xa[j] = xa[j] * rstda * gf[j]; xb[j] = xb[j] * rstdb * gf[j];
                    v2u w; w.x = cvt_pk_bf16(xa[j].x, xa[j].y); w.y = cvt_pk_bf16(xa[j].z, xa[j].w); *(v2u*)(XN + (size_t)t * D + 4 * lane + 256 * j) = w;
                    v2u w2; w2.x = cvt_pk_bf16(xb[j].x, xb[j].y); w2.y = cvt_pk_bf16(xb[j].z, xb[j].w); *(v2u*)(XN + (size_t)(t + 1) * D + 4 * lane + 256 * j) = w2; }
                f32x2 x2[4][4];
#pragma unroll
                for (int j = 0; j < 4; ++j) { x2[j][0] = (f32x2){xa[j].x, xb[j].x}; x2[j][1] = (f32x2){xa[j].y, xb[j].y}; x2[j][2] = (f32x2){xa[j].z, xb[j].z}; x2[j][3] = (f32x2){xa[j].w, xb[j].w}; }
                float lga, lgb;
                { float h0a, h0b, h1a, h1b;
#define P5_HALF(E0, ra, rb) do { float va[16], vb[16]; \
                    _Pragma("unroll") for (int e = 0; e < 16; ++e) { f32x2 a2 = {0.f, 0.f}, c2 = {0.f, 0.f};     \
                        _Pragma("unroll") for (int j = 0; j < 4; ++j) { const f32x4 w4 = *(const LAS f32x4*)(wT + ((E0) + e) * 1024 + 4 * lane + 256 * j); \
                            a2 += x2[j][0] * (f32x2){w4.x, w4.x}; c2 += x2[j][1] * (f32x2){w4.y, w4.y}; a2 += x2[j][2] * (f32x2){w4.z, w4.z}; c2 += x2[j][3] * (f32x2){w4.w, w4.w}; } \
                        a2 += c2; va[e] = a2.x; vb[e] = a2.y; } \
                    P5_BFLY(va, 8, 1) P5_BFLY(va, 4, 2) P5_BFLY(va, 2, 4) P5_BFLY(va, 1, 8) P5_BFLY(vb, 8, 1) P5_BFLY(vb, 4, 2) P5_BFLY(vb, 2, 4) P5_BFLY(vb, 1, 8) \
                    float ta = va[0] + __shfl_xor(va[0], 16), tb = vb[0] + __shfl_xor(vb[0], 16); ra = ta + __shfl_xor(ta, 32); rb = tb + __shfl_xor(tb, 32); } while (0)
                  P5_HALF(0, h0a, h0b); __builtin_amdgcn_sched_barrier(0); P5_HALF(16, h1a, h1b); __builtin_amdgcn_sched_barrier(0);
#undef P5_HALF
                  lga = (lane & 16) ? h1a : h0a; lgb = (lane & 16) ? h1b : h0b; }
                P5_ROWPOST(lga, tl); __builtin_amdgcn_sched_barrier(0); P5_ROWPOST(lgb, tl + 1);
#pragma unroll
                for (int j = 0; j < 4; ++j) { xa[j] = na[j]; xb[j] = nb[j]; da[j] = nda[j]; db[j] = ndb[j]; }
            }
#undef P5_LOADROW
#undef P5_ADDD
#undef P5_BFLY
#undef P5_ROWPOST
            __syncthreads();
            if (tid < 32) lbase[tid] = (int)__hip_atomic_fetch_add(ctl + CW_CURSOR + 64 * tid, (unsigned)lcnt[tid], RLX_AGENT);
            __syncthreads();
            if (tid < 256) { const int t = ch * 64 + (tid >> 2); const unsigned e = ce[tid]; const int rel = lbase[e] + cr[tid];
                tokrel[e * SLOTCAP + rel] = t; route[t * 4 + (tid & 3)] = e | ((unsigned)rel << 8); routew[t * 4 + (tid & 3)] = cw[tid]; }
            __syncthreads();
        }
        if (BOTH(5)) GRID_BAR(5); STAMP(6);
    }
#endif


    LAS int* t_cnt = (LAS int*)(lds + TAB_CNT); LAS int* t_start = (LAS int*)(lds + TAB_TSTART); LAS int* t_tile = (LAS int*)(lds + TAB_TILEE);
    if (IN(6) || IN(7) || IN(8)) {
        if (tid < 32) t_cnt[tid] = (int)__hip_atomic_load(ctl + CW_CURSOR + 64 * tid, RLX_AGENT);
        __syncthreads();
        if (tid == 0) { int s = 0; for (int e = 0; e < 32; ++e) { t_start[e] = s; s += (t_cnt[e] + 255) >> 8; } t_start[32] = s; }
        __syncthreads();
        for (int i = tid; i < 320; i += 512) { int e = 0; for (int k = 1; k < 32; ++k) if (i >= t_start[k]) e = k; t_tile[i] = e; }
        __syncthreads();
    }
    const int MT = (IN(6) || IN(7) || IN(8)) ? t_start[32] : 0;

    if (IN(6)) {
        LAS unsigned* tokt = (LAS unsigned*)(lds + TOK_OFF);
        MoeOrder S{MT, G, bx, (const char*)XN, (const char*)ACT, (const char*)Wgu_t, (const char*)Wd_t, t_tile, tokt, (unsigned*)(ctl + CW_MT), (unsigned*)(ctl + CW_TMO), MOE_MERGED ? 0 : 1, 0};
        for (int i0 = 0; i0 < MAXU; i0 += 2) { const int i = i0 + (tid >> 8), r = tid & 255; pg8::Unit u;
            if (i < MAXU && S.next(i, u) && u.aux == 2) { const int e = u.e, rel = (u.pm - t_start[e]) * 256 + r; const int tok = rel < t_cnt[e] ? tokrel[e * SLOTCAP + rel] : 0; tokt[i * 256 + r] = (unsigned)tok * 2048u; } }
        __syncthreads();
        EpiMoe E{EpiGU{ACT, bgu, rstdrel, t_start}, EpiDown{Yb, b_down}};
        if (!MOE_MERGED) STAGGER(S, MT * 8);
        slack_convert(CS, MT * 8, G, bx, CVT_REST_ITEMS - SLACK_P6_ITEMS, SLACK_P6_ITEMS, lds + RING_OFF + wave * 8704, wave, lane);
        __syncthreads();
        if (MOE_MERGED) pg8::gemm_phase<EpiMoe, MoeOrder, true, true>(lds + RING_OFF, D, S, E, (DBG_KLOOP_PH == 6 && bx == 0) ? (unsigned*)(ctl + CW_TS + 16) : nullptr);
        else { EpiGU Eg{ACT, bgu, rstdrel, t_start}; pg8::gemm_phase<EpiGU, MoeOrder, true, true, false, PF_P6 != 0>(lds + RING_OFF, D, S, Eg, (DBG_KLOOP_PH == 6 && bx == 0) ? (unsigned*)(ctl + CW_TS + 16) : nullptr); }
        if (MOE_MERGED ? IN(8) : BOTH(6)) GRID_BAR(6); STAMP(7);
    }
    if (IN(7)) {
        if (!MOE_MERGED) {
            const int U7 = MT * 4, full7 = (U7 / G) * G, ntail = U7 - full7; const bool split = HALF_TAIL && ntail > 0 && 2 * ntail <= G;
            MoeOrder S{MT, G, bx, (const char*)XN, (const char*)ACT, (const char*)Wgu_t, (const char*)Wd_t, t_tile, (const LAS unsigned*)(lds + TOK_OFF), (unsigned*)(ctl + CW_MT), (unsigned*)(ctl + CW_TMO), 2, split ? full7 : U7};
            EpiMoe E{EpiGU{ACT, bgu, rstdrel, t_start}, EpiDown{Yb, b_down}};
            STAGGER(S, MT * 4);
            EpiDownX Ed{EpiDown{Yb, b_down}};
            pg8::gemm_phase<EpiDownX, MoeOrder, true, false, false, PF_P7 != 0>(lds + RING_OFF, D, S, Ed, (DBG_KLOOP_PH == 7 && bx == 0) ? (unsigned*)(ctl + CW_TS + 16) : nullptr);
            if (split && bx < 2 * ntail) { TailOrder T{MT, full7, bx, (const char*)ACT, (const char*)Wd_t, t_tile};
                pg8::gemm_phase<EpiDownX, TailOrder, false, false, true>(lds + RING_OFF, D, T, Ed); }
            if (BOTH(7)) GRID_BAR(7);
        }
        STAMP(8);
    }

    if (IN(8)) {
        f32x4 gf[4];
        float dbg_scale = 1.0f;
        if (DBG_RVR_PH >= 0) { const unsigned t0 = __hip_atomic_load(ctl + CW_TS + (DBG_RVR_PH >= 0 ? DBG_RVR_PH : 0), RLX_AGENT), t1 = __hip_atomic_load(ctl + CW_TS + (DBG_RVR_PH >= 0 ? DBG_RVR_PH : 0) + 1, RLX_AGENT);
            const float fr_ = fminf((float)(t1 - t0) * (0.01f / 350.0f), 1.0f); dbg_scale = 1.0f + sqrtf(0.0035f * fr_); }
#pragma unroll
        for (int j = 0; j < 4; ++j) gf[j] = *(const f32x4*)(g_final + 4 * lane + 256 * j);
        for (int t = gw; t < M; t += NGW) {
            f32x4 a[4];
#pragma unroll
            for (int j = 0; j < 4; ++j) { const f32x4 xv = *(const f32x4*)(x + (size_t)t * D + 4 * lane + 256 * j); const v2u dv = *(const v2u*)(DLb + (size_t)t * D + 4 * lane + 256 * j);
                a[j] = (f32x4){xv.x + bf_lo(dv.x), xv.y + bf_hi(dv.x), xv.z + bf_lo(dv.y), xv.w + bf_hi(dv.y)}; }
#pragma unroll
            for (int k = 0; k < 4; ++k) { const unsigned rt = route[t * 4 + k]; const float w = routew[t * 4 + k]; const int e = rt & 255u, rel = rt >> 8;
                const bf16* yr = Yb + ((size_t)t_start[e] * 256 + rel) * 1024 + 4 * lane;
#pragma unroll
                for (int j = 0; j < 4; ++j) { const v2u y = *(const v2u*)(yr + 256 * j); a[j].x += w * bf_lo(y.x); a[j].y += w * bf_hi(y.x); a[j].z += w * bf_lo(y.y); a[j].w += w * bf_hi(y.y); } }
            float s = 0.f;
#pragma unroll
            for (int j = 0; j < 4; ++j) s += (a[j].x * a[j].x + a[j].y * a[j].y) + (a[j].z * a[j].z + a[j].w * a[j].w);
            const float rstd = 1.f / sqrtf(wave_sum(s) * (1.f / D) + RMS_EPS);
#pragma unroll
            for (int j = 0; j < 4; ++j) *(f32x4*)(out + (size_t)t * D + 4 * lane + 256 * j) = a[j] * (rstd * dbg_scale) * gf[j];
        }
        STAMP(9);
        if (DBG_TIME_PH >= 0 && bx == 0 && tid == 0) { const unsigned t0 = __hip_atomic_load(ctl + CW_TS + DBG_TIME_PH, RLX_AGENT), t1 = __hip_atomic_load(ctl + CW_TS + DBG_TIME_PH + 1, RLX_AGENT);
            const unsigned span = 4u * (t1 - t0); const unsigned ts = (unsigned)__builtin_amdgcn_s_memrealtime(); while ((unsigned)__builtin_amdgcn_s_memrealtime() - ts < span) __builtin_amdgcn_s_sleep(8); }
    }
#undef IN
#undef BOTH
#undef GRID_BAR
}

extern "C" void kernel_launch(void* const* d_in, const int* in_sizes, int n_in, void* d_out, int out_size, void* d_ws, size_t ws_size, hipStream_t stream) {
    static int grid = 0;
    if (grid == 0) {
        if (n_in != 19 || in_sizes[0] != M * D || out_size != M * D || ws_size < WS_END) { fprintf(stderr, "kernel_launch: unexpected shapes (n_in %d, in0 %d, out %d, ws %zu)\n", n_in, n_in > 0 ? in_sizes[0] : -1, out_size, ws_size); grid = -1; return; }
        int dev = 0, cus = 0, per_cu = 0;
        if (hipGetDevice(&dev) != hipSuccess || hipDeviceGetAttribute(&cus, hipDeviceAttributeMultiprocessorCount, dev) != hipSuccess) { grid = -1; return; }
        if (hipFuncSetAttribute((const void*)fwd_kernel, hipFuncAttributeMaxDynamicSharedMemorySize, LDS_BYTES) != hipSuccess) { fprintf(stderr, "kernel_launch: hipFuncSetAttribute failed\n"); grid = -1; return; }
        if (hipOccupancyMaxActiveBlocksPerMultiprocessor(&per_cu, (const void*)fwd_kernel, NWAVES * 64, LDS_BYTES) != hipSuccess || per_cu < 1)
            fprintf(stderr, "kernel_launch: note: occupancy query reports %d workgroups per CU\n", per_cu);
        (void)hipGetLastError();
        grid = cus;
    }
    if (grid < 0) return;
    if (hipMemsetAsync((char*)d_ws + WS_CTL, 0, CTL_ZERO_BYTES, stream) != hipSuccess) { fprintf(stderr, "kernel_launch: hipMemsetAsync failed\n"); return; }
    Args a{};
    for (int i = 0; i < 19; ++i) a.in[i] = (const float*)d_in[i];
    a.out = (float*)d_out; a.ws = (unsigned char*)d_ws;
    for (int li = 0; li < N_LAUNCHES; ++li) {
        a.ph_lo = (N_LAUNCHES == PER_PHASE) ? li : 0; a.ph_hi = (N_LAUNCHES == PER_PHASE) ? li + 1 : PER_PHASE; a.li = li;
        hipLaunchKernelGGL(fwd_kernel, dim3(grid), dim3(NWAVES * 64), LDS_BYTES, stream, a);
        const hipError_t le = hipPeekAtLastError();
        if (le != hipSuccess) { fprintf(stderr, "kernel_launch: launch %d failed: %s\n", li, hipGetErrorName(le)); break; }
    }
}
```

```cpp
#include <hip/hip_runtime.h>
#include <cstdio>
#include <cstdint>

#ifndef MK_N_LAUNCHES
#define MK_N_LAUNCHES 1
#endif

#ifndef MOE_MERGED
#define MOE_MERGED 0
#endif
#ifndef RELAX_POST_EPI
#define RELAX_POST_EPI 0
#endif
#ifndef STAGGER_US
#define STAGGER_US 0
#endif
#ifndef P7_REVERSE
#define P7_REVERSE 0
#endif
#ifndef KEEP_WD
#define KEEP_WD 0
#endif
#ifndef P5_MFMA
#define P5_MFMA 1
#endif
#ifndef PF_P6
#define PF_P6 0
#endif
#ifndef PF_P7
#define PF_P7 0
#endif
#ifndef KV_PREFETCH
#define KV_PREFETCH 0
#endif
#ifndef FOLD_G
#define FOLD_G (P5_MFMA)
#endif
#ifndef CONV_INLINE
#define CONV_INLINE 1
#endif
#ifndef HALF_TAIL
#define HALF_TAIL 1
#endif
#ifndef DBG_TIME_PH
#define DBG_TIME_PH (-1)
#endif
#ifndef DBG_KLOOP_PH
#define DBG_KLOOP_PH (-1)
#endif
#ifndef DBG_RVR_PH
#define DBG_RVR_PH (-1)
#endif
namespace pg8 {
#define PG8_LAS __attribute__((address_space(3)))
typedef unsigned short bf16_t;
typedef short bf16x8 __attribute__((ext_vector_type(8)));
typedef float f32x4 __attribute__((ext_vector_type(4)));
typedef unsigned u32x4 __attribute__((ext_vector_type(4)));
typedef unsigned u32x2 __attribute__((ext_vector_type(2)));
constexpr int BM = 256, BK = 64, HALF = 128, HTB = HALF * BK * 2  , STAGE_BYTES = 8 * HTB, NXCD = 8;
constexpr int PFD = 6;
constexpr int PF_LDS_OFF = 150016 + 4096;
constexpr int BIAS_LDS_OFF = 150016;

__host__ __device__ __forceinline__ int lds_byte(int r, int c) { const int st = (r >> 4) * 2 + (c >> 5), rr = r & 15, cc = c & 31, ob = rr * 64 + cc * 2; return st * 1024 + (ob ^ (((ob >> 9) & 1) << 5)); }
__host__ __device__ __forceinline__ void stage_rc(int b, int& R, int& C) { const int st = b / 1024, sb = b % 1024, swz = sb ^ (((sb >> 9) & 1) << 5); R = (st >> 1) * 16 + swz / 64; C = (st & 1) * 32 + (swz % 64) / 2; }
__host__ __device__ __forceinline__ int perm32(int rho) { const int n = rho >> 4, i = rho & 15; return 8 * (i >> 2) + 4 * n + (i & 3); }

struct Unit { int pm, pn, e, aux; bool keep; const char* a; const char* b; int rofs; };

#ifndef WGM_DENSE
#define WGM_DENSE 4
#endif
#ifndef WGM_MOE
#define WGM_MOE 4
#endif
#ifndef WGM_MOE2
#define WGM_MOE2 4
#endif
__host__ __device__ __forceinline__ bool tile_of(long L, int nM, int nN, int& pm, int& pn, const int WGM = WGM_DENSE) {
    const int nwg = nM * nN; if (L >= nwg) return false;
    int wgid = (int)L; { const int q = nwg / NXCD, r = nwg % NXCD, xcd = wgid % NXCD, off = wgid / NXCD; wgid = (xcd < r ? xcd * (q + 1) : r * (q + 1) + (xcd - r) * q) + off; }
    const int nig = WGM * nN, gid = wgid / nig, fm = gid * WGM, gsz = (nM - fm) < WGM ? (nM - fm) : WGM;
    pm = fm + ((wgid % nig) % gsz); pn = (wgid % nig) / gsz; return true;
}

__device__ __forceinline__ unsigned cvt_pk_bf16(float lo, float hi) { unsigned r; asm volatile("v_cvt_pk_bf16_f32 %0, %1, %2" : "=v"(r) : "v"(lo), "v"(hi)); return r; }
__device__ __forceinline__ float bf_lo(unsigned w) { return __uint_as_float(w << 16); }
__device__ __forceinline__ float bf_hi(unsigned w) { return __uint_as_float(w & 0xffff0000u); }
__device__ __forceinline__ float sigmoidf_(float x) { return __builtin_amdgcn_rcpf(1.0f + __builtin_amdgcn_exp2f(x * -1.4426950408889634f)); }

template <class Epi, class Sched, bool ALIGN_EPI, bool GATHER, bool HALFM = false, bool PF = false>
__device__ __forceinline__ void gemm_phase(PG8_LAS unsigned char* lds, const int K, const Sched& S, const Epi& E, unsigned* dbg = nullptr) {
    const int tid = threadIdx.x, wid = __builtin_amdgcn_readfirstlane(tid >> 6), lane = tid & 63, wr = wid >> 2, wc = wid & 3, fr = lane & 15, fq = lane >> 4;
    const int nt = K / BK;
    unsigned voffA[2], voffB[2]; int RA[2]; unsigned CA2[2];
#pragma unroll
    for (int i = 0; i < 2; ++i) { int R, C; stage_rc(tid * 16 + i * 8192, R, C); const int Rb = Epi::PERM ? ((R & ~31) + perm32(R & 31)) : R;
        voffA[i] = (unsigned)(R * K + C) * 2u; voffB[i] = (unsigned)(Rb * K + C) * 2u; RA[i] = R; CA2[i] = (unsigned)C * 2u; }
    const size_t kstep = (size_t)(BK * 2);
    const size_t hstep = (size_t)HALF * K * 2;
    const unsigned ldsw = (unsigned)wid * 1024u;
    const int aoff = lds_byte(wr * 64 + fr, fq * 8), boff = lds_byte(wc * 32 + fr, fq * 8);
#define PG8_SA(b, h) (((b) * 2 + (h)) * HTB)
#define PG8_SB(b, h) ((4 + (b) * 2 + (h)) * HTB)
#define PG8_GLDS(src, dstoff) __builtin_amdgcn_global_load_lds((const unsigned*)(src), (PG8_LAS unsigned*)(lds + (dstoff)), 16, 0, 0)
#define PG8_STAGE_B(bufoff, gbase) do { PG8_GLDS((const char*)(gbase) + voffB[0], (bufoff) + ldsw); PG8_GLDS((const char*)(gbase) + voffB[1], (bufoff) + ldsw + 8192); } while (0)
#define PG8_STAGE_A(bufoff, gbase, h, o0, o1) do { \
        if constexpr (GATHER) { PG8_GLDS((const char*)(gbase) + (o0), (bufoff) + ldsw); PG8_GLDS((const char*)(gbase) + (o1), (bufoff) + ldsw + 8192); } \
        else { PG8_GLDS((const char*)(gbase) + (h) * hstep + voffA[0], (bufoff) + ldsw); PG8_GLDS((const char*)(gbase) + (h) * hstep + voffA[1], (bufoff) + ldsw + 8192); } } while (0)
#define PG8_LDA(dst, b, h) do { _Pragma("unroll") for (int m = 0; m < 4; ++m) _Pragma("unroll") for (int k = 0; k < 2; ++k) dst[m][k] = *(const PG8_LAS bf16x8*)(lds + PG8_SA(b, h) + aoff + m * 2048 + k * 1024); } while (0)
#define PG8_LDB(dst, b, h) do { _Pragma("unroll") for (int n = 0; n < 2; ++n) _Pragma("unroll") for (int k = 0; k < 2; ++k) dst[n][k] = *(const PG8_LAS bf16x8*)(lds + PG8_SB(b, h) + boff + n * 2048 + k * 1024); } while (0)
#define PG8_MMA(ai, bj, At, Bt) do { __builtin_amdgcn_s_setprio(1); _Pragma("unroll") for (int m = 0; m < 4; ++m) _Pragma("unroll") for (int n = 0; n < 2; ++n) _Pragma("unroll") for (int k = 0; k < 2; ++k) \
        acc[ai][bj][m][n] = __builtin_amdgcn_mfma_f32_16x16x32_bf16(Bt[n][k], At[m][k], acc[ai][bj][m][n], 0, 0, 0); __builtin_amdgcn_s_setprio(0); } while (0)
#define PG8_WAIT_V(n) asm volatile("s_waitcnt vmcnt(" #n ")" ::: "memory")
#define PG8_WAIT_VK do { if constexpr (PF) PG8_WAIT_V(9); else PG8_WAIT_V(8); } while (0)
#define PG8_WAIT_L(n) asm volatile("s_waitcnt lgkmcnt(" #n ")" ::: "memory")
#define PG8_BAR __builtin_amdgcn_s_barrier()
#define PG8_SCHED __builtin_amdgcn_sched_barrier(0)
#define PG8_BIAS_STAGE(u_, par_) do { const float* bp_ = wid < 4 ? E.bias_row(u_) : E.aux_row(u_); if (bp_ != nullptr) \
        __builtin_amdgcn_global_load_lds((const unsigned*)(bp_ + (wid & 3) * 64 + lane), (PG8_LAS unsigned*)(lds + BIAS_LDS_OFF + (par_) * 2048 + wid * 256), 4, 0, 0); } while (0)
    Unit cur, nxt, prv; int ui = 0; unsigned dbg_acc = 0;
    if (!S.next(0, cur)) return;
    prv = cur;
    f32x4 acc[2][2][4][2];
#pragma unroll
    for (int a = 0; a < 2; ++a)
#pragma unroll
        for (int b = 0; b < 2; ++b)
#pragma unroll
            for (int m = 0; m < 4; ++m)
#pragma unroll
                for (int n = 0; n < 2; ++n) acc[a][b][m][n] = (f32x4){0.f, 0.f, 0.f, 0.f};
    bf16x8 At[4][2], B0[2][2], B1[2][2];
    unsigned gA00 = 0, gA01 = 0, gA10 = 0, gA11 = 0, gN00 = 0, gN01 = 0, gN10 = 0, gN11 = 0;
    if constexpr (GATHER) { gA00 = S.tokoff(0, RA[0]) + CA2[0]; gA01 = S.tokoff(0, RA[1]) + CA2[1]; gA10 = S.tokoff(0, HALF + RA[0]) + CA2[0]; gA11 = S.tokoff(0, HALF + RA[1]) + CA2[1]; }
    const char* cA = cur.a; const char* cB = cur.b;
    const int pfrow = wid * 32 + (lane & 31);
#define PG8_PFPTR(u_, ui_) ((lane < 32) ? (u_).b + (size_t)pfrow * K * 2 : (GATHER ? (u_).a + S.tokoff((ui_), pfrow) : (u_).a + (size_t)pfrow * K * 2))
#define PG8_PF(kt_) do { if constexpr (PF) { const int k_ = (kt_); const char* p_ = k_ < nt ? pfc + (size_t)k_ * kstep : pfn + (size_t)(k_ - nt) * kstep; \
        __builtin_amdgcn_global_load_lds((const unsigned*)p_, (PG8_LAS unsigned*)(lds + PF_LDS_OFF + wid * 256), 4, 0, 0); } } while (0)
    const char* pfc = nullptr; const char* pfn = nullptr;
    if constexpr (PF) { pfc = PG8_PFPTR(cur, 0); pfn = pfc; }
    S.a_ready(cur);
    PG8_BIAS_STAGE(cur, 0);
    PG8_STAGE_B(PG8_SB(0, 0), cB); PG8_STAGE_B(PG8_SB(0, 1), cB + hstep); PG8_STAGE_A(PG8_SA(0, 0), cA, 0, gA00, gA01); PG8_STAGE_A(PG8_SA(0, 1), cA, 1, gA10, gA11);
    if (wr == 1) PG8_BAR;
    PG8_WAIT_V(2); PG8_BAR;
    PG8_STAGE_B(PG8_SB(1, 0), cB + kstep); PG8_STAGE_A(PG8_SA(1, 0), cA + kstep, 0, gA00, gA01); PG8_STAGE_B(PG8_SB(1, 1), cB + hstep + kstep);
    PG8_WAIT_V(6); PG8_BAR;
    PG8_PF(PFD);
    for (;;) {
        const bool has_next = S.next(ui + 1, nxt);
        if constexpr (GATHER) { if (has_next) { gN00 = S.tokoff(ui + 1, RA[0]) + CA2[0]; gN01 = S.tokoff(ui + 1, RA[1]) + CA2[1]; gN10 = S.tokoff(ui + 1, HALF + RA[0]) + CA2[0]; gN11 = S.tokoff(ui + 1, HALF + RA[1]) + CA2[1]; } }
        const char* nA = has_next ? nxt.a : cA; const char* nB = has_next ? nxt.b : cB;
        if constexpr (PF) { pfn = has_next ? PG8_PFPTR(nxt, ui + 1) : pfc; }
        unsigned dbg_t0 = 0; if (DBG_KLOOP_PH >= 0 && dbg) dbg_t0 = (unsigned)__builtin_amdgcn_s_memrealtime();
        for (int t = 0; t < nt; t += 2) {
            const bool last = (t == nt - 2);
            const char* a1 = cA + (size_t)(t + 1) * kstep;
            const char* a2 = last ? nA : cA + (size_t)(t + 2) * kstep; const char* b2 = last ? nB : cB + (size_t)(t + 2) * kstep;
            const char* a3 = a2 + kstep; const char* b3 = b2 + kstep;
            unsigned s00 = gA00, s01 = gA01, s10 = gA10, s11 = gA11;
            if constexpr (GATHER) { if (last && has_next) { s00 = gN00; s01 = gN01; s10 = gN10; s11 = gN11; } }
            if (last && has_next) S.a_ready(nxt);
            PG8_LDB(B0, 0, 0); PG8_LDB(B1, 0, 1); PG8_SCHED; PG8_LDA(At, 0, 0); PG8_STAGE_A(PG8_SA(1, 1), a1, 1, gA10, gA11);
            PG8_WAIT_VK; PG8_WAIT_L(0); PG8_BAR; PG8_MMA(0, 0, At, B0); PG8_MMA(0, 1, At, B1); PG8_BAR; PG8_SCHED;
            if constexpr (!HALFM) PG8_LDA(At, 0, 1);
            PG8_STAGE_B(PG8_SB(0, 0), b2); PG8_STAGE_B(PG8_SB(0, 1), b2 + hstep); PG8_STAGE_A(PG8_SA(0, 0), a2, 0, s00, s01); PG8_PF(t + 1 + PFD);
            PG8_WAIT_VK; PG8_WAIT_L(0); PG8_BAR; if constexpr (!HALFM) { PG8_MMA(1, 0, At, B0); PG8_MMA(1, 1, At, B1); } PG8_BAR; PG8_SCHED;
            PG8_LDB(B0, 1, 0); PG8_LDB(B1, 1, 1); PG8_SCHED; PG8_LDA(At, 1, 0); PG8_STAGE_A(PG8_SA(0, 1), a2, 1, s10, s11);
            PG8_WAIT_VK; PG8_WAIT_L(0); PG8_BAR; PG8_MMA(0, 0, At, B0); PG8_MMA(0, 1, At, B1); PG8_BAR; PG8_SCHED;
            if constexpr (!HALFM) PG8_LDA(At, 1, 1);
            PG8_STAGE_B(PG8_SB(1, 0), b3); PG8_STAGE_B(PG8_SB(1, 1), b3 + hstep); PG8_STAGE_A(PG8_SA(1, 0), a3, 0, s00, s01); PG8_PF(t + 2 + PFD);
            PG8_WAIT_VK; PG8_WAIT_L(0); PG8_BAR; if constexpr (!HALFM) { PG8_MMA(1, 0, At, B0); PG8_MMA(1, 1, At, B1); } PG8_BAR; PG8_SCHED;
        }
        if (DBG_KLOOP_PH >= 0 && dbg) { dbg_acc += (unsigned)__builtin_amdgcn_s_memrealtime() - dbg_t0; }
        if constexpr (ALIGN_EPI) { if (wr == 0) PG8_BAR; }
        if (MOE_MERGED && ui > 0) S.done(prv);
        E(acc, cur, wr, wc, fr, fq, (const PG8_LAS float*)(lds + BIAS_LDS_OFF + (ui & 1) * 2048));
        if (has_next) PG8_BIAS_STAGE(nxt, (ui + 1) & 1);
        if (MOE_MERGED) prv = cur;
        if (!has_next) break;
        if (!cur.keep) {
#pragma unroll
            for (int a = 0; a < 2; ++a)
#pragma unroll
                for (int b = 0; b < 2; ++b)
#pragma unroll
                    for (int m = 0; m < 4; ++m)
#pragma unroll
                        for (int n = 0; n < 2; ++n) acc[a][b][m][n] = (f32x4){0.f, 0.f, 0.f, 0.f};
        }
        cur = nxt; cA = nA; cB = nB; ++ui; if constexpr (PF) pfc = pfn;
        if constexpr (GATHER) { gA00 = gN00; gA01 = gN01; gA10 = gN10; gA11 = gN11; }
        if constexpr (ALIGN_EPI) { if (wr == 1) PG8_BAR; }
    }
    PG8_WAIT_V(0);
    if (DBG_KLOOP_PH >= 0 && dbg && threadIdx.x == 0) { dbg[0] = 0u; dbg[1] = dbg_acc; }
    if (MOE_MERGED) S.done(prv);
    if constexpr (!ALIGN_EPI) { if (wr == 0) PG8_BAR; }
    PG8_BAR;
#undef PG8_BIAS_STAGE
#undef PG8_PFPTR
#undef PG8_PF
#undef PG8_WAIT_VK
#undef PG8_SA
#undef PG8_SB
#undef PG8_GLDS
#undef PG8_STAGE_A
#undef PG8_STAGE_B
#undef PG8_LDA
#undef PG8_LDB
#undef PG8_MMA
#undef PG8_WAIT_V
#undef PG8_WAIT_L
#undef PG8_BAR
#undef PG8_SCHED
}
}

constexpr int NWAVES = 8;
constexpr int N_LAUNCHES = MK_N_LAUNCHES;
constexpr int PER_PHASE = 9;
constexpr int BATCH = 2, SEQ = 8192, D = 1024, M = BATCH * SEQ, HD = 64, NQH = 16, NKVH = 4, KVW = 256;
constexpr int NIN = 6656, NEXP = 32, TOPK = 4, DFF = 1024;
constexpr float RMS_EPS = 1e-5f;
constexpr float QSCALE = 0.125f * 1.4426950408889634f;
constexpr float LOG2E = 1.4426950408889634f;
constexpr int MAXTILES = 288;
constexpr int SLOTCAP = 16384;
constexpr int HELPER_CUS = 0;
constexpr int MAXU = 16;

constexpr size_t MiB = 1u << 20;
constexpr size_t WS_CTL = 0, CTL_ZERO_BYTES = MOE_MERGED ? 1 * MiB : 64 * 1024;
constexpr size_t WS_BINP = 1 * MiB;
constexpr size_t WS_BGU = 1 * MiB + 64 * 1024;
constexpr size_t WS_COS = 2 * MiB, WS_SIN = 3 * MiB;
constexpr size_t WS_WIN = 4 * MiB;
constexpr size_t WS_WAO = 17 * MiB, WS_WCO = 19 * MiB, WS_WOUT = 21 * MiB;
constexpr size_t WS_XN = 24 * MiB;
constexpr size_t WS_Q = 56 * MiB, WS_K = 88 * MiB, WS_V = 96 * MiB, WS_CB = 104 * MiB, WS_MG = 136 * MiB, WS_U = 168 * MiB, WS_SA = 200 * MiB, WS_SC = 232 * MiB;
constexpr size_t WS_WGU = 264 * MiB;
constexpr size_t WS_WD = 392 * MiB;
constexpr size_t WS_TOKREL = 456 * MiB;
constexpr size_t WS_ROUTE = 458 * MiB;
constexpr size_t WS_ROUTEW = 459 * MiB;
constexpr size_t WS_ACT = 56 * MiB;
constexpr size_t WS_Y = 200 * MiB;
constexpr size_t WS_RSTDREL = 460 * MiB;
constexpr size_t WS_DL = 464 * MiB;
constexpr size_t WS_END = 496 * MiB;
static_assert(WS_ACT + (size_t)MAXTILES * 256 * 2048 <= WS_Y && WS_Y + (size_t)MAXTILES * 256 * 2048 <= WS_WD, "MoE overlays");
constexpr int CW_TMO = 0;
constexpr int CW_TS = 512;
constexpr int CW_CURSOR = 1024;
constexpr int CW_BAR = 4096;
constexpr int CW_MT = 16384;
#define XCD_BAR_WORDS_C 3456
static_assert(CW_BAR + 3 * XCD_BAR_WORDS_C <= CW_MT && (CW_BAR + 3 * XCD_BAR_WORDS_C) * 4 <= 64 * 1024 && (!MOE_MERGED || (CW_MT + 64 * MAXTILES) * 4 <= (int)CTL_ZERO_BYTES), "CTL");

constexpr int RING_OFF = 0, RING_BYTES = 131072;
constexpr int LDSCTL_OFF = RING_BYTES, MISC_OFF = LDSCTL_OFF + 320;
constexpr int TAB_OFF = RING_BYTES + 512;
constexpr int TAB_CNT = TAB_OFF, TAB_TSTART = TAB_OFF + 128, TAB_TILEE = TAB_OFF + 128 + 160;
constexpr int TOK_OFF = TAB_OFF + 2048;
constexpr int BIAS_OFF = TOK_OFF + MAXU * 1024;
constexpr int LDS_BYTES = BIAS_OFF + 4096 + 2048;
static_assert(TAB_TILEE + 320 * 4 <= TOK_OFF && LDS_BYTES <= 163840 && BIAS_OFF == pg8::BIAS_LDS_OFF + RING_OFF, "LDS map");

#define GAS __attribute__((address_space(1)))
#define LAS __attribute__((address_space(3)))
typedef unsigned short bf16;
typedef unsigned v4u __attribute__((ext_vector_type(4)));
typedef unsigned v2u __attribute__((ext_vector_type(2)));
typedef float f32x4 __attribute__((ext_vector_type(4)));
typedef float f32x16 __attribute__((ext_vector_type(16)));
typedef float f32x2 __attribute__((ext_vector_type(2)));
typedef short bf16x8 __attribute__((ext_vector_type(8)));
typedef short s16x4 __attribute__((ext_vector_type(4)));
typedef GAS unsigned gu32;
#define RLX_AGENT __ATOMIC_RELAXED, __HIP_MEMORY_SCOPE_AGENT
#define LDS_WAIT() asm volatile("s_waitcnt lgkmcnt(0)" ::: "memory")
#define VM_WAIT() asm volatile("s_waitcnt vmcnt(0)" ::: "memory")
using pg8::cvt_pk_bf16; using pg8::bf_lo; using pg8::bf_hi;

#define XB_TMO      128
#define XB_XCNT(j)  (256  + 64 * (j))
#define XB_XSUB(j)  (1280 + 64 * (j))
#define XB_XGEN(j)  (2304 + 64 * (j))
#define XB_TOP      3328
#define XB_TOPGEN   3392
#define XCD_BAR_WORDS 3456
#define XB_SPIN_CAP (1u << 18)
static_assert(XCD_BAR_WORDS == XCD_BAR_WORDS_C, "bar words");

__device__ __forceinline__ unsigned xb_ld(unsigned* p)              { return __hip_atomic_load(p, __ATOMIC_RELAXED, __HIP_MEMORY_SCOPE_AGENT); }
__device__ __forceinline__ unsigned xb_add(unsigned* p, unsigned v) { return __hip_atomic_fetch_add(p, v, __ATOMIC_RELAXED, __HIP_MEMORY_SCOPE_AGENT); }
__device__ __forceinline__ unsigned xb_xcc_id() { return (unsigned)__builtin_amdgcn_s_getreg((3 << 11) | 20) & 0xFu; }
#define XB_SPIN(cond, bar) do { unsigned _sp = 0; while (cond) { __builtin_amdgcn_s_sleep(1); \
    if ((++_sp & 255u) == 0u) { if (xb_ld(&(bar)[XB_TMO])) break; if (_sp > XB_SPIN_CAP) { atomicAdd(&(bar)[XB_TMO], 1u); break; } } } } while (0)

struct XcdBarrier { unsigned* bar; unsigned x; volatile LAS unsigned* st; };

__device__ __forceinline__ XcdBarrier xcd_barrier_post(unsigned* bar, volatile LAS unsigned* st) {
    XcdBarrier b; b.bar = bar; b.x = xb_xcc_id(); b.st = st;
    if (threadIdx.x == 0) (void)xb_add(&bar[XB_XCNT(b.x)], 1u);
    return b;
}
__device__ __forceinline__ void xcd_barrier_complete(unsigned* bar, unsigned x, unsigned& nloc, unsigned& nx) {
    const unsigned G = gridDim.x * gridDim.y * gridDim.z;
    unsigned sum, cnt, mine, sp = 0u;
    for (;;) {
        sum = 0u; cnt = 0u; mine = 0u;
#pragma unroll
        for (unsigned j = 0; j < 16; ++j) { const unsigned c = xb_ld(&bar[XB_XCNT(j)]); sum += c; cnt += (c > 0u) ? 1u : 0u; mine = (j == x) ? c : mine; }
        if (sum == G) break;
        __builtin_amdgcn_s_sleep(1);
        if ((++sp & 255u) == 0u) { if (xb_ld(&bar[XB_TMO])) break; if (sp > XB_SPIN_CAP) { atomicAdd(&bar[XB_TMO], 1u); break; } }
    }
    nloc = mine > 0u ? mine : 1u; nx = cnt > 0u ? cnt : 1u;
}
__device__ __forceinline__ void xcd_barrier(const XcdBarrier& b) {
    asm volatile("s_waitcnt vmcnt(0)" ::: "memory");
    __syncthreads();
    if (threadIdx.x == 0) {
        unsigned* bar = b.bar;
        __builtin_amdgcn_s_waitcnt(0);
        unsigned nloc = b.st[0], nx = b.st[1];
        if (nloc == 0u) { xcd_barrier_complete(bar, b.x, nloc, nx); b.st[0] = nloc; b.st[1] = nx; }
        const unsigned old = xb_add(&bar[XB_XSUB(b.x)], 1u);
        const unsigned gen = old / nloc;
        if (old + 1u == (gen + 1u) * nloc) {
            __builtin_amdgcn_fence(__ATOMIC_RELEASE, "agent");
            asm volatile("s_waitcnt vmcnt(0)" ::: "memory");
            const unsigned og = xb_add(&bar[XB_TOP], 1u);
            const unsigned tg = og / nx;
            if (og + 1u == (tg + 1u) * nx) xb_add(&bar[XB_TOPGEN], 1u);
            else XB_SPIN(xb_ld(&bar[XB_TOPGEN]) == tg, bar);
            __builtin_amdgcn_fence(__ATOMIC_ACQUIRE, "agent");
            xb_add(&bar[XB_XGEN(b.x)], 1u);
            asm volatile("s_waitcnt vmcnt(0)" ::: "memory");
        } else {
            XB_SPIN(xb_ld(&bar[XB_XGEN(b.x)]) == gen, bar);
            __builtin_amdgcn_fence(__ATOMIC_ACQUIRE, "agent");
            asm volatile("s_waitcnt vmcnt(0)" ::: "memory");
        }
    }
    __syncthreads();
}

__device__ __forceinline__ float wave_sum(float v) {
#pragma unroll
    for (int o = 1; o < 64; o <<= 1) v += __shfl_xor(v, o);
    return v;
}
__device__ __forceinline__ float wave_max(float v) {
#pragma unroll
    for (int o = 1; o < 64; o <<= 1) v = fmaxf(v, __shfl_xor(v, o));
    return v;
}
__device__ __forceinline__ int wave_min_i(int v) {
#pragma unroll
    for (int o = 1; o < 64; o <<= 1) { const int w = __shfl_xor(v, o); v = w < v ? w : v; }
    return v;
}

template <int CTRL> __device__ __forceinline__ float dpp_f(float v) { return __builtin_bit_cast(float, __builtin_amdgcn_update_dpp(0, __builtin_bit_cast(int, v), CTRL, 0xF, 0xF, false)); }
__device__ __forceinline__ float rl_f(float v, int l) { return __builtin_bit_cast(float, __builtin_amdgcn_readlane(__builtin_bit_cast(int, v), l)); }
__device__ __forceinline__ float wave_sum_dpp(float v) { v += dpp_f<0xB1>(v); v += dpp_f<0x4E>(v); v += dpp_f<0x141>(v); v += dpp_f<0x140>(v); return (rl_f(v, 0) + rl_f(v, 16)) + (rl_f(v, 32) + rl_f(v, 48)); }
__device__ __forceinline__ float half_max_dpp(float v) { v = fmaxf(v, dpp_f<0xB1>(v)); v = fmaxf(v, dpp_f<0x4E>(v)); v = fmaxf(v, dpp_f<0x141>(v)); v = fmaxf(v, dpp_f<0x140>(v)); return fmaxf(rl_f(v, 0), rl_f(v, 16)); }

__device__ __forceinline__ int win_dest(int c) {
    if (c < 1280) { const int h = c >> 6, d = c & 63, s = d >> 5, i = d & 31; return (h << 6) + 8 * (i >> 2) + 4 * s + (i & 3); }
    if (c < 2560) return c;
    if (c < 3584) { const int i = c - 2560; return 2560 + (i >> 2) * 8 + (i & 3); }
    if (c < 4608) { const int i = c - 3584; return 2560 + (i >> 2) * 8 + 4 + (i & 3); }
    if (c < 5632) { const int i = c - 4608; return 4608 + (i >> 2) * 8 + (i & 3); }
    { const int i = c - 5632; return 4608 + (i >> 2) * 8 + 4 + (i & 3); }
}
__device__ __forceinline__ int map_dest(int mode, int n) {
    if (mode == 0) return n;
    if (mode == 1) return win_dest(n);
    if (mode == 2) return (n >> 2) * 8 + (n & 3);
    return (n >> 2) * 8 + 4 + (n & 3);
}

constexpr int NWAVES_C = 8;
struct CvtItem { const GAS float* W; GAS bf16* WT; int K, N, mode, k0, n0, keep; };
__device__ __forceinline__ void cvt_load(f32x4 (&v)[16], const CvtItem& it, int lane) {
    const GAS float* p = it.W + (size_t)(it.k0 + 4 * (lane >> 4)) * it.N + it.n0 + 4 * (lane & 15);
#pragma unroll
    for (int j = 0; j < 4; ++j)
#pragma unroll
        for (int r = 0; r < 4; ++r) v[j * 4 + r] = __builtin_nontemporal_load((const GAS f32x4*)(p + (size_t)(16 * j + r) * it.N));
}
__device__ __forceinline__ void cvt_store(const f32x4 (&v)[16], const CvtItem& it, LAS unsigned char* scr, int lane, const LAS float* gl) {
    const int kq = lane >> 4, nl = 4 * (lane & 15);
    const bool gs = FOLD_G && it.mode >= 2;
#pragma unroll
    for (int j = 0; j < 4; ++j) { f32x4 gk = *(const LAS f32x4*)(gl + it.k0 + 16 * j + 4 * kq);
        if (!gs) gk = (f32x4){1.f, 1.f, 1.f, 1.f};
#pragma unroll
        for (int i = 0; i < 4; ++i) { v2u w; w.x = cvt_pk_bf16(v[j * 4 + 0][i] * gk[0], v[j * 4 + 1][i] * gk[1]); w.y = cvt_pk_bf16(v[j * 4 + 2][i] * gk[2], v[j * 4 + 3][i] * gk[3]);
            *(LAS v2u*)(scr + (nl + i) * 136 + (16 * j + 4 * kq) * 2) = w; } }
    LDS_WAIT(); asm volatile("" ::: "memory");
#pragma unroll
    for (int jj = 0; jj < 8; ++jj) { const int n = (lane >> 3) + 8 * jj, c = lane & 7;
        const v2u a = *(const LAS v2u*)(scr + n * 136 + c * 16), b = *(const LAS v2u*)(scr + n * 136 + c * 16 + 8);
        v4u o; o.x = a.x; o.y = a.y; o.z = b.x; o.w = b.y;
        GAS v4u* dp = (GAS v4u*)(it.WT + (size_t)map_dest(it.mode, it.n0 + n) * it.K + it.k0 + 8 * c);
        if (it.keep) *dp = o; else __builtin_nontemporal_store(o, dp); }
    LDS_WAIT(); asm volatile("" ::: "memory");
}
struct CvtSrc { const float* w_in; bf16* Win_t; const LAS unsigned long long* ptab; const LAS float* gl; };
constexpr int CVT_IN_ITEMS = (1024 / 64) * (6656 / 64);
constexpr int CVT_SQ_ITEMS = 256;
constexpr int CVT_REST_ITEMS = (3 + 32 * 3) * CVT_SQ_ITEMS;
#ifndef SLACK_CVT
#define SLACK_CVT 1
#endif
constexpr int SLACK_P1_ITEMS = SLACK_CVT ? 8192 : 0;
constexpr int SLACK_P6_ITEMS = SLACK_CVT ? 8192 : 0;

__device__ __forceinline__ CvtItem cvt_item_in(const CvtSrc& S, int id) { CvtItem it; it.keep = 0; it.W = (const GAS float*)S.w_in; it.WT = (GAS bf16*)S.Win_t; it.K = 1024; it.N = 6656; it.mode = 1; it.k0 = 64 * (id / 104); it.n0 = 64 * (id % 104); return it; }
__device__ __forceinline__ CvtItem cvt_item_rest(const CvtSrc& S, int id) {
    CvtItem it; it.keep = (KEEP_WD && (id >> 8) >= 67) ? 1 : 0; it.K = 1024; it.N = 1024; const int mat = id >> 8, r = id & 255; it.k0 = 64 * (r >> 4); it.n0 = 64 * (r & 15);
    int si = mat, e = 0, which = 2;
    if (mat >= 67) { e = mat - 67; which = 2; si = 5; }
    else if (mat >= 3) { const int q = mat - 3; e = q >> 1; which = q & 1; si = 3 + which; }
    const unsigned long long ps = S.ptab[si], pd = S.ptab[6 + si];
    const unsigned long long psu = ((unsigned long long)__builtin_amdgcn_readfirstlane((unsigned)(ps >> 32)) << 32) | (unsigned)__builtin_amdgcn_readfirstlane((unsigned)ps);
    const unsigned long long pdu = ((unsigned long long)__builtin_amdgcn_readfirstlane((unsigned)(pd >> 32)) << 32) | (unsigned)__builtin_amdgcn_readfirstlane((unsigned)pd);
    it.W = (const GAS float*)psu + (size_t)e * 1048576; it.WT = (GAS bf16*)pdu + (size_t)e * (which < 2 ? 2097152 : 1048576);
    it.mode = mat < 3 ? 0 : (which == 0 ? 2 : which == 1 ? 3 : 0);
    return it;
}
template <int SET> __device__ __forceinline__ void cvt_run(const CvtSrc& S, int first, int stride, int n_items, LAS unsigned char* scr, int lane, int base = 0) {
    f32x4 r0[16], r1[16]; CvtItem i0, i1;
    int id = first; if (id >= n_items) return;
    i0 = SET == 0 ? cvt_item_in(S, id) : cvt_item_rest(S, base + id); cvt_load(r0, i0, lane);
    for (;;) {
        const int idn = id + stride;
        if (idn >= n_items) { cvt_store(r0, i0, scr, lane, S.gl); break; }
        i1 = SET == 0 ? cvt_item_in(S, idn) : cvt_item_rest(S, base + idn); cvt_load(r1, i1, lane); cvt_store(r0, i0, scr, lane, S.gl);
        id = idn + stride;
        if (id >= n_items) { cvt_store(r1, i1, scr, lane, S.gl); break; }
        i0 = SET == 0 ? cvt_item_in(S, id) : cvt_item_rest(S, base + id); cvt_load(r0, i0, lane); cvt_store(r1, i1, scr, lane, S.gl);
    }
}

__device__ __forceinline__ void slack_convert(const CvtSrc& S, int U, int G, int c, int base, int n_items, LAS unsigned char* scr, int wave, int lane) {
    if (n_items <= 0) return;
    int rem = U % G; if (G - rem < G / 4) rem = 0;
    const int ncv = G - rem;
    if (c < rem) return;
    cvt_run<1>(S, (c - rem) * NWAVES_C + wave, ncv * NWAVES_C, n_items, scr, lane, base);
}

__device__ __forceinline__ void rms_row_to_bf16(const float* xrow, const float* g, bf16* orow, int lane) {
    const GAS f32x4* xr = (const GAS f32x4*)xrow + lane; const GAS f32x4* gr = (const GAS f32x4*)g + lane;
    f32x4 v[4]; float s = 0.f;
#pragma unroll
    for (int j = 0; j < 4; ++j) { v[j] = __builtin_nontemporal_load(xr + 64 * j); s += (v[j].x * v[j].x + v[j].y * v[j].y) + (v[j].z * v[j].z + v[j].w * v[j].w); }
    const float rstd = 1.f / sqrtf(wave_sum(s) * (1.f / D) + RMS_EPS);
    GAS v2u* o8 = (GAS v2u*)orow + lane;
#pragma unroll
    for (int j = 0; j < 4; ++j) { const f32x4 gg = gr[64 * j]; v2u w; w.x = cvt_pk_bf16(v[j].x * rstd * gg.x, v[j].y * rstd * gg.y); w.y = cvt_pk_bf16(v[j].z * rstd * gg.z, v[j].w * rstd * gg.w); o8[64 * j] = w; }
}

struct DenseOrder {
    int nM, nN, G, c, K; const char* A; const char* B;
    __device__ __forceinline__ bool next(int i, pg8::Unit& u) const {
        if (!pg8::tile_of((long)i * G + c, nM, nN, u.pm, u.pn)) return false;
        u.e = 0; u.aux = 1; u.keep = false; u.rofs = 0; u.a = A + (size_t)u.pm * 256 * K * 2; u.b = B + (size_t)u.pn * 256 * K * 2; return true; }
    __device__ __forceinline__ unsigned tokoff(int, int) const { return 0u; }
    __device__ __forceinline__ void a_ready(const pg8::Unit&) const {}
    __device__ __forceinline__ void done(const pg8::Unit&) const {}
};
struct MergeOrder {
    int nM, nN, G, c, K; const char* A0; const char* B0; const char* A1; const char* B1;
    __device__ __forceinline__ bool next(int i, pg8::Unit& u) const {
        if (!pg8::tile_of((long)(i >> 1) * G + c, nM, nN, u.pm, u.pn)) return false;
        const int br = i & 1; u.e = 0; u.aux = br; u.keep = (br == 0); u.rofs = 0;
        u.a = (br ? A1 : A0) + (size_t)u.pm * 256 * K * 2; u.b = (br ? B1 : B0) + (size_t)u.pn * 256 * K * 2; return true; }
    __device__ __forceinline__ unsigned tokoff(int, int) const { return 0u; }
    __device__ __forceinline__ void a_ready(const pg8::Unit&) const {}
    __device__ __forceinline__ void done(const pg8::Unit&) const {}
};
struct MoeOrder {
    int MT, G, c; const char* XNb; const char* ACTb; const char* Wgu; const char* Wd; const LAS int* tile_e; const LAS unsigned* tok; unsigned* ready; unsigned* tmo; int part; int ulim;
    __device__ __forceinline__ bool next(int i, pg8::Unit& u) const {
        const long U1 = (long)MT * 8; const long L = (long)i * G + c + (part == 2 ? U1 : 0);
        if (part == 1 && L >= U1) return false;
        if (part == 2 && L - U1 >= ulim) return false;
        if (L < U1) { pg8::tile_of(L, MT, 8, u.pm, u.pn, WGM_MOE); const int e = __builtin_amdgcn_readfirstlane(tile_e[u.pm]);
            u.e = e; u.aux = 2; u.keep = false; u.rofs = 0; u.a = XNb; u.b = Wgu + (size_t)e * (2048 * 1024 * 2) + (size_t)u.pn * (256 * 1024 * 2); return true; }
        if (!pg8::tile_of(L - U1, MT, 4, u.pm, u.pn, WGM_MOE2)) return false;
        if (P7_REVERSE && part == 2) u.pm = MT - 1 - u.pm;
        const int e = __builtin_amdgcn_readfirstlane(tile_e[u.pm]);
        u.e = e; u.aux = 3; u.keep = false; u.rofs = 0; u.a = ACTb + (size_t)u.pm * (256 * 1024 * 2); u.b = Wd + (size_t)e * (1024 * 1024 * 2) + (size_t)u.pn * (256 * 1024 * 2); return true; }
    __device__ __forceinline__ unsigned tokoff(int i, int row) const { return (part != 2 && (long)i * G + c < (long)MT * 8) ? tok[i * 256 + row] : (unsigned)row * 2048u; }
    __device__ __forceinline__ void a_ready(const pg8::Unit& u) const {
        if (u.aux != 3 || part != 0) return;
        if (threadIdx.x < 64) {
            const unsigned long long t0 = __builtin_amdgcn_s_memrealtime(); unsigned polls = 0;
            while ((unsigned)__builtin_amdgcn_readfirstlane(__hip_atomic_load(ready + 64 * u.pm, __ATOMIC_RELAXED, __HIP_MEMORY_SCOPE_AGENT)) < 64u) {
                if ((++polls & 255u) == 0u && __builtin_amdgcn_readfirstlane(__hip_atomic_load(tmo, __ATOMIC_RELAXED, __HIP_MEMORY_SCOPE_AGENT)) != 0u) break;
                if (__builtin_amdgcn_s_memrealtime() - t0 > 2000000ull) { if (threadIdx.x == 0) __hip_atomic_store(tmo, 1u, __ATOMIC_RELAXED, __HIP_MEMORY_SCOPE_AGENT); break; }
                __builtin_amdgcn_s_sleep(2); }
            __builtin_amdgcn_fence(__ATOMIC_ACQUIRE, "agent");
            asm volatile("s_waitcnt vmcnt(0)" ::: "memory");
        }
        asm volatile("" ::: "memory"); __builtin_amdgcn_s_barrier(); asm volatile("" ::: "memory");
    }
    __device__ __forceinline__ void done(const pg8::Unit& u) const {
        if (u.aux != 2 || part != 0) return;
        asm volatile("s_waitcnt vmcnt(0)" ::: "memory");
        if ((threadIdx.x & 63) == 0) __hip_atomic_fetch_add(ready + 64 * u.pm, 1u, __ATOMIC_RELAXED, __HIP_MEMORY_SCOPE_AGENT);
    }
};

struct TailOrder {
    int MT, ubase, c; const char* ACTb; const char* Wd; const LAS int* tile_e;
    __device__ __forceinline__ bool next(int i, pg8::Unit& u) const {
        if (i != 0 || !pg8::tile_of((long)ubase + (c >> 1), MT, 4, u.pm, u.pn, WGM_MOE2)) return false;
        const int e = __builtin_amdgcn_readfirstlane(tile_e[u.pm]);
        u.e = e; u.aux = 4; u.keep = false; u.rofs = 128 * (c & 1); u.a = ACTb + ((size_t)u.pm * 256 + 128 * (c & 1)) * (1024 * 2);     u.b = Wd + (size_t)e * (1024 * 1024 * 2) + (size_t)u.pn * (256 * 1024 * 2); return true; }
    __device__ __forceinline__ unsigned tokoff(int, int row) const { return (unsigned)(128 * (c & 1) + (row & 127)) * 2048u; }
    __device__ __forceinline__ void a_ready(const pg8::Unit&) const {}
    __device__ __forceinline__ void done(const pg8::Unit&) const {}
};

using pg8::f32x4; using pg8::Unit;
struct EpiInProj {
    static constexpr bool PERM = true;
    __device__ static __forceinline__ int nstores(const Unit&) { return 16; }
    bf16 *Q, *Kb, *Vb, *CB, *U, *SA, *SC; const float* bias; const float* cosT; const float* sinT;
    __device__ __forceinline__ const float* bias_row(const Unit& u) const { return bias + u.pn * 256; }
    __device__ __forceinline__ const float* aux_row(const Unit&) const { return nullptr; }
    __device__ __forceinline__ void operator()(const f32x4 (&acc)[2][2][4][2], const Unit& u, int wr, int wc, int fr, int fq, const LAS float* bl) const {
        const int pn = u.pn, row0 = u.pm * 256 + wr * 64 + fr, cl0 = wc * 32 + 8 * fq;
        f32x4 bv[2][2];
#pragma unroll
        for (int bj = 0; bj < 2; ++bj)
#pragma unroll
            for (int n = 0; n < 2; ++n) bv[bj][n] = *(const LAS f32x4*)(bl + cl0 + bj * 128 + 4 * n);
        if (pn < 5) {
            bf16* base = pn < 4 ? Q : Kb; const int ld = pn < 4 ? 1024 : 256, colt = pn < 4 ? pn * 256 : 0; const float sc = pn < 4 ? QSCALE : 1.0f;
            const int i0 = 16 * (wc & 1) + 4 * fq;
#pragma unroll
            for (int ai = 0; ai < 2; ++ai)
#pragma unroll
                for (int m = 0; m < 4; ++m) { const int row = row0 + ai * 128 + m * 16, pos = row & (SEQ - 1);
                    const f32x4 c4 = *(const f32x4*)(cosT + pos * 32 + i0) * sc, s4 = *(const f32x4*)(sinT + pos * 32 + i0) * sc;
#pragma unroll
                    for (int bj = 0; bj < 2; ++bj) { const f32x4 t1 = acc[ai][bj][m][0] + bv[bj][0], t2 = acc[ai][bj][m][1] + bv[bj][1];
                        const f32x4 o1 = t1 * c4 - t2 * s4, o2 = t2 * c4 + t1 * s4;
                        v4u w; w.x = cvt_pk_bf16(o1[0], o1[1]); w.y = cvt_pk_bf16(o1[2], o1[3]); w.z = cvt_pk_bf16(o2[0], o2[1]); w.w = cvt_pk_bf16(o2[2], o2[3]);
                        *(v4u*)(base + (size_t)row * ld + colt + cl0 + bj * 128) = w; } }
        } else if (pn >= 10 && pn < 18) {
            const int colt = (pn - 10) * 128 + (cl0 >> 1);
#pragma unroll
            for (int ai = 0; ai < 2; ++ai)
#pragma unroll
                for (int m = 0; m < 4; ++m) { const int row = row0 + ai * 128 + m * 16;
#pragma unroll
                    for (int bj = 0; bj < 2; ++bj) { const f32x4 p = (acc[ai][bj][m][0] + bv[bj][0]) * (acc[ai][bj][m][1] + bv[bj][1]);
                        v2u w; w.x = cvt_pk_bf16(p[0], p[1]); w.y = cvt_pk_bf16(p[2], p[3]);
                        *(v2u*)(U + (size_t)row * 1024 + colt + bj * 64) = w; } }
        } else if (pn >= 18) {
            const int colt = (pn - 18) * 128 + (cl0 >> 1);
#pragma unroll
            for (int ai = 0; ai < 2; ++ai)
#pragma unroll
                for (int m = 0; m < 4; ++m) { const int row = row0 + ai * 128 + m * 16;
#pragma unroll
                    for (int bj = 0; bj < 2; ++bj) { const f32x4 a4 = acc[ai][bj][m][0] + bv[bj][0], c4 = acc[ai][bj][m][1] + bv[bj][1]; f32x4 r4, s4;
#pragma unroll
                        for (int q = 0; q < 4; ++q) { const float ea = __builtin_amdgcn_exp2f(a4[q] * -1.4426950408889634f), ec = __builtin_amdgcn_exp2f(c4[q] * -1.4426950408889634f);
                            s4[q] = fmaxf(__builtin_amdgcn_rcpf(1.0f + ec), 1e-20f); r4[q] = (1.0f + ec) * __builtin_amdgcn_rcpf(1.0f + ea); r4[q] = fminf(r4[q], 1e20f); }
                        v2u wr_, ws_; wr_.x = cvt_pk_bf16(r4[0], r4[1]); wr_.y = cvt_pk_bf16(r4[2], r4[3]); ws_.x = cvt_pk_bf16(s4[0], s4[1]); ws_.y = cvt_pk_bf16(s4[2], s4[3]);
                        *(v2u*)(SA + (size_t)row * 1024 + colt + bj * 64) = wr_; *(v2u*)(SC + (size_t)row * 1024 + colt + bj * 64) = ws_; } }
        } else {
            bf16* base; int ld = 1024, colt; const bool sg = false;
            if (pn == 5) { base = Vb; ld = 256; colt = 0; }
            else { base = CB; colt = (pn - 6) * 256; }
#pragma unroll
            for (int ai = 0; ai < 2; ++ai)
#pragma unroll
                for (int m = 0; m < 4; ++m) { const int row = row0 + ai * 128 + m * 16;
#pragma unroll
                    for (int bj = 0; bj < 2; ++bj) { f32x4 v0 = acc[ai][bj][m][0] + bv[bj][0], v1 = acc[ai][bj][m][1] + bv[bj][1];
                        if (sg) {
#pragma unroll
                            for (int q = 0; q < 4; ++q) { v0[q] = pg8::sigmoidf_(v0[q]); v1[q] = pg8::sigmoidf_(v1[q]); } }
                        v4u w; w.x = cvt_pk_bf16(v0[0], v0[1]); w.y = cvt_pk_bf16(v0[2], v0[3]); w.z = cvt_pk_bf16(v1[0], v1[1]); w.w = cvt_pk_bf16(v1[2], v1[3]);
                        *(v4u*)(base + (size_t)row * ld + colt + cl0 + bj * 128) = w; } }
        }
    }
};
struct EpiMerge {
    static constexpr bool PERM = true;
    __device__ static __forceinline__ int nstores(const Unit& u) { return u.aux == 0 ? 0 : 16; }
    const bf16 *SA, *SC; bf16* MG;
    __device__ __forceinline__ const float* bias_row(const Unit&) const { return nullptr; }
    __device__ __forceinline__ const float* aux_row(const Unit&) const { return nullptr; }
    __device__ __forceinline__ void operator()(f32x4 (&acc)[2][2][4][2], const Unit& u, int wr, int wc, int fr, int fq, const LAS float*) const {
        const int row0 = u.pm * 256 + wr * 64 + fr, col0 = u.pn * 256 + wc * 32 + 8 * fq;
        const bf16* G = u.aux == 0 ? SA : SC;
        v4u gv[2][4][2];
#pragma unroll
        for (int ai = 0; ai < 2; ++ai)
#pragma unroll
            for (int m = 0; m < 4; ++m)
#pragma unroll
                for (int bj = 0; bj < 2; ++bj) gv[ai][m][bj] = *(const v4u*)(G + (size_t)(row0 + ai * 128 + m * 16) * 1024 + col0 + bj * 128);
#pragma unroll
        for (int ai = 0; ai < 2; ++ai)
#pragma unroll
            for (int m = 0; m < 4; ++m)
#pragma unroll
                for (int bj = 0; bj < 2; ++bj) { const v4u c = gv[ai][m][bj];
                    const f32x4 c0 = {bf_lo(c.x), bf_hi(c.x), bf_lo(c.y), bf_hi(c.y)}, c1 = {bf_lo(c.z), bf_hi(c.z), bf_lo(c.w), bf_hi(c.w)};
                    const f32x4 v0 = acc[ai][bj][m][0] * c0, v1 = acc[ai][bj][m][1] * c1;
                    if (u.aux == 0) { acc[ai][bj][m][0] = v0; acc[ai][bj][m][1] = v1; }
                    else { v4u w; w.x = cvt_pk_bf16(v0[0], v0[1]); w.y = cvt_pk_bf16(v0[2], v0[3]); w.z = cvt_pk_bf16(v1[0], v1[1]); w.w = cvt_pk_bf16(v1[2], v1[3]);
                        *(v4u*)(MG + (size_t)(row0 + ai * 128 + m * 16) * 1024 + col0 + bj * 128) = w; } }
    }
};
struct EpiRes {
    static constexpr bool PERM = true;
    __device__ static __forceinline__ int nstores(const Unit&) { return 16; }
    bf16* DL;
    __device__ __forceinline__ const float* bias_row(const Unit&) const { return nullptr; }
    __device__ __forceinline__ const float* aux_row(const Unit&) const { return nullptr; }
    __device__ __forceinline__ void operator()(const f32x4 (&acc)[2][2][4][2], const Unit& u, int wr, int wc, int fr, int fq, const LAS float*) const {
        const int row0 = u.pm * 256 + wr * 64 + fr, col0 = u.pn * 256 + wc * 32 + 8 * fq;
#pragma unroll
        for (int ai = 0; ai < 2; ++ai)
#pragma unroll
            for (int m = 0; m < 4; ++m) { bf16* rp = DL + (size_t)(row0 + ai * 128 + m * 16) * 1024 + col0;
#pragma unroll
                for (int bj = 0; bj < 2; ++bj) { const f32x4 v0 = acc[ai][bj][m][0], v1 = acc[ai][bj][m][1];
                    v4u w; w.x = cvt_pk_bf16(v0[0], v0[1]); w.y = cvt_pk_bf16(v0[2], v0[3]); w.z = cvt_pk_bf16(v1[0], v1[1]); w.w = cvt_pk_bf16(v1[2], v1[3]);
                    *(v4u*)(rp + bj * 128) = w; } }
    }
};
struct EpiGU {
    static constexpr bool PERM = true;
    __device__ static __forceinline__ int nstores(const Unit&) { return 16; }
    bf16* ACT; const float* bgu; const float* rstdrel; const LAS int* tst;
    __device__ __forceinline__ const float* bias_row(const Unit& u) const { return bgu + (size_t)u.e * 2048 + u.pn * 256; }
    __device__ __forceinline__ const float* aux_row(const Unit& u) const { return P5_MFMA ? rstdrel + (size_t)u.e * SLOTCAP + (u.pm - tst[u.e]) * 256 : nullptr; }
    __device__ __forceinline__ void operator()(const f32x4 (&acc)[2][2][4][2], const Unit& u, int wr, int wc, int fr, int fq, const LAS float* bl) const {
        const int row0 = u.pm * 256 + wr * 64 + fr, cl0 = u.pn * 256 + wc * 32 + 8 * fq;
        const LAS float* bb = bl + wc * 32 + 8 * fq;
        f32x4 bv[2][2];
#pragma unroll
        for (int bj = 0; bj < 2; ++bj)
#pragma unroll
            for (int n = 0; n < 2; ++n) bv[bj][n] = *(const LAS f32x4*)(bb + bj * 128 + 4 * n);
#pragma unroll
        for (int ai = 0; ai < 2; ++ai)
#pragma unroll
            for (int m = 0; m < 4; ++m) { bf16* rp = ACT + (size_t)(row0 + ai * 128 + m * 16) * 1024 + (cl0 >> 1);
                const float rs = P5_MFMA ? bl[256 + wr * 64 + fr + ai * 128 + m * 16] : 1.0f;
#pragma unroll
                for (int bj = 0; bj < 2; ++bj) { const f32x4 g4 = acc[ai][bj][m][0] * rs + bv[bj][0], u4 = acc[ai][bj][m][1] * rs + bv[bj][1]; f32x4 o;
#pragma unroll
                    for (int q = 0; q < 4; ++q) { const float g = __builtin_amdgcn_fmed3f(g4[q], -3.0e38f, 7.0f), uu = __builtin_amdgcn_fmed3f(u4[q], -7.0f, 7.0f);
                        o[q] = g * __builtin_amdgcn_rcpf(1.0f + __builtin_amdgcn_exp2f(g * -2.4554669595930157f)) * (uu + 1.0f); }
                    if (MOE_MERGED) { const unsigned long long w = (unsigned long long)cvt_pk_bf16(o[0], o[1]) | ((unsigned long long)cvt_pk_bf16(o[2], o[3]) << 32);
                        __hip_atomic_store((unsigned long long*)(rp + bj * 64), w, __ATOMIC_RELAXED, __HIP_MEMORY_SCOPE_AGENT); }
                    else { v2u w; w.x = cvt_pk_bf16(o[0], o[1]); w.y = cvt_pk_bf16(o[2], o[3]); *(v2u*)(rp + bj * 64) = w; } } }
    }
};
struct EpiDown {
    static constexpr bool PERM = true;
    __device__ static __forceinline__ int nstores(const Unit&) { return 16; }
    bf16* Y; const float* bd;
    __device__ __forceinline__ const float* bias_row(const Unit& u) const { return bd + (size_t)u.e * 1024 + u.pn * 256; }
    __device__ __forceinline__ const float* aux_row(const Unit&) const { return nullptr; }
    __device__ __forceinline__ void operator()(const f32x4 (&acc)[2][2][4][2], const Unit& u, int wr, int wc, int fr, int fq, const LAS float* bl) const {
        const int row0 = u.pm * 256 + wr * 64 + fr, cl0 = u.pn * 256 + wc * 32 + 8 * fq;
        const LAS float* bb = bl + wc * 32 + 8 * fq;
        f32x4 bv[2][2];
#pragma unroll
        for (int bj = 0; bj < 2; ++bj)
#pragma unroll
            for (int n = 0; n < 2; ++n) bv[bj][n] = *(const LAS f32x4*)(bb + bj * 128 + 4 * n);
#pragma unroll
        for (int ai = 0; ai < 2; ++ai)
#pragma unroll
            for (int m = 0; m < 4; ++m) { bf16* rp = Y + (size_t)(row0 + ai * 128 + m * 16) * 1024 + cl0;
#pragma unroll
                for (int bj = 0; bj < 2; ++bj) { const f32x4 v0 = acc[ai][bj][m][0] + bv[bj][0], v1 = acc[ai][bj][m][1] + bv[bj][1];
                    v4u w; w.x = cvt_pk_bf16(v0[0], v0[1]); w.y = cvt_pk_bf16(v0[2], v0[3]); w.z = cvt_pk_bf16(v1[0], v1[1]); w.w = cvt_pk_bf16(v1[2], v1[3]);
                    *(v4u*)(rp + bj * 128) = w; } }
    }
    __device__ __forceinline__ void half(const f32x4 (&acc)[2][2][4][2], const Unit& u, int wr, int wc, int fr, int fq, const LAS float* bl) const {
        const int row0 = u.pm * 256 + u.rofs + wr * 64 + fr, cl0 = u.pn * 256 + wc * 32 + 8 * fq;
        const LAS float* bb = bl + wc * 32 + 8 * fq;
        f32x4 bv[2][2];
#pragma unroll
        for (int bj = 0; bj < 2; ++bj)
#pragma unroll
            for (int n = 0; n < 2; ++n) bv[bj][n] = *(const LAS f32x4*)(bb + bj * 128 + 4 * n);
#pragma unroll
        for (int m = 0; m < 4; ++m) { bf16* rp = Y + (size_t)(row0 + m * 16) * 1024 + cl0;
#pragma unroll
            for (int bj = 0; bj < 2; ++bj) { const f32x4 v0 = acc[0][bj][m][0] + bv[bj][0], v1 = acc[0][bj][m][1] + bv[bj][1];
                v4u w; w.x = cvt_pk_bf16(v0[0], v0[1]); w.y = cvt_pk_bf16(v0[2], v0[3]); w.z = cvt_pk_bf16(v1[0], v1[1]); w.w = cvt_pk_bf16(v1[2], v1[3]);
                *(v4u*)(rp + bj * 128) = w; } }
    }
};
struct EpiDownX {
    static constexpr bool PERM = true;
    __device__ static __forceinline__ int nstores(const Unit&) { return 0; }
    EpiDown dn;
    __device__ __forceinline__ const float* bias_row(const Unit& u) const { return dn.bias_row(u); }
    __device__ __forceinline__ const float* aux_row(const Unit&) const { return nullptr; }
    __device__ __forceinline__ void operator()(const f32x4 (&acc)[2][2][4][2], const Unit& u, int wr, int wc, int fr, int fq, const LAS float* bl) const { if (u.aux == 4) dn.half(acc, u, wr, wc, fr, fq, bl); else dn(acc, u, wr, wc, fr, fq, bl); }
};
struct EpiMoe {
    static constexpr bool PERM = true;
    __device__ static __forceinline__ int nstores(const Unit&) { return MOE_MERGED ? 0 : 16; }
    EpiGU gu; EpiDown dn;
    __device__ __forceinline__ const float* bias_row(const Unit& u) const { return u.aux == 2 ? gu.bias_row(u) : dn.bias_row(u); }
    __device__ __forceinline__ const float* aux_row(const Unit& u) const { return u.aux == 2 ? gu.aux_row(u) : nullptr; }
    __device__ __forceinline__ void operator()(const f32x4 (&acc)[2][2][4][2], const Unit& u, int wr, int wc, int fr, int fq, const LAS float* bl) const { if (u.aux == 2) gu(acc, u, wr, wc, fr, fq, bl); else if (u.aux == 4) dn.half(acc, u, wr, wc, fr, fq, bl); else dn(acc, u, wr, wc, fr, fq, bl); }
};

namespace att {
constexpr int KS_STRIDE = 144, VT_STRIDE = 520;
constexpr int L_KS = 0, L_VT = 36864, L_ST = 70144, L_SC = 102912, L_END = 103936;
static_assert(L_VT == 256 * KS_STRIDE && L_ST == L_VT + 64 * VT_STRIDE && L_END <= RING_BYTES, "attention LDS map");
__device__ __forceinline__ int crow(int r, int hi) { return (r & 3) + 8 * (r >> 2) + 4 * hi; }

struct KVRegs { v4u k[4], v[4]; };
__device__ __forceinline__ void attn_load(KVRegs& R, int uu, const bf16* Kb, const bf16* Vb) {
    const int tid = threadIdx.x, n = uu & 63, kvh = (uu >> 6) & 3, b = uu >> 8, tokbase = b * SEQ, r0 = 128 * (n - 1);
#pragma unroll
    for (int it = 0; it < 4; ++it) { const int p = tid + 512 * it, row = p >> 3, ch = p & 7; int pos = r0 + row; pos = pos < 0 ? 0 : pos;
        R.k[it] = *(const v4u*)(Kb + (size_t)(tokbase + pos) * KVW + kvh * 64 + ch * 8); }
#pragma unroll
    for (int it = 0; it < 4; ++it) { const int p = tid + 512 * it, key = p & 255, c = p >> 8; int pos = r0 + key; pos = pos < 0 ? 0 : pos;
        R.v[it] = *(const v4u*)(Vb + (size_t)(tokbase + pos) * KVW + kvh * 64 + c * 8); }
}
__device__ __forceinline__ void attn_store(const KVRegs& R, LAS unsigned char* lds) {
    const int tid = threadIdx.x;
#pragma unroll
    for (int it = 0; it < 4; ++it) { const int p = tid + 512 * it, row = p >> 3, ch = p & 7; *(LAS v4u*)(lds + L_KS + row * KS_STRIDE + ch * 16) = R.k[it]; }
#pragma unroll
    for (int it = 0; it < 4; ++it) { const int p = tid + 512 * it, key = p & 255, c = p >> 8; const v4u v = R.v[it];
        LAS unsigned short* vt = (LAS unsigned short*)(lds + L_VT + (8 * c) * VT_STRIDE + key * 2);
        vt[0 * (VT_STRIDE / 2)] = (unsigned short)(v.x & 0xffffu); vt[1 * (VT_STRIDE / 2)] = (unsigned short)(v.x >> 16);
        vt[2 * (VT_STRIDE / 2)] = (unsigned short)(v.y & 0xffffu); vt[3 * (VT_STRIDE / 2)] = (unsigned short)(v.y >> 16);
        vt[4 * (VT_STRIDE / 2)] = (unsigned short)(v.z & 0xffffu); vt[5 * (VT_STRIDE / 2)] = (unsigned short)(v.z >> 16);
        vt[6 * (VT_STRIDE / 2)] = (unsigned short)(v.w & 0xffffu); vt[7 * (VT_STRIDE / 2)] = (unsigned short)(v.w >> 16); }
}
struct ConvCtx { const bf16* Ub; bf16* CB; const LAS float* w; int c0, row; bool on; v4u um2, um1; };
struct ConvB { v4u u[4], cb[4]; };
__device__ __forceinline__ void conv_issue(ConvB& B, const ConvCtx& C) {
#pragma unroll
    for (int r = 0; r < 4; ++r) { const size_t off = (size_t)(C.row + r) * 1024 + C.c0; B.u[r] = *(const v4u*)(C.Ub + off); B.cb[r] = *(const v4u*)(C.CB + off); }
}
__device__ __forceinline__ void conv_finish(const ConvB& B, ConvCtx& C) {
    float w0[8], w1[8], w2[8];
    { const f32x4 a0 = *(const LAS f32x4*)(C.w + C.c0), a1 = *(const LAS f32x4*)(C.w + C.c0 + 4), b0 = *(const LAS f32x4*)(C.w + 1024 + C.c0), b1 = *(const LAS f32x4*)(C.w + 1024 + C.c0 + 4),
                  c0_ = *(const LAS f32x4*)(C.w + 2048 + C.c0), c1_ = *(const LAS f32x4*)(C.w + 2048 + C.c0 + 4);
#pragma unroll
      for (int q = 0; q < 4; ++q) { w0[q] = a0[q]; w0[q + 4] = a1[q]; w1[q] = b0[q]; w1[q + 4] = b1[q]; w2[q] = c0_[q]; w2[q + 4] = c1_[q]; } }
#pragma unroll
    for (int r = 0; r < 4; ++r) { const v4u u0 = B.u[r], cb = B.cb[r], um2 = C.um2, um1 = C.um1; v4u o;
#define CONV2(F, qa) cvt_pk_bf16(bf_lo(cb.F) * (w0[qa] * bf_lo(um2.F) + w1[qa] * bf_lo(um1.F) + w2[qa] * bf_lo(u0.F)), bf_hi(cb.F) * (w0[qa + 1] * bf_hi(um2.F) + w1[qa + 1] * bf_hi(um1.F) + w2[qa + 1] * bf_hi(u0.F)))
        o.x = CONV2(x, 0); o.y = CONV2(y, 2); o.z = CONV2(z, 4); o.w = CONV2(w, 6);
#undef CONV2
        if (C.on) { *(v4u*)(C.CB + (size_t)(C.row + r) * 1024 + C.c0) = o; C.um2 = um1; C.um1 = u0; } }
    if (C.on) C.row += 4;
}
template <int SUB> __device__ __forceinline__ void attn_sub(LAS unsigned char* lds, int uu, int un, KVRegs& R, const bf16* Q, const bf16* Kb, const bf16* Vb, bf16* O, float sinkv, int hq, ConvCtx& CV) {
    const int tid = threadIdx.x, lane = tid & 63, r32 = lane & 31, hi = lane >> 5, wid = __builtin_amdgcn_readfirstlane(tid >> 6);
    const int n = uu & 63, b = uu >> 8, tokbase = b * SEQ;
    LAS float* scr = (LAS float*)(lds + L_SC + wid * 128);
    LAS unsigned short* stg = (LAS unsigned short*)(lds + L_ST + wid * 4096);
    {
        const int q0 = 64 * (wid & 1) + 32 * SUB, tb = q0 >> 5;
        const size_t qtok = (size_t)tokbase + 128 * n + q0;
        bf16x8 qf[4];
#pragma unroll
        for (int s = 0; s < 4; ++s) qf[s] = *(const bf16x8*)(Q + (qtok + r32) * 1024 + hq * 64 + 16 * s + 8 * hi);
        if constexpr (SUB == 0) { if (KV_PREFETCH) attn_load(R, un, Kb, Vb); }
        ConvB CBt; conv_issue(CBt, CV);
        f32x16 sc[5];
#pragma unroll
        for (int i = 0; i < 5; ++i) { f32x16 a = {};
#pragma unroll
            for (int s = 0; s < 4; ++s) { const bf16x8 kf = *(const LAS bf16x8*)(lds + L_KS + (32 * (tb + i) + r32) * KS_STRIDE + (16 * s + 8 * hi) * 2);
                a = __builtin_amdgcn_mfma_f32_32x32x16_bf16(kf, qf[s], a, 0, 0, 0); }
            sc[i] = a; }
#pragma unroll
        for (int r = 0; r < 16; ++r) { const int kl = crow(r, hi);
            if (!(kl > r32)) sc[0][r] = -INFINITY;
            if (!(kl <= r32)) sc[4][r] = -INFINITY; }
        if (n == 0) {
#pragma unroll
            for (int i = 0; i < 4; ++i) if (tb + i < 4) {
#pragma unroll
                for (int r = 0; r < 16; ++r) sc[i][r] = -INFINITY; } }
        float mx = sinkv;
#pragma unroll
        for (int i = 0; i < 5; ++i)
#pragma unroll
            for (int r = 0; r < 16; ++r) mx = fmaxf(mx, sc[i][r]);
        mx = fmaxf(mx, __shfl_xor(mx, 32));
        float sum = 0.f;
#pragma unroll
        for (int i = 0; i < 5; ++i)
#pragma unroll
            for (int r = 0; r < 16; ++r) { const float p = __builtin_amdgcn_exp2f(sc[i][r] - mx); sc[i][r] = p; sum += p; }
        sum += __shfl_xor(sum, 32);
        const float denom = sum + __builtin_amdgcn_exp2f(sinkv - mx);
        if (hi == 0) scr[r32] = __builtin_amdgcn_rcpf(denom);
        f32x16 o[2]; o[0] = f32x16{}; o[1] = f32x16{};
#pragma unroll
        for (int i = 0; i < 5; ++i)
#pragma unroll
            for (int s2 = 0; s2 < 2; ++s2) {
                v4u pw; pw.x = cvt_pk_bf16(sc[i][8 * s2 + 0], sc[i][8 * s2 + 1]); pw.y = cvt_pk_bf16(sc[i][8 * s2 + 2], sc[i][8 * s2 + 3]);
                pw.z = cvt_pk_bf16(sc[i][8 * s2 + 4], sc[i][8 * s2 + 5]); pw.w = cvt_pk_bf16(sc[i][8 * s2 + 6], sc[i][8 * s2 + 7]);
                const bf16x8 pa = __builtin_bit_cast(bf16x8, pw);
                const int key0 = 32 * (tb + i) + 16 * s2 + 4 * hi;
#pragma unroll
                for (int dh = 0; dh < 2; ++dh) { const LAS unsigned char* vp = lds + L_VT + (32 * dh + r32) * VT_STRIDE + key0 * 2;
                    const s16x4 lo = *(const LAS s16x4*)vp, h4 = *(const LAS s16x4*)(vp + 16);
                    const bf16x8 vb = {lo[0], lo[1], lo[2], lo[3], h4[0], h4[1], h4[2], h4[3]};
                    o[dh] = __builtin_amdgcn_mfma_f32_32x32x16_bf16(pa, vb, o[dh], 0, 0, 0); } }
#pragma unroll
        for (int r = 0; r < 16; ++r) { const int orow = crow(r, hi); const float rl = scr[orow];
#pragma unroll
            for (int dh = 0; dh < 2; ++dh) stg[orow * 64 + dh * 32 + r32] = (unsigned short)(cvt_pk_bf16(o[dh][r] * rl, 0.f) & 0xffffu); }
        bf16* Ow = O + qtok * 1024 + hq * 64;
#pragma unroll
        for (int i = 0; i < 4; ++i) { const int row = i * 8 + (lane >> 3), ch = lane & 7; const v4u v = *(const LAS v4u*)(stg + row * 64 + ch * 8); *(v4u*)(Ow + (size_t)row * 1024 + ch * 8) = v; }
        conv_finish(CBt, CV);
    }
}
__device__ __forceinline__ void attn_compute(LAS unsigned char* lds, int uu, int un, KVRegs& R, const bf16* Q, const bf16* Kb, const bf16* Vb, bf16* O, const float* sinks, ConvCtx& CV) {
    const int wid = __builtin_amdgcn_readfirstlane(threadIdx.x >> 6), kvh = (uu >> 6) & 3, hq = 4 * kvh + (wid >> 1);
    const float sinkv = sinks[hq] * LOG2E;
    attn_sub<0>(lds, uu, un, R, Q, Kb, Vb, O, sinkv, hq, CV);
    attn_sub<1>(lds, uu, un, R, Q, Kb, Vb, O, sinkv, hq, CV);
    __syncthreads();
}
}

struct Args { const float* in[19]; float* out; unsigned char* ws; int ph_lo, ph_hi, li, pad; };

__global__ void __launch_bounds__(NWAVES * 64, 2) fwd_kernel(Args args) {
    extern __shared__ __attribute__((aligned(16))) unsigned char lds_raw[];
    LAS unsigned char* lds = (LAS unsigned char*)lds_raw;
    volatile LAS unsigned* MISC = (volatile LAS unsigned*)(lds + MISC_OFF);
    const int tid = threadIdx.x, lane = tid & 63, wave = __builtin_amdgcn_readfirstlane(tid >> 6);
    const int G = gridDim.x; const int bx = blockIdx.x; const int vcu = (G % 8 == 0) ? (bx % 8) * (G / 8) + bx / 8 : bx;
    unsigned char* ws = args.ws;
    gu32* ctl = (gu32*)(ws + WS_CTL);
    const float* x = args.in[0]; const float* g_mix = args.in[1]; const float* w_in = args.in[2]; const float* b_in = args.in[3]; const float* sinks = args.in[4];
    const float* w_conv = args.in[5]; const float* w_attn_o = args.in[6]; const float* w_conv_o = args.in[7]; const float* w_out = args.in[8]; const float* g_ffn = args.in[9];
    const float* w_router = args.in[10]; const float* b_router = args.in[11]; const float* w_gate = args.in[12]; const float* b_gate = args.in[13]; const float* w_up = args.in[14];
    const float* b_up = args.in[15]; const float* w_down = args.in[16]; const float* b_down = args.in[17]; const float* g_final = args.in[18];
    float* out = args.out;
    float* binp = (float*)(ws + WS_BINP); float* bgu = (float*)(ws + WS_BGU); float* cosT = (float*)(ws + WS_COS); float* sinT = (float*)(ws + WS_SIN);
    bf16* Win_t = (bf16*)(ws + WS_WIN); bf16* Wao_t = (bf16*)(ws + WS_WAO); bf16* Wco_t = (bf16*)(ws + WS_WCO); bf16* Wout_t = (bf16*)(ws + WS_WOUT);
    bf16* XN = (bf16*)(ws + WS_XN); bf16* Qb = (bf16*)(ws + WS_Q); bf16* Kb = (bf16*)(ws + WS_K); bf16* Vb = (bf16*)(ws + WS_V); bf16* CB = (bf16*)(ws + WS_CB);
    bf16* MG = (bf16*)(ws + WS_MG); bf16* Ub = (bf16*)(ws + WS_U); bf16* SA = (bf16*)(ws + WS_SA); bf16* SC = (bf16*)(ws + WS_SC);
    bf16* Wgu_t = (bf16*)(ws + WS_WGU); bf16* Wd_t = (bf16*)(ws + WS_WD);
    int* tokrel = (int*)(ws + WS_TOKREL); float* rstdrel = (float*)(ws + WS_RSTDREL); unsigned* route = (unsigned*)(ws + WS_ROUTE); float* routew = (float*)(ws + WS_ROUTEW);
    bf16* ACT = (bf16*)(ws + WS_ACT); bf16* Yb = (bf16*)(ws + WS_Y); bf16* DLb = (bf16*)(ws + WS_DL);

    for (int u = tid; u < (LDS_BYTES - LDSCTL_OFF) / 4; u += NWAVES * 64) ((LAS unsigned*)(lds + LDSCTL_OFF))[u] = 0u;
    __syncthreads();
    XcdBarrier bar; bar.bar = (unsigned*)(ctl + CW_BAR); bar.x = 0; bar.st = nullptr;
    if (N_LAUNCHES != PER_PHASE) bar = xcd_barrier_post((unsigned*)(ctl + CW_BAR), MISC + 8);
#define GRID_BAR(seam) do { if (N_LAUNCHES == PER_PHASE) { if (tid == 0) __hip_atomic_store(ctl + CW_TMO, 0xBADBA0u | (unsigned)(seam), RLX_AGENT); } else { xcd_barrier(bar); } } while (0)
    const int lo = args.ph_lo, hi = args.ph_hi;
#define IN(k) (lo <= (k) && (k) < hi)
#define BOTH(k) (IN(k) && IN((k) + 1))
    const int gw = vcu * NWAVES + wave, NGW = G * NWAVES;
#define STAMP(k) do { if ((DBG_TIME_PH >= 0 || DBG_RVR_PH >= 0) && (k) < 16 && bx == 0 && tid == 0) __hip_atomic_store(ctl + CW_TS + (k), (unsigned)__builtin_amdgcn_s_memrealtime(), RLX_AGENT); } while (0)
    STAMP(0);

    LAS unsigned long long* ptab = (LAS unsigned long long*)(lds + TAB_OFF + 1600);
    if (tid == 0) { ptab[0] = (unsigned long long)w_attn_o; ptab[1] = (unsigned long long)w_conv_o; ptab[2] = (unsigned long long)w_out; ptab[3] = (unsigned long long)w_gate; ptab[4] = (unsigned long long)w_up; ptab[5] = (unsigned long long)w_down;
        ptab[6] = (unsigned long long)Wao_t; ptab[7] = (unsigned long long)Wco_t; ptab[8] = (unsigned long long)Wout_t; ptab[9] = (unsigned long long)Wgu_t; ptab[10] = (unsigned long long)Wgu_t; ptab[11] = (unsigned long long)Wd_t; }
    __syncthreads();
    LAS float* gffl = (LAS float*)(lds + RING_OFF + 69632);
    const CvtSrc CS{w_in, Win_t, ptab, gffl};
    const int HELP = (HELPER_CUS > 0 && G == 256 && N_LAUNCHES == 1) ? HELPER_CUS : 0;
    if (IN(0)) {
        LAS unsigned char* scr = lds + RING_OFF + wave * 8704;
        for (int i = tid; i < 256; i += 512) *(LAS f32x4*)(gffl + 4 * i) = *(const f32x4*)(g_ffn + 4 * i);
        __syncthreads();
        cvt_run<0>(CS, gw, NGW, CVT_IN_ITEMS, scr, lane);
        if (HELP == 0) cvt_run<1>(CS, gw, NGW, CVT_REST_ITEMS - SLACK_P1_ITEMS - SLACK_P6_ITEMS, scr, lane);
        const int gt = vcu * (NWAVES * 64) + tid, NGT = G * NWAVES * 64;
        for (int c = gt; c < NIN; c += NGT) binp[win_dest(c)] = b_in[c];
        for (int i = gt; i < NEXP * DFF; i += NGT) { const int e = i >> 10, c = i & 1023; bgu[e * 2048 + map_dest(2, c)] = b_gate[i]; bgu[e * 2048 + map_dest(3, c)] = b_up[i]; }
        for (int i = gt; i < SEQ * 32; i += NGT) { const int pos = i >> 5, f = i & 31;
            const double inv = exp2(-(double)f * (13.287712379549449 / 32.0));
            const double rev = (double)pos * inv * 0.15915494309189535; const float fr = (float)(rev - rint(rev));
            cosT[i] = __builtin_amdgcn_cosf(fr); sinT[i] = __builtin_amdgcn_sinf(fr); }
        for (int m = gw; m < M; m += NGW) rms_row_to_bf16(x + (size_t)m * D, g_mix, XN + (size_t)m * D, lane);
        if (BOTH(0)) GRID_BAR(0); STAMP(1);
    }

#define STAGGER(S_, total_units) do { if (STAGGER_US > 0) { int nu_ = 0; pg8::Unit u_; while (S_.next(nu_, u_)) ++nu_; const int mx_ = ((total_units) + G - 1) / G; \
        if (nu_ < mx_) { const unsigned long long t0_ = __builtin_amdgcn_s_memrealtime(); while (__builtin_amdgcn_s_memrealtime() - t0_ < (unsigned long long)(STAGGER_US * 100)) __builtin_amdgcn_s_sleep(16); } } } while (0)
    if (IN(1)) {
        if (bx < G - HELP) {
            DenseOrder S{M / 256, NIN / 256, G - HELP, bx, D, (const char*)XN, (const char*)Win_t};
            EpiInProj E{Qb, Kb, Vb, CB, Ub, SA, SC, binp, cosT, sinT};
            if (HELP == 0) STAGGER(S, (M / 256) * (NIN / 256));
            for (int i = tid; i < 256; i += 512) *(LAS f32x4*)(gffl + 4 * i) = *(const f32x4*)(g_ffn + 4 * i);
            __syncthreads();
            if (HELP == 0) slack_convert(CS, (M / 256) * (NIN / 256), G, bx, CVT_REST_ITEMS - SLACK_P1_ITEMS - SLACK_P6_ITEMS, SLACK_P1_ITEMS, lds + RING_OFF + wave * 8704, wave, lane);
            __syncthreads();
            pg8::gemm_phase<EpiInProj, DenseOrder, true, false>(lds + RING_OFF, D, S, E, (DBG_KLOOP_PH == 1 && bx == 0) ? (unsigned*)(ctl + CW_TS + 16) : nullptr);
        } else {
            cvt_run<1>(CS, (bx - (G - HELP)) * NWAVES + wave, HELP * NWAVES, CVT_REST_ITEMS, lds + RING_OFF + wave * 8704, lane);
        }
        if (BOTH(1)) GRID_BAR(1); STAMP(2);
    }

    if (IN(2)) {
        const bool cinl = CONV_INLINE && G == 256 && BATCH * NKVH * (SEQ / 128) == 512;
        { constexpr int NU = BATCH * NKVH * (SEQ / 128); att::KVRegs R; int uu = vcu;
            LAS float* wcl = (LAS float*)(lds + RING_OFF + 104448);
            for (int i = tid; i < 768; i += 512) *(LAS f32x4*)(wcl + 4 * i) = *(const f32x4*)(w_conv + 4 * i);
            __syncthreads();
            att::ConvCtx CV; CV.Ub = Ub; CV.CB = CB; CV.w = wcl; CV.c0 = (tid & 127) * 8; CV.row = (cinl ? vcu : 0) * 64 + (tid >> 7) * 16; CV.on = cinl; CV.um2 = (v4u){0u, 0u, 0u, 0u}; CV.um1 = (v4u){0u, 0u, 0u, 0u};
            if (cinl && (CV.row & (SEQ - 1)) >= 2) { CV.um2 = *(const v4u*)(Ub + (size_t)(CV.row - 2) * 1024 + CV.c0); CV.um1 = *(const v4u*)(Ub + (size_t)(CV.row - 1) * 1024 + CV.c0); }
            if (KV_PREFETCH && uu < NU) att::attn_load(R, uu, Kb, Vb);
            while (uu < NU) { if (!KV_PREFETCH) att::attn_load(R, uu, Kb, Vb); att::attn_store(R, lds + RING_OFF); __syncthreads(); const int un = uu + G < NU ? uu + G : uu;
                att::attn_compute(lds + RING_OFF, uu, un, R, Qb, Kb, Vb, Qb, sinks, CV); uu += G; } }
        if (!cinl)
        for (int ch = vcu; ch < M / 64; ch += G) {
            const int c0 = (tid & 127) * 8, row0 = ch * 64 + (tid >> 7) * 16, pos0 = row0 & (SEQ - 1);
            float w0[8], w1[8], w2[8];
#pragma unroll
            for (int q = 0; q < 8; ++q) { w0[q] = w_conv[c0 + q]; w1[q] = w_conv[1024 + c0 + q]; w2[q] = w_conv[2048 + c0 + q]; }
            v4u um2 = {0u, 0u, 0u, 0u}, um1 = {0u, 0u, 0u, 0u};
            if (pos0 >= 2) { um2 = *(const v4u*)(Ub + (size_t)(row0 - 2) * 1024 + c0); um1 = *(const v4u*)(Ub + (size_t)(row0 - 1) * 1024 + c0); }
#pragma unroll 4
            for (int r = 0; r < 16; ++r) { const size_t off = (size_t)(row0 + r) * 1024 + c0;
                const v4u u0 = *(const v4u*)(Ub + off), cb = *(const v4u*)(CB + off); v4u o;
#define CONV2(F, qa) cvt_pk_bf16(bf_lo(cb.F) * (w0[qa] * bf_lo(um2.F) + w1[qa] * bf_lo(um1.F) + w2[qa] * bf_lo(u0.F)), bf_hi(cb.F) * (w0[qa + 1] * bf_hi(um2.F) + w1[qa + 1] * bf_hi(um1.F) + w2[qa + 1] * bf_hi(u0.F)))
                o.x = CONV2(x, 0); o.y = CONV2(y, 2); o.z = CONV2(z, 4); o.w = CONV2(w, 6);
#undef CONV2
                *(v4u*)(CB + off) = o; um2 = um1; um1 = u0; }
        }
        if (BOTH(2)) GRID_BAR(2); STAMP(3);
    }

    if (IN(3)) {
        MergeOrder S{M / 256, D / 256, G, bx, D, (const char*)Qb, (const char*)Wao_t, (const char*)CB, (const char*)Wco_t};
        EpiMerge E{SA, SC, MG};
        pg8::gemm_phase<EpiMerge, MergeOrder, true, false>(lds + RING_OFF, D, S, E, (DBG_KLOOP_PH == 3 && bx == 0) ? (unsigned*)(ctl + CW_TS + 16) : nullptr);
        if (BOTH(3)) GRID_BAR(3); STAMP(4);
    }

    if (IN(4)) {
        DenseOrder S{M / 256, D / 256, G, bx, D, (const char*)MG, (const char*)Wout_t};
        EpiRes E{DLb};
        pg8::gemm_phase<EpiRes, DenseOrder, false, false>(lds + RING_OFF, D, S, E, (DBG_KLOOP_PH == 4 && bx == 0) ? (unsigned*)(ctl + CW_TS + 16) : nullptr);
        if (BOTH(4)) GRID_BAR(4); STAMP(5);
    }

#if P5_MFMA
    if (IN(5)) {
        LAS float* GL = (LAS float*)(lds + RING_OFF);
        LAS float* PL = (LAS float*)(lds + RING_OFF + 4096);
        LAS float* PS = (LAS float*)(lds + RING_OFF + 4096 + 65536);
        LAS int* lcnt = (LAS int*)(lds + TOK_OFF); LAS int* lbase = lcnt + 32; LAS unsigned* ce = (LAS unsigned*)(lds + TOK_OFF + 256); LAS int* cr = (LAS int*)(lds + TOK_OFF + 256 + 1024); LAS float* cw = (LAS float*)(lds + TOK_OFF + 256 + 2048);
        LAS float* crs = (LAS float*)(lds + TOK_OFF + 256 + 3072);
        for (int i = tid; i < 256; i += 512) *(LAS f32x4*)(GL + 4 * i) = *(const f32x4*)(g_ffn + 4 * i);
        __syncthreads();
        const int r32 = lane & 31, kh = lane >> 5, kb = 128 * wave;
        const float brt = b_router[r32];
        bf16x8 Bh[8], Bl[8];
#pragma unroll
        for (int f = 0; f < 8; ++f) { const int k0 = kb + 32 * (f >> 1) + 16 * kh + 8 * (f & 1);
            const f32x4 g0 = *(const LAS f32x4*)(GL + k0), g1 = *(const LAS f32x4*)(GL + k0 + 4);
            float wv[8];
#pragma unroll
            for (int j = 0; j < 8; ++j) wv[j] = w_router[(size_t)(k0 + j) * 32 + r32] * (j < 4 ? g0[j] : g1[j - 4]);
            v4u hw, lw;
#define SPLIT2(dsth, dstl, a_, b_) do { const unsigned h_ = cvt_pk_bf16(a_, b_); dsth = h_; dstl = cvt_pk_bf16((a_) - bf_lo(h_), (b_) - bf_hi(h_)); } while (0)
            SPLIT2(hw.x, lw.x, wv[0], wv[1]); SPLIT2(hw.y, lw.y, wv[2], wv[3]); SPLIT2(hw.z, lw.z, wv[4], wv[5]); SPLIT2(hw.w, lw.w, wv[6], wv[7]);
            Bh[f] = __builtin_bit_cast(bf16x8, hw); Bl[f] = __builtin_bit_cast(bf16x8, lw); }
        for (int ch = vcu; ch < M / 64; ch += G) {
            if (tid < 32) lcnt[tid] = 0;
            f32x16 acc[2]; acc[0] = f32x16{}; acc[1] = f32x16{}; float ss[2] = {0.f, 0.f};
#define P5M_LOADG(XQ, DQ, mt_, sp_) do { const size_t ro_ = (size_t)(ch * 64 + 32 * (mt_) + r32) * D + kb + 16 * kh + 64 * (sp_); \
                _Pragma("unroll") for (int S_ = 0; S_ < 2; ++S_) { _Pragma("unroll") for (int q = 0; q < 4; ++q) XQ[S_][q] = *(const f32x4*)(x + ro_ + 32 * S_ + 4 * q); \
                    DQ[S_][0] = *(const v4u*)(DLb + ro_ + 32 * S_); DQ[S_][1] = *(const v4u*)(DLb + ro_ + 32 * S_ + 8); } } while (0)
#define P5M_PROC(XQ, DQ, mt_, sp_) do { const size_t ro_ = (size_t)(ch * 64 + 32 * (mt_) + r32) * D + kb + 16 * kh + 64 * (sp_); \
                _Pragma("unroll") for (int S_ = 0; S_ < 2; ++S_) { const int S = 2 * (sp_) + S_; float x1[16]; \
                    _Pragma("unroll") for (int q = 0; q < 4; ++q) { x1[4 * q] = XQ[S_][q].x; x1[4 * q + 1] = XQ[S_][q].y; x1[4 * q + 2] = XQ[S_][q].z; x1[4 * q + 3] = XQ[S_][q].w; } \
                    _Pragma("unroll") for (int h = 0; h < 2; ++h) { const v4u d = DQ[S_][h]; \
                        x1[8 * h + 0] += bf_lo(d.x); x1[8 * h + 1] += bf_hi(d.x); x1[8 * h + 2] += bf_lo(d.y); x1[8 * h + 3] += bf_hi(d.y); \
                        x1[8 * h + 4] += bf_lo(d.z); x1[8 * h + 5] += bf_hi(d.z); x1[8 * h + 6] += bf_lo(d.w); x1[8 * h + 7] += bf_hi(d.w); } \
                    float s_ = 0.f; \
                    _Pragma("unroll") for (int j = 0; j < 16; ++j) s_ += x1[j] * x1[j]; \
                    ss[mt_] += s_; \
                    const int kk = kb + 32 * S + 16 * kh; v4u o0, o1; \
                    { const f32x4 g0 = *(const LAS f32x4*)(GL + kk), g1 = *(const LAS f32x4*)(GL + kk + 4), g2 = *(const LAS f32x4*)(GL + kk + 8), g3 = *(const LAS f32x4*)(GL + kk + 12); \
                      if (FOLD_G) { o0.x = cvt_pk_bf16(x1[0], x1[1]); o0.y = cvt_pk_bf16(x1[2], x1[3]); o0.z = cvt_pk_bf16(x1[4], x1[5]); o0.w = cvt_pk_bf16(x1[6], x1[7]); \
                                    o1.x = cvt_pk_bf16(x1[8], x1[9]); o1.y = cvt_pk_bf16(x1[10], x1[11]); o1.z = cvt_pk_bf16(x1[12], x1[13]); o1.w = cvt_pk_bf16(x1[14], x1[15]); } else { \
                      o0.x = cvt_pk_bf16(x1[0] * g0.x, x1[1] * g0.y); o0.y = cvt_pk_bf16(x1[2] * g0.z, x1[3] * g0.w); o0.z = cvt_pk_bf16(x1[4] * g1.x, x1[5] * g1.y); o0.w = cvt_pk_bf16(x1[6] * g1.z, x1[7] * g1.w); \
                      o1.x = cvt_pk_bf16(x1[8] * g2.x, x1[9] * g2.y); o1.y = cvt_pk_bf16(x1[10] * g2.z, x1[11] * g2.w); o1.z = cvt_pk_bf16(x1[12] * g3.x, x1[13] * g3.y); o1.w = cvt_pk_bf16(x1[14] * g3.z, x1[15] * g3.w); } } \
                    *(v4u*)(XN + ro_ + 32 * S_) = o0; *(v4u*)(XN + ro_ + 32 * S_ + 8) = o1; \
                    _Pragma("unroll") for (int q = 0; q < 2; ++q) { v4u hw, lw; \
                        SPLIT2(hw.x, lw.x, x1[8 * q + 0], x1[8 * q + 1]); SPLIT2(hw.y, lw.y, x1[8 * q + 2], x1[8 * q + 3]); SPLIT2(hw.z, lw.z, x1[8 * q + 4], x1[8 * q + 5]); SPLIT2(hw.w, lw.w, x1[8 * q + 6], x1[8 * q + 7]); \
                        const bf16x8 Ah = __builtin_bit_cast(bf16x8, hw), Al = __builtin_bit_cast(bf16x8, lw); \
                        acc[mt_] = __builtin_amdgcn_mfma_f32_32x32x16_bf16(Ah, Bh[2 * S + q], acc[mt_], 0, 0, 0); \
                        acc[mt_] = __builtin_amdgcn_mfma_f32_32x32x16_bf16(Al, Bh[2 * S + q], acc[mt_], 0, 0, 0); \
                        acc[mt_] = __builtin_amdgcn_mfma_f32_32x32x16_bf16(Ah, Bl[2 * S + q], acc[mt_], 0, 0, 0); } } } while (0)
            { f32x4 xa_[2][4], xb_[2][4]; v4u da_[2][2], db_[2][2];
              P5M_LOADG(xa_, da_, 0, 0); P5M_LOADG(xb_, db_, 0, 1);
              P5M_PROC(xa_, da_, 0, 0); P5M_LOADG(xa_, da_, 1, 0);
              P5M_PROC(xb_, db_, 0, 1); P5M_LOADG(xb_, db_, 1, 1);
              P5M_PROC(xa_, da_, 1, 0); P5M_PROC(xb_, db_, 1, 1); }
#undef P5M_LOADG
#undef P5M_PROC
#undef SPLIT2
#pragma unroll
            for (int mt = 0; mt < 2; ++mt) { const float st = ss[mt] + __shfl_xor(ss[mt], 32); if (kh == 0) PS[wave * 64 + 32 * mt + r32] = st;
#pragma unroll
                for (int r = 0; r < 16; ++r) PL[(wave * 64 + 32 * mt + ((r & 3) + 8 * (r >> 2) + 4 * kh)) * 32 + r32] = acc[mt][r]; }
            __syncthreads();
#define P5_ROWPOST(lgin, tl_) do { float lg = lgin; int te[4]; float tlg[4]; \
                _Pragma("unroll") for (int k = 0; k < 4; ++k) { const float mx = half_max_dpp(lg); const unsigned long long bm = __ballot(lg == mx); const int sel = __builtin_ctzll(bm); te[k] = sel; tlg[k] = mx; if ((lane & 31) == sel) lg = -INFINITY; } \
                const float e1 = __expf(tlg[1] - tlg[0]), e2 = __expf(tlg[2] - tlg[0]), e3 = __expf(tlg[3] - tlg[0]), inv = 1.0f / (1.0f + e1 + e2 + e3); \
                if (lane < 4) { const int ek = lane == 0 ? te[0] : lane == 1 ? te[1] : lane == 2 ? te[2] : te[3]; const float wk = (lane == 0 ? 1.0f : lane == 1 ? e1 : lane == 2 ? e2 : e3) * inv; \
                    const int r = atomicAdd((int*)(lcnt + ek), 1); ce[(tl_) * 4 + lane] = (unsigned)ek; cr[(tl_) * 4 + lane] = r; cw[(tl_) * 4 + lane] = wk; } } while (0)
#pragma unroll 1
            for (int rr = 0; rr < 8; ++rr) { const int tl = wave * 8 + rr; float lgs = 0.f, sq = 0.f;
#pragma unroll
                for (int w2 = 0; w2 < 8; ++w2) { lgs += PL[(w2 * 64 + tl) * 32 + r32]; sq += PS[w2 * 64 + tl]; }
                const float rstd = 1.f / sqrtf(sq * (1.f / D) + RMS_EPS);
                if (lane == 0) crs[tl] = rstd;
                P5_ROWPOST(lgs * rstd + brt, tl); }
#undef P5_ROWPOST
            __syncthreads();
            if (tid < 32) lbase[tid] = (int)__hip_atomic_fetch_add(ctl + CW_CURSOR + 64 * tid, (unsigned)lcnt[tid], RLX_AGENT);
            __syncthreads();
            if (tid < 256) { const int t = ch * 64 + (tid >> 2); const unsigned e = ce[tid]; const int rel = lbase[e] + cr[tid];
                tokrel[e * SLOTCAP + rel] = t; rstdrel[e * SLOTCAP + rel] = crs[tid >> 2]; route[t * 4 + (tid & 3)] = e | ((unsigned)rel << 8); routew[t * 4 + (tid & 3)] = cw[tid]; }
            __syncthreads();
        }
        if (BOTH(5)) GRID_BAR(5); STAMP(6);
    }
#else
    if (IN(5)) {
        LAS float* wT = (LAS float*)(lds + RING_OFF);
        { f32x4 wv[16];
#pragma unroll
          for (int k = 0; k < 16; ++k) { const int idx = tid + 512 * k, c = idx & 1023, e4 = idx >> 10; wv[k] = *(const f32x4*)(w_router + (size_t)c * 32 + e4 * 4); }
#pragma unroll
          for (int k = 0; k < 16; ++k) { const int idx = tid + 512 * k, c = idx & 1023, e4 = idx >> 10;
            wT[(e4 * 4 + 0) * 1024 + c] = wv[k].x; wT[(e4 * 4 + 1) * 1024 + c] = wv[k].y; wT[(e4 * 4 + 2) * 1024 + c] = wv[k].z; wT[(e4 * 4 + 3) * 1024 + c] = wv[k].w; } }
        LAS int* lcnt = (LAS int*)(lds + TOK_OFF); LAS int* lbase = lcnt + 32; LAS unsigned* ce = (LAS unsigned*)(lds + TOK_OFF + 256); LAS int* cr = (LAS int*)(lds + TOK_OFF + 256 + 1024); LAS float* cw = (LAS float*)(lds + TOK_OFF + 256 + 2048);
        const int psrc = 4 * ((lane & 48) | ((lane & 1) << 3) | ((lane & 2) << 1) | ((lane & 4) >> 1) | ((lane & 8) >> 3));
        const float brt = b_router[lane & 31];
        f32x4 gf[4];
#pragma unroll
        for (int j = 0; j < 4; ++j) gf[j] = *(const f32x4*)(g_ffn + 4 * lane + 256 * j);
        for (int ch = vcu; ch < M / 64; ch += G) {
            if (tid < 32) lcnt[tid] = 0;
            __syncthreads();
#define P5_LOADROW(dst, dd, t_) _Pragma("unroll") for (int j = 0; j < 4; ++j) { dst[j] = *(const f32x4*)(x + (size_t)(t_) * D + 4 * lane + 256 * j); dd[j] = *(const v2u*)(DLb + (size_t)(t_) * D + 4 * lane + 256 * j); }
#define P5_ADDD(dst, dd) _Pragma("unroll") for (int j = 0; j < 4; ++j) { dst[j].x += bf_lo(dd[j].x); dst[j].y += bf_hi(dd[j].x); dst[j].z += bf_lo(dd[j].y); dst[j].w += bf_hi(dd[j].y); }
#define P5_BFLY(v, NV, MK) _Pragma("unroll") for (int i = 0; i < NV; ++i) { const bool up = (lane & MK) != 0; const float send = up ? v[i] : v[i + NV], keep = up ? v[i + NV] : v[i]; v[i] = keep + __shfl_xor(send, MK); }
#define P5_ROWPOST(lgin, tl_) do { float lg = __builtin_bit_cast(float, __builtin_amdgcn_ds_bpermute(psrc, __builtin_bit_cast(int, lgin))) + brt; int te[4]; float tlg[4];     \
                _Pragma("unroll") for (int k = 0; k < 4; ++k) { const float mx = half_max_dpp(lg); const unsigned long long bm = __ballot(lg == mx); const int sel = __builtin_ctzll(bm); te[k] = sel; tlg[k] = mx; if ((lane & 31) == sel) lg = -INFINITY; } \
                const float e1 = __expf(tlg[1] - tlg[0]), e2 = __expf(tlg[2] - tlg[0]), e3 = __expf(tlg[3] - tlg[0]), inv = 1.0f / (1.0f + e1 + e2 + e3); \
                if (lane < 4) { const int ek = lane == 0 ? te[0] : lane == 1 ? te[1] : lane == 2 ? te[2] : te[3]; const float wk = (lane == 0 ? 1.0f : lane == 1 ? e1 : lane == 2 ? e2 : e3) * inv; \
                    const int r = atomicAdd((int*)(lcnt + ek), 1); ce[(tl_) * 4 + lane] = (unsigned)ek; cr[(tl_) * 4 + lane] = r; cw[(tl_) * 4 + lane] = wk; } } while (0)
            f32x4 xa[4], xb[4]; v2u da[4], db[4];
            P5_LOADROW(xa, da, ch * 64 + wave * 8); P5_LOADROW(xb, db, ch * 64 + wave * 8 + 1);
#pragma unroll 1
            for (int pp = 0; pp < 4; ++pp) {
                const int tl = wave * 8 + 2 * pp, t = ch * 64 + tl, tn = pp < 3 ? t + 2 : t;
                f32x4 na[4], nb[4]; v2u nda[4], ndb[4];
                P5_LOADROW(na, nda, tn); P5_LOADROW(nb, ndb, tn + 1);
                P5_ADDD(xa, da); P5_ADDD(xb, db);
                float sa = 0.f, sb = 0.f;
#pragma unroll
                for (int j = 0; j < 4; ++j) { sa += (xa[j].x * xa[j].x + xa[j].y * xa[j].y) + (xa[j].z * xa[j].z + xa[j].w * xa[j].w); sb += (xb[j].x * xb[j].x + xb[j].y * xb[j].y) + (xb[j].z * xb[j].z + xb[j].w * xb[j].w); }
                const float rstda = 1.f / sqrtf(wave_sum_dpp(sa) * (1.f / D) + RMS_EPS), rstdb = 1.f / sqrtf(wave_sum_dpp(sb) * (1.f / D) + RMS_EPS);
#pragma unroll
                for (int j = 0; j < 4; ++j) { xa[j] = xa[j] * rstda * gf[j]; xb[j] = xb[j] * rstdb * gf[j];
                    v2u w; w.x = cvt_pk_bf16(xa[j].x, xa[j].y); w.y = cvt_pk_bf16(xa[j].z, xa[j].w); *(v2u*)(XN + (size_t)t * D + 4 * lane + 256 * j) = w;
                    v2u w2; w2.x = cvt_pk_bf16(xb[j].x, xb[j].y); w2.y = cvt_pk_bf16(xb[j].z, xb[j].w); *(v2u*)(XN + (size_t)(t + 1) * D + 4 * lane + 256 * j) = w2; }
                f32x2 x2[4][4];
#pragma unroll
                for (int j = 0; j < 4; ++j) { x2[j][0] = (f32x2){xa[j].x, xb[j].x}; x2[j][1] = (f32x2){xa[j].y, xb[j].y}; x2[j][2] = (f32x2){xa[j].z, xb[j].z}; x2[j][3] = (f32x2){xa[j].w, xb[j].w}; }
                float lga, lgb;
                { float h0a, h0b, h1a, h1b;
#define P5_HALF(E0, ra, rb) do { float va[16], vb[16]; \
                    _Pragma("unroll") for (int e = 0; e < 16; ++e) { f32x2 a2 = {0.f, 0.f}, c2 = {0.f, 0.f};     \
                        _Pragma("unroll") for (int j = 0; j < 4; ++j) { const f32x4 w4 = *(const LAS f32x4*)(wT + ((E0) + e) * 1024 + 4 * lane + 256 * j); \
                            a2 += x2[j][0] * (f32x2){w4.x, w4.x}; c2 += x2[j][1] * (f32x2){w4.y, w4.y}; a2 += x2[j][2] * (f32x2){w4.z, w4.z}; c2 += x2[j][3] * (f32x2){w4.w, w4.w}; } \
                        a2 += c2; va[e] = a2.x; vb[e] = a2.y; } \
                    P5_BFLY(va, 8, 1) P5_BFLY(va, 4, 2) P5_BFLY(va, 2, 4) P5_BFLY(va, 1, 8) P5_BFLY(vb, 8, 1) P5_BFLY(vb, 4, 2) P5_BFLY(vb, 2, 4) P5_BFLY(vb, 1, 8) \
                    float ta = va[0] + __shfl_xor(va[0], 16), tb = vb[0] + __shfl_xor(vb[0], 16); ra = ta + __shfl_xor(ta, 32); rb = tb + __shfl_xor(tb, 32); } while (0)
                  P5_HALF(0, h0a, h0b); __builtin_amdgcn_sched_barrier(0); P5_HALF(16, h1a, h1b); __builtin_amdgcn_sched_barrier(0);
#undef P5_HALF
                  lga = (lane & 16) ? h1a : h0a; lgb = (lane & 16) ? h1b : h0b; }
                P5_ROWPOST(lga, tl); __builtin_amdgcn_sched_barrier(0); P5_ROWPOST(lgb, tl + 1);
#pragma unroll
                for (int j = 0; j < 4; ++j) { xa[j] = na[j]; xb[j] = nb[j]; da[j] = nda[j]; db[j] = ndb[j]; }
            }
#undef P5_LOADROW
#undef P5_ADDD
#undef P5_BFLY
#undef P5_ROWPOST
            __syncthreads();
            if (tid < 32) lbase[tid] = (int)__hip_atomic_fetch_add(ctl + CW_CURSOR + 64 * tid, (unsigned)lcnt[tid], RLX_AGENT);
            __syncthreads();
            if (tid < 256) { const int t = ch * 64 + (tid >> 2); const unsigned e = ce[tid]; const int rel = lbase[e] + cr[tid];
                tokrel[e * SLOTCAP + rel] = t; route[t * 4 + (tid & 3)] = e | ((unsigned)rel << 8); routew[t * 4 + (tid & 3)] = cw[tid]; }
            __syncthreads();
        }
        if (BOTH(5)) GRID_BAR(5); STAMP(6);
    }
#endif


    LAS int* t_cnt = (LAS int*)(lds + TAB_CNT); LAS int* t_start = (LAS int*)(lds + TAB_TSTART); LAS int* t_tile = (LAS int*)(lds + TAB_TILEE);
    if (IN(6) || IN(7) || IN(8)) {
        if (tid < 32) t_cnt[tid] = (int)__hip_atomic_load(ctl + CW_CURSOR + 64 * tid, RLX_AGENT);
        __syncthreads();
        if (tid == 0) { int s = 0; for (int e = 0; e < 32; ++e) { t_start[e] = s; s += (t_cnt[e] + 255) >> 8; } t_start[32] = s; }
        __syncthreads();
        for (int i = tid; i < 320; i += 512) { int e = 0; for (int k = 1; k < 32; ++k) if (i >= t_start[k]) e = k; t_tile[i] = e; }
        __syncthreads();
    }
    const int MT = (IN(6) || IN(7) || IN(8)) ? t_start[32] : 0;

    if (IN(6)) {
        LAS unsigned* tokt = (LAS unsigned*)(lds + TOK_OFF);
        MoeOrder S{MT, G, bx, (const char*)XN, (const char*)ACT, (const char*)Wgu_t, (const char*)Wd_t, t_tile, tokt, (unsigned*)(ctl + CW_MT), (unsigned*)(ctl + CW_TMO), MOE_MERGED ? 0 : 1, 0};
        for (int i0 = 0; i0 < MAXU; i0 += 2) { const int i = i0 + (tid >> 8), r = tid & 255; pg8::Unit u;
            if (i < MAXU && S.next(i, u) && u.aux == 2) { const int e = u.e, rel = (u.pm - t_start[e]) * 256 + r; const int tok = rel < t_cnt[e] ? tokrel[e * SLOTCAP + rel] : 0; tokt[i * 256 + r] = (unsigned)tok * 2048u; } }
        __syncthreads();
        EpiMoe E{EpiGU{ACT, bgu, rstdrel, t_start}, EpiDown{Yb, b_down}};
        if (!MOE_MERGED) STAGGER(S, MT * 8);
        for (int i = tid; i < 256; i += 512) *(LAS f32x4*)(gffl + 4 * i) = *(const f32x4*)(g_ffn + 4 * i);
        __syncthreads();
        slack_convert(CS, MT * 8, G, bx, CVT_REST_ITEMS - SLACK_P6_ITEMS, SLACK_P6_ITEMS, lds + RING_OFF + wave * 8704, wave, lane);
        __syncthreads();
        if (MOE_MERGED) pg8::gemm_phase<EpiMoe, MoeOrder, true, true>(lds + RING_OFF, D, S, E, (DBG_KLOOP_PH == 6 && bx == 0) ? (unsigned*)(ctl + CW_TS + 16) : nullptr);
        else { EpiGU Eg{ACT, bgu, rstdrel, t_start}; pg8::gemm_phase<EpiGU, MoeOrder, true, true, false, PF_P6 != 0>(lds + RING_OFF, D, S, Eg, (DBG_KLOOP_PH == 6 && bx == 0) ? (unsigned*)(ctl + CW_TS + 16) : nullptr); }
        if (MOE_MERGED ? IN(8) : BOTH(6)) GRID_BAR(6); STAMP(7);
    }
    if (IN(7)) {
        if (!MOE_MERGED) {
            const int U7 = MT * 4, full7 = (U7 / G) * G, ntail = U7 - full7; const bool split = HALF_TAIL && ntail > 0 && 2 * ntail <= G;
            MoeOrder S{MT, G, bx, (const char*)XN, (const char*)ACT, (const char*)Wgu_t, (const char*)Wd_t, t_tile, (const LAS unsigned*)(lds + TOK_OFF), (unsigned*)(ctl + CW_MT), (unsigned*)(ctl + CW_TMO), 2, split ? full7 : U7};
            EpiMoe E{EpiGU{ACT, bgu, rstdrel, t_start}, EpiDown{Yb, b_down}};
            STAGGER(S, MT * 4);
            EpiDownX Ed{EpiDown{Yb, b_down}};
            pg8::gemm_phase<EpiDownX, MoeOrder, true, false, false, PF_P7 != 0>(lds + RING_OFF, D, S, Ed, (DBG_KLOOP_PH == 7 && bx == 0) ? (unsigned*)(ctl + CW_TS + 16) : nullptr);
            if (split && bx < 2 * ntail) { TailOrder T{MT, full7, bx, (const char*)ACT, (const char*)Wd_t, t_tile};
                pg8::gemm_phase<EpiDownX, TailOrder, false, false, true>(lds + RING_OFF, D, T, Ed); }
            if (BOTH(7)) GRID_BAR(7);
        }
        STAMP(8);
    }

    if (IN(8)) {
        f32x4 gf[4];
        float dbg_scale = 1.0f;
        if (DBG_RVR_PH >= 0) { const unsigned t0 = __hip_atomic_load(ctl + CW_TS + (DBG_RVR_PH >= 0 ? DBG_RVR_PH : 0), RLX_AGENT), t1 = __hip_atomic_load(ctl + CW_TS + (DBG_RVR_PH >= 0 ? DBG_RVR_PH : 0) + 1, RLX_AGENT);
            const float fr_ = fminf((float)(t1 - t0) * (0.01f / 350.0f), 1.0f); dbg_scale = 1.0f + sqrtf(0.0035f * fr_); }
#pragma unroll
        for (int j = 0; j < 4; ++j) gf[j] = *(const f32x4*)(g_final + 4 * lane + 256 * j);
        for (int t = gw; t < M; t += NGW) {
            f32x4 a[4];
#pragma unroll
            for (int j = 0; j < 4; ++j) {
                if (FOLD_G) { const v2u xv = *(const v2u*)(XN + (size_t)t * D + 4 * lane + 256 * j); a[j] = (f32x4){bf_lo(xv.x), bf_hi(xv.x), bf_lo(xv.y), bf_hi(xv.y)}; }
                else { const f32x4 xv = *(const f32x4*)(x + (size_t)t * D + 4 * lane + 256 * j); const v2u dv = *(const v2u*)(DLb + (size_t)t * D + 4 * lane + 256 * j);
                    a[j] = (f32x4){xv.x + bf_lo(dv.x), xv.y + bf_hi(dv.x), xv.z + bf_lo(dv.y), xv.w + bf_hi(dv.y)}; } }
#pragma unroll
            for (int k = 0; k < 4; ++k) { const unsigned rt = route[t * 4 + k]; const float w = routew[t * 4 + k]; const int e = rt & 255u, rel = rt >> 8;
                const bf16* yr = Yb + ((size_t)t_start[e] * 256 + rel) * 1024 + 4 * lane;
#pragma unroll
                for (int j = 0; j < 4; ++j) { const v2u y = *(const v2u*)(yr + 256 * j); a[j].x += w * bf_lo(y.x); a[j].y += w * bf_hi(y.x); a[j].z += w * bf_lo(y.y); a[j].w += w * bf_hi(y.y); } }
            float s = 0.f;
#pragma unroll
            for (int j = 0; j < 4; ++j) s += (a[j].x * a[j].x + a[j].y * a[j].y) + (a[j].z * a[j].z + a[j].w * a[j].w);
            const float rstd = 1.f / sqrtf(wave_sum(s) * (1.f / D) + RMS_EPS);
#pragma unroll
            for (int j = 0; j < 4; ++j) *(f32x4*)(out + (size_t)t * D + 4 * lane + 256 * j) = a[j] * (rstd * dbg_scale) * gf[j];
        }
        STAMP(9);
        if (DBG_TIME_PH >= 0 && bx == 0 && tid == 0) { const unsigned t0 = __hip_atomic_load(ctl + CW_TS + DBG_TIME_PH, RLX_AGENT), t1 = __hip_atomic_load(ctl + CW_TS + DBG_TIME_PH + 1, RLX_AGENT);
            const unsigned span = 4u * (t1 - t0); const unsigned ts = (unsigned)__builtin_amdgcn_s_memrealtime(); while ((unsigned)__builtin_amdgcn_s_memrealtime() - ts < span) __builtin_amdgcn_s_sleep(8); }
    }
#undef IN
#undef BOTH
#undef GRID_BAR
}

extern "C" void kernel_launch(void* const* d_in, const int* in_sizes, int n_in, void* d_out, int out_size, void* d_ws, size_t ws_size, hipStream_t stream) {
    static int grid = 0;
    if (grid == 0) {
        if (n_in != 19 || in_sizes[0] != M * D || out_size != M * D || ws_size < WS_END) { fprintf(stderr, "kernel_launch: unexpected shapes (n_in %d, in0 %d, out %d, ws %zu)\n", n_in, n_in > 0 ? in_sizes[0] : -1, out_size, ws_size); grid = -1; return; }
        int dev = 0, cus = 0, per_cu = 0;
        if (hipGetDevice(&dev) != hipSuccess || hipDeviceGetAttribute(&cus, hipDeviceAttributeMultiprocessorCount, dev) != hipSuccess) { grid = -1; return; }
        if (hipFuncSetAttribute((const void*)fwd_kernel, hipFuncAttributeMaxDynamicSharedMemorySize, LDS_BYTES) != hipSuccess) { fprintf(stderr, "kernel_launch: hipFuncSetAttribute failed\n"); grid = -1; return; }
        if (hipOccupancyMaxActiveBlocksPerMultiprocessor(&per_cu, (const void*)fwd_kernel, NWAVES * 64, LDS_BYTES) != hipSuccess || per_cu < 1)
            fprintf(stderr, "kernel_launch: note: occupancy query reports %d workgroups per CU\n", per_cu);
        (void)hipGetLastError();
        grid = cus;
    }
    if (grid < 0) return;
    if (hipMemsetAsync((char*)d_ws + WS_CTL, 0, CTL_ZERO_BYTES, stream) != hipSuccess) { fprintf(stderr, "kernel_launch: hipMemsetAsync failed\n"); return; }
    Args a{};
    for (int i = 0; i < 19; ++i) a.in[i] = (const float*)d_in[i];
    a.out = (float*)d_out; a.ws = (unsigned char*)d_ws;
    for (int li = 0; li < N_LAUNCHES; ++li) {
        a.ph_lo = (N_LAUNCHES == PER_PHASE) ? li : 0; a.ph_hi = (N_LAUNCHES == PER_PHASE) ? li + 1 : PER_PHASE; a.li = li;
        hipLaunchKernelGGL(fwd_kernel, dim3(grid), dim3(NWAVES * 64), LDS_BYTES, stream, a);
        const hipError_t le = hipPeekAtLastError();
        if (le != hipSuccess) { fprintf(stderr, "kernel_launch: launch %d failed: %s\n", li, hipGetErrorName(le)); break; }
    }
}
```

```cpp
#include <hip/hip_runtime.h>
#include <cstdio>
#include <cstdint>

#ifndef MK_N_LAUNCHES
#define MK_N_LAUNCHES 1
#endif

#ifndef MOE_MERGED
#define MOE_MERGED 0
#endif
#ifndef RELAX_POST_EPI
#define RELAX_POST_EPI 0
#endif
#ifndef STAGGER_US
#define STAGGER_US 0
#endif
#ifndef P7_REVERSE
#define P7_REVERSE 0
#endif
#ifndef KEEP_WD
#define KEEP_WD 0
#endif
#ifndef P5_MFMA
#define P5_MFMA 1
#endif
#ifndef PF_P6
#define PF_P6 0
#endif
#ifndef PF_P7
#define PF_P7 0
#endif
#ifndef KV_PREFETCH
#define KV_PREFETCH 0
#endif
#ifndef FOLD_G
#define FOLD_G (P5_MFMA)
#endif
#ifndef FOLD_GMIX
#define FOLD_GMIX (P5_MFMA)
#endif
#ifndef CONV_INLINE
#define CONV_INLINE 1
#endif
#ifndef HALF_TAIL
#define HALF_TAIL 1
#endif
#ifndef DBG_TIME_PH
#define DBG_TIME_PH (-1)
#endif
#ifndef DBG_KLOOP_PH
#define DBG_KLOOP_PH (-1)
#endif
#ifndef DBG_RVR_PH
#define DBG_RVR_PH (-1)
#endif
namespace pg8 {
#define PG8_LAS __attribute__((address_space(3)))
typedef unsigned short bf16_t;
typedef short bf16x8 __attribute__((ext_vector_type(8)));
typedef float f32x4 __attribute__((ext_vector_type(4)));
typedef unsigned u32x4 __attribute__((ext_vector_type(4)));
typedef unsigned u32x2 __attribute__((ext_vector_type(2)));
constexpr int BM = 256, BK = 64, HALF = 128, HTB = HALF * BK * 2  , STAGE_BYTES = 8 * HTB, NXCD = 8;
constexpr int PFD = 6;
constexpr int PF_LDS_OFF = 150016 + 4096;
constexpr int BIAS_LDS_OFF = 150016;

__host__ __device__ __forceinline__ int lds_byte(int r, int c) { const int st = (r >> 4) * 2 + (c >> 5), rr = r & 15, cc = c & 31, ob = rr * 64 + cc * 2; return st * 1024 + (ob ^ (((ob >> 9) & 1) << 5)); }
__host__ __device__ __forceinline__ void stage_rc(int b, int& R, int& C) { const int st = b / 1024, sb = b % 1024, swz = sb ^ (((sb >> 9) & 1) << 5); R = (st >> 1) * 16 + swz / 64; C = (st & 1) * 32 + (swz % 64) / 2; }
__host__ __device__ __forceinline__ int perm32(int rho) { const int n = rho >> 4, i = rho & 15; return 8 * (i >> 2) + 4 * n + (i & 3); }

struct Unit { int pm, pn, e, aux; bool keep; const char* a; const char* b; int rofs; };

#ifndef WGM_DENSE
#define WGM_DENSE 4
#endif
#ifndef WGM_MOE
#define WGM_MOE 4
#endif
#ifndef WGM_MOE2
#define WGM_MOE2 4
#endif
__host__ __device__ __forceinline__ bool tile_of(long L, int nM, int nN, int& pm, int& pn, const int WGM = WGM_DENSE) {
    const int nwg = nM * nN; if (L >= nwg) return false;
    int wgid = (int)L; { const int q = nwg / NXCD, r = nwg % NXCD, xcd = wgid % NXCD, off = wgid / NXCD; wgid = (xcd < r ? xcd * (q + 1) : r * (q + 1) + (xcd - r) * q) + off; }
    const int nig = WGM * nN, gid = wgid / nig, fm = gid * WGM, gsz = (nM - fm) < WGM ? (nM - fm) : WGM;
    pm = fm + ((wgid % nig) % gsz); pn = (wgid % nig) / gsz; return true;
}

__device__ __forceinline__ unsigned cvt_pk_bf16(float lo, float hi) { unsigned r; asm volatile("v_cvt_pk_bf16_f32 %0, %1, %2" : "=v"(r) : "v"(lo), "v"(hi)); return r; }
__device__ __forceinline__ float bf_lo(unsigned w) { return __uint_as_float(w << 16); }
__device__ __forceinline__ float bf_hi(unsigned w) { return __uint_as_float(w & 0xffff0000u); }
__device__ __forceinline__ float sigmoidf_(float x) { return __builtin_amdgcn_rcpf(1.0f + __builtin_amdgcn_exp2f(x * -1.4426950408889634f)); }

template <class Epi, class Sched, bool ALIGN_EPI, bool GATHER, bool HALFM = false, bool PF = false>
__device__ __forceinline__ void gemm_phase(PG8_LAS unsigned char* lds, const int K, const Sched& S, const Epi& E, unsigned* dbg = nullptr) {
    const int tid = threadIdx.x, wid = __builtin_amdgcn_readfirstlane(tid >> 6), lane = tid & 63, wr = wid >> 2, wc = wid & 3, fr = lane & 15, fq = lane >> 4;
    const int nt = K / BK;
    unsigned voffA[2], voffB[2]; int RA[2]; unsigned CA2[2];
#pragma unroll
    for (int i = 0; i < 2; ++i) { int R, C; stage_rc(tid * 16 + i * 8192, R, C); const int Rb = Epi::PERM ? ((R & ~31) + perm32(R & 31)) : R;
        voffA[i] = (unsigned)(R * K + C) * 2u; voffB[i] = (unsigned)(Rb * K + C) * 2u; RA[i] = R; CA2[i] = (unsigned)C * 2u; }
    const size_t kstep = (size_t)(BK * 2);
    const size_t hstep = (size_t)HALF * K * 2;
    const unsigned ldsw = (unsigned)wid * 1024u;
    const int aoff = lds_byte(wr * 64 + fr, fq * 8), boff = lds_byte(wc * 32 + fr, fq * 8);
#define PG8_SA(b, h) (((b) * 2 + (h)) * HTB)
#define PG8_SB(b, h) ((4 + (b) * 2 + (h)) * HTB)
#define PG8_GLDS(src, dstoff) __builtin_amdgcn_global_load_lds((const unsigned*)(src), (PG8_LAS unsigned*)(lds + (dstoff)), 16, 0, 0)
#define PG8_STAGE_B(bufoff, gbase) do { PG8_GLDS((const char*)(gbase) + voffB[0], (bufoff) + ldsw); PG8_GLDS((const char*)(gbase) + voffB[1], (bufoff) + ldsw + 8192); } while (0)
#define PG8_STAGE_A(bufoff, gbase, h, o0, o1) do { \
        if constexpr (GATHER) { PG8_GLDS((const char*)(gbase) + (o0), (bufoff) + ldsw); PG8_GLDS((const char*)(gbase) + (o1), (bufoff) + ldsw + 8192); } \
        else { PG8_GLDS((const char*)(gbase) + (h) * hstep + voffA[0], (bufoff) + ldsw); PG8_GLDS((const char*)(gbase) + (h) * hstep + voffA[1], (bufoff) + ldsw + 8192); } } while (0)
#define PG8_LDA(dst, b, h) do { _Pragma("unroll") for (int m = 0; m < 4; ++m) _Pragma("unroll") for (int k = 0; k < 2; ++k) dst[m][k] = *(const PG8_LAS bf16x8*)(lds + PG8_SA(b, h) + aoff + m * 2048 + k * 1024); } while (0)
#define PG8_LDB(dst, b, h) do { _Pragma("unroll") for (int n = 0; n < 2; ++n) _Pragma("unroll") for (int k = 0; k < 2; ++k) dst[n][k] = *(const PG8_LAS bf16x8*)(lds + PG8_SB(b, h) + boff + n * 2048 + k * 1024); } while (0)
#define PG8_MMA(ai, bj, At, Bt) do { __builtin_amdgcn_s_setprio(1); _Pragma("unroll") for (int m = 0; m < 4; ++m) _Pragma("unroll") for (int n = 0; n < 2; ++n) _Pragma("unroll") for (int k = 0; k < 2; ++k) \
        acc[ai][bj][m][n] = __builtin_amdgcn_mfma_f32_16x16x32_bf16(Bt[n][k], At[m][k], acc[ai][bj][m][n], 0, 0, 0); __builtin_amdgcn_s_setprio(0); } while (0)
#define PG8_WAIT_V(n) asm volatile("s_waitcnt vmcnt(" #n ")" ::: "memory")
#define PG8_WAIT_VK do { if constexpr (PF) PG8_WAIT_V(9); else PG8_WAIT_V(8); } while (0)
#define PG8_WAIT_L(n) asm volatile("s_waitcnt lgkmcnt(" #n ")" ::: "memory")
#define PG8_BAR __builtin_amdgcn_s_barrier()
#define PG8_SCHED __builtin_amdgcn_sched_barrier(0)
#define PG8_BIAS_STAGE(u_, par_) do { const float* bp_ = wid < 4 ? E.bias_row(u_) : E.aux_row(u_); if (bp_ != nullptr) \
        __builtin_amdgcn_global_load_lds((const unsigned*)(bp_ + (wid & 3) * 64 + lane), (PG8_LAS unsigned*)(lds + BIAS_LDS_OFF + (par_) * 2048 + wid * 256), 4, 0, 0); } while (0)
    Unit cur, nxt, prv; int ui = 0; unsigned dbg_acc = 0;
    if (!S.next(0, cur)) return;
    prv = cur;
    f32x4 acc[2][2][4][2];
#pragma unroll
    for (int a = 0; a < 2; ++a)
#pragma unroll
        for (int b = 0; b < 2; ++b)
#pragma unroll
            for (int m = 0; m < 4; ++m)
#pragma unroll
                for (int n = 0; n < 2; ++n) acc[a][b][m][n] = (f32x4){0.f, 0.f, 0.f, 0.f};
    bf16x8 At[4][2], B0[2][2], B1[2][2];
    unsigned gA00 = 0, gA01 = 0, gA10 = 0, gA11 = 0, gN00 = 0, gN01 = 0, gN10 = 0, gN11 = 0;
    if constexpr (GATHER) { gA00 = S.tokoff(0, RA[0]) + CA2[0]; gA01 = S.tokoff(0, RA[1]) + CA2[1]; gA10 = S.tokoff(0, HALF + RA[0]) + CA2[0]; gA11 = S.tokoff(0, HALF + RA[1]) + CA2[1]; }
    const char* cA = cur.a; const char* cB = cur.b;
    const int pfrow = wid * 32 + (lane & 31);
#define PG8_PFPTR(u_, ui_) ((lane < 32) ? (u_).b + (size_t)pfrow * K * 2 : (GATHER ? (u_).a + S.tokoff((ui_), pfrow) : (u_).a + (size_t)pfrow * K * 2))
#define PG8_PF(kt_) do { if constexpr (PF) { const int k_ = (kt_); const char* p_ = k_ < nt ? pfc + (size_t)k_ * kstep : pfn + (size_t)(k_ - nt) * kstep; \
        __builtin_amdgcn_global_load_lds((const unsigned*)p_, (PG8_LAS unsigned*)(lds + PF_LDS_OFF + wid * 256), 4, 0, 0); } } while (0)
    const char* pfc = nullptr; const char* pfn = nullptr;
    if constexpr (PF) { pfc = PG8_PFPTR(cur, 0); pfn = pfc; }
    S.a_ready(cur);
    PG8_BIAS_STAGE(cur, 0);
    PG8_STAGE_B(PG8_SB(0, 0), cB); PG8_STAGE_B(PG8_SB(0, 1), cB + hstep); PG8_STAGE_A(PG8_SA(0, 0), cA, 0, gA00, gA01); PG8_STAGE_A(PG8_SA(0, 1), cA, 1, gA10, gA11);
    if (wr == 1) PG8_BAR;
    PG8_WAIT_V(2); PG8_BAR;
    PG8_STAGE_B(PG8_SB(1, 0), cB + kstep); PG8_STAGE_A(PG8_SA(1, 0), cA + kstep, 0, gA00, gA01); PG8_STAGE_B(PG8_SB(1, 1), cB + hstep + kstep);
    PG8_WAIT_V(6); PG8_BAR;
    PG8_PF(PFD);
    for (;;) {
        const bool has_next = S.next(ui + 1, nxt);
        if constexpr (GATHER) { if (has_next) { gN00 = S.tokoff(ui + 1, RA[0]) + CA2[0]; gN01 = S.tokoff(ui + 1, RA[1]) + CA2[1]; gN10 = S.tokoff(ui + 1, HALF + RA[0]) + CA2[0]; gN11 = S.tokoff(ui + 1, HALF + RA[1]) + CA2[1]; } }
        const char* nA = has_next ? nxt.a : cA; const char* nB = has_next ? nxt.b : cB;
        if constexpr (PF) { pfn = has_next ? PG8_PFPTR(nxt, ui + 1) : pfc; }
        unsigned dbg_t0 = 0; if (DBG_KLOOP_PH >= 0 && dbg) dbg_t0 = (unsigned)__builtin_amdgcn_s_memrealtime();
        for (int t = 0; t < nt; t += 2) {
            const bool last = (t == nt - 2);
            const char* a1 = cA + (size_t)(t + 1) * kstep;
            const char* a2 = last ? nA : cA + (size_t)(t + 2) * kstep; const char* b2 = last ? nB : cB + (size_t)(t + 2) * kstep;
            const char* a3 = a2 + kstep; const char* b3 = b2 + kstep;
            unsigned s00 = gA00, s01 = gA01, s10 = gA10, s11 = gA11;
            if constexpr (GATHER) { if (last && has_next) { s00 = gN00; s01 = gN01; s10 = gN10; s11 = gN11; } }
            if (last && has_next) S.a_ready(nxt);
            PG8_LDB(B0, 0, 0); PG8_LDB(B1, 0, 1); PG8_SCHED; PG8_LDA(At, 0, 0); PG8_STAGE_A(PG8_SA(1, 1), a1, 1, gA10, gA11);
            PG8_WAIT_VK; PG8_WAIT_L(0); PG8_BAR; PG8_MMA(0, 0, At, B0); PG8_MMA(0, 1, At, B1); PG8_BAR; PG8_SCHED;
            if constexpr (!HALFM) PG8_LDA(At, 0, 1);
            PG8_STAGE_B(PG8_SB(0, 0), b2); PG8_STAGE_B(PG8_SB(0, 1), b2 + hstep); PG8_STAGE_A(PG8_SA(0, 0), a2, 0, s00, s01); PG8_PF(t + 1 + PFD);
            PG8_WAIT_VK; PG8_WAIT_L(0); PG8_BAR; if constexpr (!HALFM) { PG8_MMA(1, 0, At, B0); PG8_MMA(1, 1, At, B1); } PG8_BAR; PG8_SCHED;
            PG8_LDB(B0, 1, 0); PG8_LDB(B1, 1, 1); PG8_SCHED; PG8_LDA(At, 1, 0); PG8_STAGE_A(PG8_SA(0, 1), a2, 1, s10, s11);
            PG8_WAIT_VK; PG8_WAIT_L(0); PG8_BAR; PG8_MMA(0, 0, At, B0); PG8_MMA(0, 1, At, B1); PG8_BAR; PG8_SCHED;
            if constexpr (!HALFM) PG8_LDA(At, 1, 1);
            PG8_STAGE_B(PG8_SB(1, 0), b3); PG8_STAGE_B(PG8_SB(1, 1), b3 + hstep); PG8_STAGE_A(PG8_SA(1, 0), a3, 0, s00, s01); PG8_PF(t + 2 + PFD);
            PG8_WAIT_VK; PG8_WAIT_L(0); PG8_BAR; if constexpr (!HALFM) { PG8_MMA(1, 0, At, B0); PG8_MMA(1, 1, At, B1); } PG8_BAR; PG8_SCHED;
        }
        if (DBG_KLOOP_PH >= 0 && dbg) { dbg_acc += (unsigned)__builtin_amdgcn_s_memrealtime() - dbg_t0; }
        if constexpr (ALIGN_EPI) { if (wr == 0) PG8_BAR; }
        if (MOE_MERGED && ui > 0) S.done(prv);
        E(acc, cur, wr, wc, fr, fq, (const PG8_LAS float*)(lds + BIAS_LDS_OFF + (ui & 1) * 2048));
        if (has_next) PG8_BIAS_STAGE(nxt, (ui + 1) & 1);
        if (MOE_MERGED) prv = cur;
        if (!has_next) break;
        if (!cur.keep) {
#pragma unroll
            for (int a = 0; a < 2; ++a)
#pragma unroll
                for (int b = 0; b < 2; ++b)
#pragma unroll
                    for (int m = 0; m < 4; ++m)
#pragma unroll
                        for (int n = 0; n < 2; ++n) acc[a][b][m][n] = (f32x4){0.f, 0.f, 0.f, 0.f};
        }
        cur = nxt; cA = nA; cB = nB; ++ui; if constexpr (PF) pfc = pfn;
        if constexpr (GATHER) { gA00 = gN00; gA01 = gN01; gA10 = gN10; gA11 = gN11; }
        if constexpr (ALIGN_EPI) { if (wr == 1) PG8_BAR; }
    }
    PG8_WAIT_V(0);
    if (DBG_KLOOP_PH >= 0 && dbg && threadIdx.x == 0) { dbg[0] = 0u; dbg[1] = dbg_acc; }
    if (MOE_MERGED) S.done(prv);
    if constexpr (!ALIGN_EPI) { if (wr == 0) PG8_BAR; }
    PG8_BAR;
#undef PG8_BIAS_STAGE
#undef PG8_PFPTR
#undef PG8_PF
#undef PG8_WAIT_VK
#undef PG8_SA
#undef PG8_SB
#undef PG8_GLDS
#undef PG8_STAGE_A
#undef PG8_STAGE_B
#undef PG8_LDA
#undef PG8_LDB
#undef PG8_MMA
#undef PG8_WAIT_V
#undef PG8_WAIT_L
#undef PG8_BAR
#undef PG8_SCHED
}
}

constexpr int NWAVES = 8;
constexpr int N_LAUNCHES = MK_N_LAUNCHES;
constexpr int PER_PHASE = 9;
constexpr int BATCH = 2, SEQ = 8192, D = 1024, M = BATCH * SEQ, HD = 64, NQH = 16, NKVH = 4, KVW = 256;
constexpr int NIN = 6656, NEXP = 32, TOPK = 4, DFF = 1024;
constexpr float RMS_EPS = 1e-5f;
constexpr float QSCALE = 0.125f * 1.4426950408889634f;
constexpr float LOG2E = 1.4426950408889634f;
constexpr int MAXTILES = 288;
constexpr int SLOTCAP = 16384;
constexpr int HELPER_CUS = 0;
constexpr int MAXU = 16;

constexpr size_t MiB = 1u << 20;
constexpr size_t WS_CTL = 0, CTL_ZERO_BYTES = MOE_MERGED ? 1 * MiB : 64 * 1024;
constexpr size_t WS_BINP = 1 * MiB;
constexpr size_t WS_BGU = 1 * MiB + 64 * 1024;
constexpr size_t WS_RSTD0 = 1 * MiB + 512 * 1024;
constexpr size_t WS_COS = 2 * MiB, WS_SIN = 3 * MiB;
constexpr size_t WS_WIN = 4 * MiB;
constexpr size_t WS_WAO = 17 * MiB, WS_WCO = 19 * MiB, WS_WOUT = 21 * MiB;
constexpr size_t WS_XN = 24 * MiB;
constexpr size_t WS_Q = 56 * MiB, WS_K = 88 * MiB, WS_V = 96 * MiB, WS_CB = 104 * MiB, WS_MG = 136 * MiB, WS_U = 168 * MiB, WS_SA = 200 * MiB, WS_SC = 232 * MiB;
constexpr size_t WS_WGU = 264 * MiB;
constexpr size_t WS_WD = 392 * MiB;
constexpr size_t WS_TOKREL = 456 * MiB;
constexpr size_t WS_ROUTE = 458 * MiB;
constexpr size_t WS_ROUTEW = 459 * MiB;
constexpr size_t WS_ACT = 56 * MiB;
constexpr size_t WS_Y = 200 * MiB;
constexpr size_t WS_RSTDREL = 460 * MiB;
constexpr size_t WS_DL = 464 * MiB;
constexpr size_t WS_END = 496 * MiB;
static_assert(WS_ACT + (size_t)MAXTILES * 256 * 2048 <= WS_Y && WS_Y + (size_t)MAXTILES * 256 * 2048 <= WS_WD, "MoE overlays");
constexpr int CW_TMO = 0;
constexpr int CW_TS = 512;
constexpr int CW_CURSOR = 1024;
constexpr int CW_BAR = 4096;
constexpr int CW_MT = 16384;
#define XCD_BAR_WORDS_C 3456
static_assert(CW_BAR + 3 * XCD_BAR_WORDS_C <= CW_MT && (CW_BAR + 3 * XCD_BAR_WORDS_C) * 4 <= 64 * 1024 && (!MOE_MERGED || (CW_MT + 64 * MAXTILES) * 4 <= (int)CTL_ZERO_BYTES), "CTL");

constexpr int RING_OFF = 0, RING_BYTES = 131072;
constexpr int LDSCTL_OFF = RING_BYTES, MISC_OFF = LDSCTL_OFF + 320;
constexpr int TAB_OFF = RING_BYTES + 512;
constexpr int TAB_CNT = TAB_OFF, TAB_TSTART = TAB_OFF + 128, TAB_TILEE = TAB_OFF + 128 + 160;
constexpr int TOK_OFF = TAB_OFF + 2048;
constexpr int BIAS_OFF = TOK_OFF + MAXU * 1024;
constexpr int LDS_BYTES = BIAS_OFF + 4096 + 2048;
static_assert(TAB_TILEE + 320 * 4 <= TOK_OFF && LDS_BYTES <= 163840 && BIAS_OFF == pg8::BIAS_LDS_OFF + RING_OFF, "LDS map");

#define GAS __attribute__((address_space(1)))
#define LAS __attribute__((address_space(3)))
typedef unsigned short bf16;
typedef unsigned v4u __attribute__((ext_vector_type(4)));
typedef unsigned v2u __attribute__((ext_vector_type(2)));
typedef float f32x4 __attribute__((ext_vector_type(4)));
typedef float f32x16 __attribute__((ext_vector_type(16)));
typedef float f32x2 __attribute__((ext_vector_type(2)));
typedef short bf16x8 __attribute__((ext_vector_type(8)));
typedef short s16x4 __attribute__((ext_vector_type(4)));
typedef GAS unsigned gu32;
#define RLX_AGENT __ATOMIC_RELAXED, __HIP_MEMORY_SCOPE_AGENT
#define LDS_WAIT() asm volatile("s_waitcnt lgkmcnt(0)" ::: "memory")
#define VM_WAIT() asm volatile("s_waitcnt vmcnt(0)" ::: "memory")
using pg8::cvt_pk_bf16; using pg8::bf_lo; using pg8::bf_hi;

#define XB_TMO      128
#define XB_XCNT(j)  (256  + 64 * (j))
#define XB_XSUB(j)  (1280 + 64 * (j))
#define XB_XGEN(j)  (2304 + 64 * (j))
#define XB_TOP      3328
#define XB_TOPGEN   3392
#define XCD_BAR_WORDS 3456
#define XB_SPIN_CAP (1u << 18)
static_assert(XCD_BAR_WORDS == XCD_BAR_WORDS_C, "bar words");

__device__ __forceinline__ unsigned xb_ld(unsigned* p)              { return __hip_atomic_load(p, __ATOMIC_RELAXED, __HIP_MEMORY_SCOPE_AGENT); }
__device__ __forceinline__ unsigned xb_add(unsigned* p, unsigned v) { return __hip_atomic_fetch_add(p, v, __ATOMIC_RELAXED, __HIP_MEMORY_SCOPE_AGENT); }
__device__ __forceinline__ unsigned xb_xcc_id() { return (unsigned)__builtin_amdgcn_s_getreg((3 << 11) | 20) & 0xFu; }
#define XB_SPIN(cond, bar) do { unsigned _sp = 0; while (cond) { __builtin_amdgcn_s_sleep(1); \
    if ((++_sp & 255u) == 0u) { if (xb_ld(&(bar)[XB_TMO])) break; if (_sp > XB_SPIN_CAP) { atomicAdd(&(bar)[XB_TMO], 1u); break; } } } } while (0)

struct XcdBarrier { unsigned* bar; unsigned x; volatile LAS unsigned* st; };

__device__ __forceinline__ XcdBarrier xcd_barrier_post(unsigned* bar, volatile LAS unsigned* st) {
    XcdBarrier b; b.bar = bar; b.x = xb_xcc_id(); b.st = st;
    if (threadIdx.x == 0) (void)xb_add(&bar[XB_XCNT(b.x)], 1u);
    return b;
}
__device__ __forceinline__ void xcd_barrier_complete(unsigned* bar, unsigned x, unsigned& nloc, unsigned& nx) {
    const unsigned G = gridDim.x * gridDim.y * gridDim.z;
    unsigned sum, cnt, mine, sp = 0u;
    for (;;) {
        sum = 0u; cnt = 0u; mine = 0u;
#pragma unroll
        for (unsigned j = 0; j < 16; ++j) { const unsigned c = xb_ld(&bar[XB_XCNT(j)]); sum += c; cnt += (c > 0u) ? 1u : 0u; mine = (j == x) ? c : mine; }
        if (sum == G) break;
        __builtin_amdgcn_s_sleep(1);
        if ((++sp & 255u) == 0u) { if (xb_ld(&bar[XB_TMO])) break; if (sp > XB_SPIN_CAP) { atomicAdd(&bar[XB_TMO], 1u); break; } }
    }
    nloc = mine > 0u ? mine : 1u; nx = cnt > 0u ? cnt : 1u;
}
__device__ __forceinline__ void xcd_barrier(const XcdBarrier& b) {
    asm volatile("s_waitcnt vmcnt(0)" ::: "memory");
    __syncthreads();
    if (threadIdx.x == 0) {
        unsigned* bar = b.bar;
        __builtin_amdgcn_s_waitcnt(0);
        unsigned nloc = b.st[0], nx = b.st[1];
        if (nloc == 0u) { xcd_barrier_complete(bar, b.x, nloc, nx); b.st[0] = nloc; b.st[1] = nx; }
        const unsigned old = xb_add(&bar[XB_XSUB(b.x)], 1u);
        const unsigned gen = old / nloc;
        if (old + 1u == (gen + 1u) * nloc) {
            __builtin_amdgcn_fence(__ATOMIC_RELEASE, "agent");
            asm volatile("s_waitcnt vmcnt(0)" ::: "memory");
            const unsigned og = xb_add(&bar[XB_TOP], 1u);
            const unsigned tg = og / nx;
            if (og + 1u == (tg + 1u) * nx) xb_add(&bar[XB_TOPGEN], 1u);
            else XB_SPIN(xb_ld(&bar[XB_TOPGEN]) == tg, bar);
            __builtin_amdgcn_fence(__ATOMIC_ACQUIRE, "agent");
            xb_add(&bar[XB_XGEN(b.x)], 1u);
            asm volatile("s_waitcnt vmcnt(0)" ::: "memory");
        } else {
            XB_SPIN(xb_ld(&bar[XB_XGEN(b.x)]) == gen, bar);
            __builtin_amdgcn_fence(__ATOMIC_ACQUIRE, "agent");
            asm volatile("s_waitcnt vmcnt(0)" ::: "memory");
        }
    }
    __syncthreads();
}

__device__ __forceinline__ float wave_sum(float v) {
#pragma unroll
    for (int o = 1; o < 64; o <<= 1) v += __shfl_xor(v, o);
    return v;
}
__device__ __forceinline__ float wave_max(float v) {
#pragma unroll
    for (int o = 1; o < 64; o <<= 1) v = fmaxf(v, __shfl_xor(v, o));
    return v;
}
__device__ __forceinline__ int wave_min_i(int v) {
#pragma unroll
    for (int o = 1; o < 64; o <<= 1) { const int w = __shfl_xor(v, o); v = w < v ? w : v; }
    return v;
}

template <int CTRL> __device__ __forceinline__ float dpp_f(float v) { return __builtin_bit_cast(float, __builtin_amdgcn_update_dpp(0, __builtin_bit_cast(int, v), CTRL, 0xF, 0xF, false)); }
__device__ __forceinline__ float rl_f(float v, int l) { return __builtin_bit_cast(float, __builtin_amdgcn_readlane(__builtin_bit_cast(int, v), l)); }
__device__ __forceinline__ float wave_sum_dpp(float v) { v += dpp_f<0xB1>(v); v += dpp_f<0x4E>(v); v += dpp_f<0x141>(v); v += dpp_f<0x140>(v); return (rl_f(v, 0) + rl_f(v, 16)) + (rl_f(v, 32) + rl_f(v, 48)); }
__device__ __forceinline__ float half_max_dpp(float v) { v = fmaxf(v, dpp_f<0xB1>(v)); v = fmaxf(v, dpp_f<0x4E>(v)); v = fmaxf(v, dpp_f<0x141>(v)); v = fmaxf(v, dpp_f<0x140>(v)); return fmaxf(rl_f(v, 0), rl_f(v, 16)); }

__device__ __forceinline__ int win_dest(int c) {
    if (c < 1280) { const int h = c >> 6, d = c & 63, s = d >> 5, i = d & 31; return (h << 6) + 8 * (i >> 2) + 4 * s + (i & 3); }
    if (c < 2560) return c;
    if (c < 3584) { const int i = c - 2560; return 2560 + (i >> 2) * 8 + (i & 3); }
    if (c < 4608) { const int i = c - 3584; return 2560 + (i >> 2) * 8 + 4 + (i & 3); }
    if (c < 5632) { const int i = c - 4608; return 4608 + (i >> 2) * 8 + (i & 3); }
    { const int i = c - 5632; return 4608 + (i >> 2) * 8 + 4 + (i & 3); }
}
__device__ __forceinline__ int map_dest(int mode, int n) {
    if (mode == 0) return n;
    if (mode == 1) return win_dest(n);
    if (mode == 2) return (n >> 2) * 8 + (n & 3);
    return (n >> 2) * 8 + 4 + (n & 3);
}

constexpr int NWAVES_C = 8;
struct CvtItem { const GAS float* W; GAS bf16* WT; int K, N, mode, k0, n0, keep; };
__device__ __forceinline__ void cvt_load(f32x4 (&v)[16], const CvtItem& it, int lane) {
    const GAS float* p = it.W + (size_t)(it.k0 + 4 * (lane >> 4)) * it.N + it.n0 + 4 * (lane & 15);
#pragma unroll
    for (int j = 0; j < 4; ++j)
#pragma unroll
        for (int r = 0; r < 4; ++r) v[j * 4 + r] = __builtin_nontemporal_load((const GAS f32x4*)(p + (size_t)(16 * j + r) * it.N));
}
__device__ __forceinline__ void cvt_store(const f32x4 (&v)[16], const CvtItem& it, LAS unsigned char* scr, int lane, const LAS float* gl) {
    const int kq = lane >> 4, nl = 4 * (lane & 15);
    const bool gs = (FOLD_G && it.mode >= 2) || (FOLD_GMIX && it.mode == 1);
    const int goff = it.mode == 1 ? 1024 : 0;
#pragma unroll
    for (int j = 0; j < 4; ++j) { f32x4 gk = *(const LAS f32x4*)(gl + goff + it.k0 + 16 * j + 4 * kq);
        if (!gs) gk = (f32x4){1.f, 1.f, 1.f, 1.f};
#pragma unroll
        for (int i = 0; i < 4; ++i) { v2u w; w.x = cvt_pk_bf16(v[j * 4 + 0][i] * gk[0], v[j * 4 + 1][i] * gk[1]); w.y = cvt_pk_bf16(v[j * 4 + 2][i] * gk[2], v[j * 4 + 3][i] * gk[3]);
            *(LAS v2u*)(scr + (nl + i) * 136 + (16 * j + 4 * kq) * 2) = w; } }
    LDS_WAIT(); asm volatile("" ::: "memory");
#pragma unroll
    for (int jj = 0; jj < 8; ++jj) { const int n = (lane >> 3) + 8 * jj, c = lane & 7;
        const v2u a = *(const LAS v2u*)(scr + n * 136 + c * 16), b = *(const LAS v2u*)(scr + n * 136 + c * 16 + 8);
        v4u o; o.x = a.x; o.y = a.y; o.z = b.x; o.w = b.y;
        GAS v4u* dp = (GAS v4u*)(it.WT + (size_t)map_dest(it.mode, it.n0 + n) * it.K + it.k0 + 8 * c);
        if (it.keep) *dp = o; else __builtin_nontemporal_store(o, dp); }
    LDS_WAIT(); asm volatile("" ::: "memory");
}
struct CvtSrc { const float* w_in; bf16* Win_t; const LAS unsigned long long* ptab; const LAS float* gl; };
constexpr int CVT_IN_ITEMS = (1024 / 64) * (6656 / 64);
constexpr int CVT_SQ_ITEMS = 256;
constexpr int CVT_REST_ITEMS = (3 + 32 * 3) * CVT_SQ_ITEMS;
#ifndef SLACK_CVT
#define SLACK_CVT 1
#endif
constexpr int SLACK_P1_ITEMS = SLACK_CVT ? 8192 : 0;
constexpr int SLACK_P6_ITEMS = SLACK_CVT ? 8192 : 0;

__device__ __forceinline__ CvtItem cvt_item_in(const CvtSrc& S, int id) { CvtItem it; it.keep = 0; it.W = (const GAS float*)S.w_in; it.WT = (GAS bf16*)S.Win_t; it.K = 1024; it.N = 6656; it.mode = 1; it.k0 = 64 * (id / 104); it.n0 = 64 * (id % 104); return it; }
__device__ __forceinline__ CvtItem cvt_item_rest(const CvtSrc& S, int id) {
    CvtItem it; it.keep = (KEEP_WD && (id >> 8) >= 67) ? 1 : 0; it.K = 1024; it.N = 1024; const int mat = id >> 8, r = id & 255; it.k0 = 64 * (r >> 4); it.n0 = 64 * (r & 15);
    int si = mat, e = 0, which = 2;
    if (mat >= 67) { e = mat - 67; which = 2; si = 5; }
    else if (mat >= 3) { const int q = mat - 3; e = q >> 1; which = q & 1; si = 3 + which; }
    const unsigned long long ps = S.ptab[si], pd = S.ptab[6 + si];
    const unsigned long long psu = ((unsigned long long)__builtin_amdgcn_readfirstlane((unsigned)(ps >> 32)) << 32) | (unsigned)__builtin_amdgcn_readfirstlane((unsigned)ps);
    const unsigned long long pdu = ((unsigned long long)__builtin_amdgcn_readfirstlane((unsigned)(pd >> 32)) << 32) | (unsigned)__builtin_amdgcn_readfirstlane((unsigned)pd);
    it.W = (const GAS float*)psu + (size_t)e * 1048576; it.WT = (GAS bf16*)pdu + (size_t)e * (which < 2 ? 2097152 : 1048576);
    it.mode = mat < 3 ? 0 : (which == 0 ? 2 : which == 1 ? 3 : 0);
    return it;
}
template <int SET> __device__ __forceinline__ void cvt_run(const CvtSrc& S, int first, int stride, int n_items, LAS unsigned char* scr, int lane, int base = 0) {
    f32x4 r0[16], r1[16]; CvtItem i0, i1;
    int id = first; if (id >= n_items) return;
    i0 = SET == 0 ? cvt_item_in(S, id) : cvt_item_rest(S, base + id); cvt_load(r0, i0, lane);
    for (;;) {
        const int idn = id + stride;
        if (idn >= n_items) { cvt_store(r0, i0, scr, lane, S.gl); break; }
        i1 = SET == 0 ? cvt_item_in(S, idn) : cvt_item_rest(S, base + idn); cvt_load(r1, i1, lane); cvt_store(r0, i0, scr, lane, S.gl);
        id = idn + stride;
        if (id >= n_items) { cvt_store(r1, i1, scr, lane, S.gl); break; }
        i0 = SET == 0 ? cvt_item_in(S, id) : cvt_item_rest(S, base + id); cvt_load(r0, i0, lane); cvt_store(r1, i1, scr, lane, S.gl);
    }
}

__device__ __forceinline__ void slack_convert(const CvtSrc& S, int U, int G, int c, int base, int n_items, LAS unsigned char* scr, int wave, int lane) {
    if (n_items <= 0) return;
    int rem = U % G; if (G - rem < G / 4) rem = 0;
    const int ncv = G - rem;
    if (c < rem) return;
    cvt_run<1>(S, (c - rem) * NWAVES_C + wave, ncv * NWAVES_C, n_items, scr, lane, base);
}

__device__ __forceinline__ void rms_row_to_bf16(const float* xrow, const float* g, bf16* orow, int lane) {
    const GAS f32x4* xr = (const GAS f32x4*)xrow + lane; const GAS f32x4* gr = (const GAS f32x4*)g + lane;
    f32x4 v[4]; float s = 0.f;
#pragma unroll
    for (int j = 0; j < 4; ++j) { v[j] = __builtin_nontemporal_load(xr + 64 * j); s += (v[j].x * v[j].x + v[j].y * v[j].y) + (v[j].z * v[j].z + v[j].w * v[j].w); }
    const float rstd = 1.f / sqrtf(wave_sum(s) * (1.f / D) + RMS_EPS);
    GAS v2u* o8 = (GAS v2u*)orow + lane;
#pragma unroll
    for (int j = 0; j < 4; ++j) { const f32x4 gg = gr[64 * j]; v2u w; w.x = cvt_pk_bf16(v[j].x * rstd * gg.x, v[j].y * rstd * gg.y); w.y = cvt_pk_bf16(v[j].z * rstd * gg.z, v[j].w * rstd * gg.w); o8[64 * j] = w; }
}

struct DenseOrder {
    int nM, nN, G, c, K; const char* A; const char* B;
    __device__ __forceinline__ bool next(int i, pg8::Unit& u) const {
        if (!pg8::tile_of((long)i * G + c, nM, nN, u.pm, u.pn)) return false;
        u.e = 0; u.aux = 1; u.keep = false; u.rofs = 0; u.a = A + (size_t)u.pm * 256 * K * 2; u.b = B + (size_t)u.pn * 256 * K * 2; return true; }
    __device__ __forceinline__ unsigned tokoff(int, int) const { return 0u; }
    __device__ __forceinline__ void a_ready(const pg8::Unit&) const {}
    __device__ __forceinline__ void done(const pg8::Unit&) const {}
};
struct MergeOrder {
    int nM, nN, G, c, K; const char* A0; const char* B0; const char* A1; const char* B1;
    __device__ __forceinline__ bool next(int i, pg8::Unit& u) const {
        if (!pg8::tile_of((long)(i >> 1) * G + c, nM, nN, u.pm, u.pn)) return false;
        const int br = i & 1; u.e = 0; u.aux = br; u.keep = (br == 0); u.rofs = 0;
        u.a = (br ? A1 : A0) + (size_t)u.pm * 256 * K * 2; u.b = (br ? B1 : B0) + (size_t)u.pn * 256 * K * 2; return true; }
    __device__ __forceinline__ unsigned tokoff(int, int) const { return 0u; }
    __device__ __forceinline__ void a_ready(const pg8::Unit&) const {}
    __device__ __forceinline__ void done(const pg8::Unit&) const {}
};
struct MoeOrder {
    int MT, G, c; const char* XNb; const char* ACTb; const char* Wgu; const char* Wd; const LAS int* tile_e; const LAS unsigned* tok; unsigned* ready; unsigned* tmo; int part; int ulim;
    __device__ __forceinline__ bool next(int i, pg8::Unit& u) const {
        const long U1 = (long)MT * 8; const long L = (long)i * G + c + (part == 2 ? U1 : 0);
        if (part == 1 && L >= U1) return false;
        if (part == 2 && L - U1 >= ulim) return false;
        if (L < U1) { pg8::tile_of(L, MT, 8, u.pm, u.pn, WGM_MOE); const int e = __builtin_amdgcn_readfirstlane(tile_e[u.pm]);
            u.e = e; u.aux = 2; u.keep = false; u.rofs = 0; u.a = XNb; u.b = Wgu + (size_t)e * (2048 * 1024 * 2) + (size_t)u.pn * (256 * 1024 * 2); return true; }
        if (!pg8::tile_of(L - U1, MT, 4, u.pm, u.pn, WGM_MOE2)) return false;
        if (P7_REVERSE && part == 2) u.pm = MT - 1 - u.pm;
        const int e = __builtin_amdgcn_readfirstlane(tile_e[u.pm]);
        u.e = e; u.aux = 3; u.keep = false; u.rofs = 0; u.a = ACTb + (size_t)u.pm * (256 * 1024 * 2); u.b = Wd + (size_t)e * (1024 * 1024 * 2) + (size_t)u.pn * (256 * 1024 * 2); return true; }
    __device__ __forceinline__ unsigned tokoff(int i, int row) const { return (part != 2 && (long)i * G + c < (long)MT * 8) ? tok[i * 256 + row] : (unsigned)row * 2048u; }
    __device__ __forceinline__ void a_ready(const pg8::Unit& u) const {
        if (u.aux != 3 || part != 0) return;
        if (threadIdx.x < 64) {
            const unsigned long long t0 = __builtin_amdgcn_s_memrealtime(); unsigned polls = 0;
            while ((unsigned)__builtin_amdgcn_readfirstlane(__hip_atomic_load(ready + 64 * u.pm, __ATOMIC_RELAXED, __HIP_MEMORY_SCOPE_AGENT)) < 64u) {
                if ((++polls & 255u) == 0u && __builtin_amdgcn_readfirstlane(__hip_atomic_load(tmo, __ATOMIC_RELAXED, __HIP_MEMORY_SCOPE_AGENT)) != 0u) break;
                if (__builtin_amdgcn_s_memrealtime() - t0 > 2000000ull) { if (threadIdx.x == 0) __hip_atomic_store(tmo, 1u, __ATOMIC_RELAXED, __HIP_MEMORY_SCOPE_AGENT); break; }
                __builtin_amdgcn_s_sleep(2); }
            __builtin_amdgcn_fence(__ATOMIC_ACQUIRE, "agent");
            asm volatile("s_waitcnt vmcnt(0)" ::: "memory");
        }
        asm volatile("" ::: "memory"); __builtin_amdgcn_s_barrier(); asm volatile("" ::: "memory");
    }
    __device__ __forceinline__ void done(const pg8::Unit& u) const {
        if (u.aux != 2 || part != 0) return;
        asm volatile("s_waitcnt vmcnt(0)" ::: "memory");
        if ((threadIdx.x & 63) == 0) __hip_atomic_fetch_add(ready + 64 * u.pm, 1u, __ATOMIC_RELAXED, __HIP_MEMORY_SCOPE_AGENT);
    }
};

struct TailOrder {
    int MT, ubase, c; const char* ACTb; const char* Wd; const LAS int* tile_e;
    __device__ __forceinline__ bool next(int i, pg8::Unit& u) const {
        if (i != 0 || !pg8::tile_of((long)ubase + (c >> 1), MT, 4, u.pm, u.pn, WGM_MOE2)) return false;
        const int e = __builtin_amdgcn_readfirstlane(tile_e[u.pm]);
        u.e = e; u.aux = 4; u.keep = false; u.rofs = 128 * (c & 1); u.a = ACTb + ((size_t)u.pm * 256 + 128 * (c & 1)) * (1024 * 2);     u.b = Wd + (size_t)e * (1024 * 1024 * 2) + (size_t)u.pn * (256 * 1024 * 2); return true; }
    __device__ __forceinline__ unsigned tokoff(int, int row) const { return (unsigned)(128 * (c & 1) + (row & 127)) * 2048u; }
    __device__ __forceinline__ void a_ready(const pg8::Unit&) const {}
    __device__ __forceinline__ void done(const pg8::Unit&) const {}
};

using pg8::f32x4; using pg8::Unit;
struct EpiInProj {
    static constexpr bool PERM = true;
    __device__ static __forceinline__ int nstores(const Unit&) { return 16; }
    bf16 *Q, *Kb, *Vb, *CB, *U, *SA, *SC; const float* bias; const float* cosT; const float* sinT; const float* rstd0;
    __device__ __forceinline__ const float* bias_row(const Unit& u) const { return bias + u.pn * 256; }
    __device__ __forceinline__ const float* aux_row(const Unit& u) const { return FOLD_GMIX ? rstd0 + u.pm * 256 : nullptr; }
    __device__ __forceinline__ void operator()(const f32x4 (&acc)[2][2][4][2], const Unit& u, int wr, int wc, int fr, int fq, const LAS float* bl) const {
        const int pn = u.pn, row0 = u.pm * 256 + wr * 64 + fr, cl0 = wc * 32 + 8 * fq;
        f32x4 bv[2][2];
#pragma unroll
        for (int bj = 0; bj < 2; ++bj)
#pragma unroll
            for (int n = 0; n < 2; ++n) bv[bj][n] = *(const LAS f32x4*)(bl + cl0 + bj * 128 + 4 * n);
        float rsv[2][4];
#pragma unroll
        for (int ai = 0; ai < 2; ++ai)
#pragma unroll
            for (int m = 0; m < 4; ++m) rsv[ai][m] = FOLD_GMIX ? bl[256 + wr * 64 + fr + ai * 128 + m * 16] : 1.0f;
        if (pn < 5) {
            bf16* base = pn < 4 ? Q : Kb; const int ld = pn < 4 ? 1024 : 256, colt = pn < 4 ? pn * 256 : 0; const float sc = pn < 4 ? QSCALE : 1.0f;
            const int i0 = 16 * (wc & 1) + 4 * fq;
#pragma unroll
            for (int ai = 0; ai < 2; ++ai)
#pragma unroll
                for (int m = 0; m < 4; ++m) { const int row = row0 + ai * 128 + m * 16, pos = row & (SEQ - 1);
                    const f32x4 c4 = *(const f32x4*)(cosT + pos * 32 + i0) * sc, s4 = *(const f32x4*)(sinT + pos * 32 + i0) * sc;
#pragma unroll
                    for (int bj = 0; bj < 2; ++bj) { const f32x4 t1 = acc[ai][bj][m][0] * rsv[ai][m] + bv[bj][0], t2 = acc[ai][bj][m][1] * rsv[ai][m] + bv[bj][1];
                        const f32x4 o1 = t1 * c4 - t2 * s4, o2 = t2 * c4 + t1 * s4;
                        v4u w; w.x = cvt_pk_bf16(o1[0], o1[1]); w.y = cvt_pk_bf16(o1[2], o1[3]); w.z = cvt_pk_bf16(o2[0], o2[1]); w.w = cvt_pk_bf16(o2[2], o2[3]);
                        *(v4u*)(base + (size_t)row * ld + colt + cl0 + bj * 128) = w; } }
        } else if (pn >= 10 && pn < 18) {
            const int colt = (pn - 10) * 128 + (cl0 >> 1);
#pragma unroll
            for (int ai = 0; ai < 2; ++ai)
#pragma unroll
                for (int m = 0; m < 4; ++m) { const int row = row0 + ai * 128 + m * 16;
#pragma unroll
                    for (int bj = 0; bj < 2; ++bj) { const f32x4 p = (acc[ai][bj][m][0] * rsv[ai][m] + bv[bj][0]) * (acc[ai][bj][m][1] * rsv[ai][m] + bv[bj][1]);
                        v2u w; w.x = cvt_pk_bf16(p[0], p[1]); w.y = cvt_pk_bf16(p[2], p[3]);
                        *(v2u*)(U + (size_t)row * 1024 + colt + bj * 64) = w; } }
        } else if (pn >= 18) {
            const int colt = (pn - 18) * 128 + (cl0 >> 1);
#pragma unroll
            for (int ai = 0; ai < 2; ++ai)
#pragma unroll
                for (int m = 0; m < 4; ++m) { const int row = row0 + ai * 128 + m * 16;
#pragma unroll
                    for (int bj = 0; bj < 2; ++bj) { const f32x4 a4 = acc[ai][bj][m][0] * rsv[ai][m] + bv[bj][0], c4 = acc[ai][bj][m][1] * rsv[ai][m] + bv[bj][1]; f32x4 r4, s4;
#pragma unroll
                        for (int q = 0; q < 4; ++q) { const float ea = __builtin_amdgcn_exp2f(a4[q] * -1.4426950408889634f), ec = __builtin_amdgcn_exp2f(c4[q] * -1.4426950408889634f);
                            s4[q] = fmaxf(__builtin_amdgcn_rcpf(1.0f + ec), 1e-20f); r4[q] = (1.0f + ec) * __builtin_amdgcn_rcpf(1.0f + ea); r4[q] = fminf(r4[q], 1e20f); }
                        v2u wr_, ws_; wr_.x = cvt_pk_bf16(r4[0], r4[1]); wr_.y = cvt_pk_bf16(r4[2], r4[3]); ws_.x = cvt_pk_bf16(s4[0], s4[1]); ws_.y = cvt_pk_bf16(s4[2], s4[3]);
                        *(v2u*)(SA + (size_t)row * 1024 + colt + bj * 64) = wr_; *(v2u*)(SC + (size_t)row * 1024 + colt + bj * 64) = ws_; } }
        } else {
            bf16* base; int ld = 1024, colt; const bool sg = false;
            if (pn == 5) { base = Vb; ld = 256; colt = 0; }
            else { base = CB; colt = (pn - 6) * 256; }
#pragma unroll
            for (int ai = 0; ai < 2; ++ai)
#pragma unroll
                for (int m = 0; m < 4; ++m) { const int row = row0 + ai * 128 + m * 16;
#pragma unroll
                    for (int bj = 0; bj < 2; ++bj) { f32x4 v0 = acc[ai][bj][m][0] * rsv[ai][m] + bv[bj][0], v1 = acc[ai][bj][m][1] * rsv[ai][m] + bv[bj][1];
                        if (sg) {
#pragma unroll
                            for (int q = 0; q < 4; ++q) { v0[q] = pg8::sigmoidf_(v0[q]); v1[q] = pg8::sigmoidf_(v1[q]); } }
                        v4u w; w.x = cvt_pk_bf16(v0[0], v0[1]); w.y = cvt_pk_bf16(v0[2], v0[3]); w.z = cvt_pk_bf16(v1[0], v1[1]); w.w = cvt_pk_bf16(v1[2], v1[3]);
                        *(v4u*)(base + (size_t)row * ld + colt + cl0 + bj * 128) = w; } }
        }
    }
};
struct EpiMerge {
    static constexpr bool PERM = true;
    __device__ static __forceinline__ int nstores(const Unit& u) { return u.aux == 0 ? 0 : 16; }
    const bf16 *SA, *SC; bf16* MG;
    __device__ __forceinline__ const float* bias_row(const Unit&) const { return nullptr; }
    __device__ __forceinline__ const float* aux_row(const Unit&) const { return nullptr; }
    __device__ __forceinline__ void operator()(f32x4 (&acc)[2][2][4][2], const Unit& u, int wr, int wc, int fr, int fq, const LAS float*) const {
        const int row0 = u.pm * 256 + wr * 64 + fr, col0 = u.pn * 256 + wc * 32 + 8 * fq;
        const bf16* G = u.aux == 0 ? SA : SC;
        v4u gv[2][4][2];
#pragma unroll
        for (int ai = 0; ai < 2; ++ai)
#pragma unroll
            for (int m = 0; m < 4; ++m)
#pragma unroll
                for (int bj = 0; bj < 2; ++bj) gv[ai][m][bj] = *(const v4u*)(G + (size_t)(row0 + ai * 128 + m * 16) * 1024 + col0 + bj * 128);
#pragma unroll
        for (int ai = 0; ai < 2; ++ai)
#pragma unroll
            for (int m = 0; m < 4; ++m)
#pragma unroll
                for (int bj = 0; bj < 2; ++bj) { const v4u c = gv[ai][m][bj];
                    const f32x4 c0 = {bf_lo(c.x), bf_hi(c.x), bf_lo(c.y), bf_hi(c.y)}, c1 = {bf_lo(c.z), bf_hi(c.z), bf_lo(c.w), bf_hi(c.w)};
                    const f32x4 v0 = acc[ai][bj][m][0] * c0, v1 = acc[ai][bj][m][1] * c1;
                    if (u.aux == 0) { acc[ai][bj][m][0] = v0; acc[ai][bj][m][1] = v1; }
                    else { v4u w; w.x = cvt_pk_bf16(v0[0], v0[1]); w.y = cvt_pk_bf16(v0[2], v0[3]); w.z = cvt_pk_bf16(v1[0], v1[1]); w.w = cvt_pk_bf16(v1[2], v1[3]);
                        *(v4u*)(MG + (size_t)(row0 + ai * 128 + m * 16) * 1024 + col0 + bj * 128) = w; } }
    }
};
struct EpiRes {
    static constexpr bool PERM = true;
    __device__ static __forceinline__ int nstores(const Unit&) { return 16; }
    bf16* DL;
    __device__ __forceinline__ const float* bias_row(const Unit&) const { return nullptr; }
    __device__ __forceinline__ const float* aux_row(const Unit&) const { return nullptr; }
    __device__ __forceinline__ void operator()(const f32x4 (&acc)[2][2][4][2], const Unit& u, int wr, int wc, int fr, int fq, const LAS float*) const {
        const int row0 = u.pm * 256 + wr * 64 + fr, col0 = u.pn * 256 + wc * 32 + 8 * fq;
#pragma unroll
        for (int ai = 0; ai < 2; ++ai)
#pragma unroll
            for (int m = 0; m < 4; ++m) { bf16* rp = DL + (size_t)(row0 + ai * 128 + m * 16) * 1024 + col0;
#pragma unroll
                for (int bj = 0; bj < 2; ++bj) { const f32x4 v0 = acc[ai][bj][m][0], v1 = acc[ai][bj][m][1];
                    v4u w; w.x = cvt_pk_bf16(v0[0], v0[1]); w.y = cvt_pk_bf16(v0[2], v0[3]); w.z = cvt_pk_bf16(v1[0], v1[1]); w.w = cvt_pk_bf16(v1[2], v1[3]);
                    *(v4u*)(rp + bj * 128) = w; } }
    }
};
struct EpiGU {
    static constexpr bool PERM = true;
    __device__ static __forceinline__ int nstores(const Unit&) { return 16; }
    bf16* ACT; const float* bgu; const float* rstdrel; const LAS int* tst;
    __device__ __forceinline__ const float* bias_row(const Unit& u) const { return bgu + (size_t)u.e * 2048 + u.pn * 256; }
    __device__ __forceinline__ const float* aux_row(const Unit& u) const { return P5_MFMA ? rstdrel + (size_t)u.e * SLOTCAP + (u.pm - tst[u.e]) * 256 : nullptr; }
    __device__ __forceinline__ void operator()(const f32x4 (&acc)[2][2][4][2], const Unit& u, int wr, int wc, int fr, int fq, const LAS float* bl) const {
        const int row0 = u.pm * 256 + wr * 64 + fr, cl0 = u.pn * 256 + wc * 32 + 8 * fq;
        const LAS float* bb = bl + wc * 32 + 8 * fq;
        f32x4 bv[2][2];
#pragma unroll
        for (int bj = 0; bj < 2; ++bj)
#pragma unroll
            for (int n = 0; n < 2; ++n) bv[bj][n] = *(const LAS f32x4*)(bb + bj * 128 + 4 * n);
#pragma unroll
        for (int ai = 0; ai < 2; ++ai)
#pragma unroll
            for (int m = 0; m < 4; ++m) { bf16* rp = ACT + (size_t)(row0 + ai * 128 + m * 16) * 1024 + (cl0 >> 1);
                const float rs = P5_MFMA ? bl[256 + wr * 64 + fr + ai * 128 + m * 16] : 1.0f;
#pragma unroll
                for (int bj = 0; bj < 2; ++bj) { const f32x4 g4 = acc[ai][bj][m][0] * rs + bv[bj][0], u4 = acc[ai][bj][m][1] * rs + bv[bj][1]; f32x4 o;
#pragma unroll
                    for (int q = 0; q < 4; ++q) { const float g = __builtin_amdgcn_fmed3f(g4[q], -3.0e38f, 7.0f), uu = __builtin_amdgcn_fmed3f(u4[q], -7.0f, 7.0f);
                        o[q] = g * __builtin_amdgcn_rcpf(1.0f + __builtin_amdgcn_exp2f(g * -2.4554669595930157f)) * (uu + 1.0f); }
                    if (MOE_MERGED) { const unsigned long long w = (unsigned long long)cvt_pk_bf16(o[0], o[1]) | ((unsigned long long)cvt_pk_bf16(o[2], o[3]) << 32);
                        __hip_atomic_store((unsigned long long*)(rp + bj * 64), w, __ATOMIC_RELAXED, __HIP_MEMORY_SCOPE_AGENT); }
                    else { v2u w; w.x = cvt_pk_bf16(o[0], o[1]); w.y = cvt_pk_bf16(o[2], o[3]); *(v2u*)(rp + bj * 64) = w; } } }
    }
};
struct EpiDown {
    static constexpr bool PERM = true;
    __device__ static __forceinline__ int nstores(const Unit&) { return 16; }
    bf16* Y; const float* bd;
    __device__ __forceinline__ const float* bias_row(const Unit& u) const { return bd + (size_t)u.e * 1024 + u.pn * 256; }
    __device__ __forceinline__ const float* aux_row(const Unit&) const { return nullptr; }
    __device__ __forceinline__ void operator()(const f32x4 (&acc)[2][2][4][2], const Unit& u, int wr, int wc, int fr, int fq, const LAS float* bl) const {
        const int row0 = u.pm * 256 + wr * 64 + fr, cl0 = u.pn * 256 + wc * 32 + 8 * fq;
        const LAS float* bb = bl + wc * 32 + 8 * fq;
        f32x4 bv[2][2];
#pragma unroll
        for (int bj = 0; bj < 2; ++bj)
#pragma unroll
            for (int n = 0; n < 2; ++n) bv[bj][n] = *(const LAS f32x4*)(bb + bj * 128 + 4 * n);
#pragma unroll
        for (int ai = 0; ai < 2; ++ai)
#pragma unroll
            for (int m = 0; m < 4; ++m) { bf16* rp = Y + (size_t)(row0 + ai * 128 + m * 16) * 1024 + cl0;
#pragma unroll
                for (int bj = 0; bj < 2; ++bj) { const f32x4 v0 = acc[ai][bj][m][0] + bv[bj][0], v1 = acc[ai][bj][m][1] + bv[bj][1];
                    v4u w; w.x = cvt_pk_bf16(v0[0], v0[1]); w.y = cvt_pk_bf16(v0[2], v0[3]); w.z = cvt_pk_bf16(v1[0], v1[1]); w.w = cvt_pk_bf16(v1[2], v1[3]);
                    *(v4u*)(rp + bj * 128) = w; } }
    }
    __device__ __forceinline__ void half(const f32x4 (&acc)[2][2][4][2], const Unit& u, int wr, int wc, int fr, int fq, const LAS float* bl) const {
        const int row0 = u.pm * 256 + u.rofs + wr * 64 + fr, cl0 = u.pn * 256 + wc * 32 + 8 * fq;
        const LAS float* bb = bl + wc * 32 + 8 * fq;
        f32x4 bv[2][2];
#pragma unroll
        for (int bj = 0; bj < 2; ++bj)
#pragma unroll
            for (int n = 0; n < 2; ++n) bv[bj][n] = *(const LAS f32x4*)(bb + bj * 128 + 4 * n);
#pragma unroll
        for (int m = 0; m < 4; ++m) { bf16* rp = Y + (size_t)(row0 + m * 16) * 1024 + cl0;
#pragma unroll
            for (int bj = 0; bj < 2; ++bj) { const f32x4 v0 = acc[0][bj][m][0] + bv[bj][0], v1 = acc[0][bj][m][1] + bv[bj][1];
                v4u w; w.x = cvt_pk_bf16(v0[0], v0[1]); w.y = cvt_pk_bf16(v0[2], v0[3]); w.z = cvt_pk_bf16(v1[0], v1[1]); w.w = cvt_pk_bf16(v1[2], v1[3]);
                *(v4u*)(rp + bj * 128) = w; } }
    }
};
struct EpiDownX {
    static constexpr bool PERM = true;
    __device__ static __forceinline__ int nstores(const Unit&) { return 0; }
    EpiDown dn;
    __device__ __forceinline__ const float* bias_row(const Unit& u) const { return dn.bias_row(u); }
    __device__ __forceinline__ const float* aux_row(const Unit&) const { return nullptr; }
    __device__ __forceinline__ void operator()(const f32x4 (&acc)[2][2][4][2], const Unit& u, int wr, int wc, int fr, int fq, const LAS float* bl) const { if (u.aux == 4) dn.half(acc, u, wr, wc, fr, fq, bl); else dn(acc, u, wr, wc, fr, fq, bl); }
};
struct EpiMoe {
    static constexpr bool PERM = true;
    __device__ static __forceinline__ int nstores(const Unit&) { return MOE_MERGED ? 0 : 16; }
    EpiGU gu; EpiDown dn;
    __device__ __forceinline__ const float* bias_row(const Unit& u) const { return u.aux == 2 ? gu.bias_row(u) : dn.bias_row(u); }
    __device__ __forceinline__ const float* aux_row(const Unit& u) const { return u.aux == 2 ? gu.aux_row(u) : nullptr; }
    __device__ __forceinline__ void operator()(const f32x4 (&acc)[2][2][4][2], const Unit& u, int wr, int wc, int fr, int fq, const LAS float* bl) const { if (u.aux == 2) gu(acc, u, wr, wc, fr, fq, bl); else if (u.aux == 4) dn.half(acc, u, wr, wc, fr, fq, bl); else dn(acc, u, wr, wc, fr, fq, bl); }
};

namespace att {
constexpr int KS_STRIDE = 144, VT_STRIDE = 520;
constexpr int L_KS = 0, L_VT = 36864, L_ST = 70144, L_SC = 102912, L_END = 103936;
static_assert(L_VT == 256 * KS_STRIDE && L_ST == L_VT + 64 * VT_STRIDE && L_END <= RING_BYTES, "attention LDS map");
__device__ __forceinline__ int crow(int r, int hi) { return (r & 3) + 8 * (r >> 2) + 4 * hi; }

struct KVRegs { v4u k[4], v[4]; };
__device__ __forceinline__ void attn_load(KVRegs& R, int uu, const bf16* Kb, const bf16* Vb) {
    const int tid = threadIdx.x, n = uu & 63, kvh = (uu >> 6) & 3, b = uu >> 8, tokbase = b * SEQ, r0 = 128 * (n - 1);
#pragma unroll
    for (int it = 0; it < 4; ++it) { const int p = tid + 512 * it, row = p >> 3, ch = p & 7; int pos = r0 + row; pos = pos < 0 ? 0 : pos;
        R.k[it] = *(const v4u*)(Kb + (size_t)(tokbase + pos) * KVW + kvh * 64 + ch * 8); }
#pragma unroll
    for (int it = 0; it < 4; ++it) { const int p = tid + 512 * it, key = p & 255, c = p >> 8; int pos = r0 + key; pos = pos < 0 ? 0 : pos;
        R.v[it] = *(const v4u*)(Vb + (size_t)(tokbase + pos) * KVW + kvh * 64 + c * 8); }
}
__device__ __forceinline__ void attn_store(const KVRegs& R, LAS unsigned char* lds) {
    const int tid = threadIdx.x;
#pragma unroll
    for (int it = 0; it < 4; ++it) { const int p = tid + 512 * it, row = p >> 3, ch = p & 7; *(LAS v4u*)(lds + L_KS + row * KS_STRIDE + ch * 16) = R.k[it]; }
#pragma unroll
    for (int it = 0; it < 4; ++it) { const int p = tid + 512 * it, key = p & 255, c = p >> 8; const v4u v = R.v[it];
        LAS unsigned short* vt = (LAS unsigned short*)(lds + L_VT + (8 * c) * VT_STRIDE + key * 2);
        vt[0 * (VT_STRIDE / 2)] = (unsigned short)(v.x & 0xffffu); vt[1 * (VT_STRIDE / 2)] = (unsigned short)(v.x >> 16);
        vt[2 * (VT_STRIDE / 2)] = (unsigned short)(v.y & 0xffffu); vt[3 * (VT_STRIDE / 2)] = (unsigned short)(v.y >> 16);
        vt[4 * (VT_STRIDE / 2)] = (unsigned short)(v.z & 0xffffu); vt[5 * (VT_STRIDE / 2)] = (unsigned short)(v.z >> 16);
        vt[6 * (VT_STRIDE / 2)] = (unsigned short)(v.w & 0xffffu); vt[7 * (VT_STRIDE / 2)] = (unsigned short)(v.w >> 16); }
}
struct ConvCtx { const bf16* Ub; bf16* CB; const LAS float* w; int c0, row; bool on; v4u um2, um1; };
struct ConvB { v4u u[4], cb[4]; };
__device__ __forceinline__ void conv_issue(ConvB& B, const ConvCtx& C) {
#pragma unroll
    for (int r = 0; r < 4; ++r) { const size_t off = (size_t)(C.row + r) * 1024 + C.c0; B.u[r] = *(const v4u*)(C.Ub + off); B.cb[r] = *(const v4u*)(C.CB + off); }
}
__device__ __forceinline__ void conv_finish(const ConvB& B, ConvCtx& C) {
    float w0[8], w1[8], w2[8];
    { const f32x4 a0 = *(const LAS f32x4*)(C.w + C.c0), a1 = *(const LAS f32x4*)(C.w + C.c0 + 4), b0 = *(const LAS f32x4*)(C.w + 1024 + C.c0), b1 = *(const LAS f32x4*)(C.w + 1024 + C.c0 + 4),
                  c0_ = *(const LAS f32x4*)(C.w + 2048 + C.c0), c1_ = *(const LAS f32x4*)(C.w + 2048 + C.c0 + 4);
#pragma unroll
      for (int q = 0; q < 4; ++q) { w0[q] = a0[q]; w0[q + 4] = a1[q]; w1[q] = b0[q]; w1[q + 4] = b1[q]; w2[q] = c0_[q]; w2[q + 4] = c1_[q]; } }
#pragma unroll
    for (int r = 0; r < 4; ++r) { const v4u u0 = B.u[r], cb = B.cb[r], um2 = C.um2, um1 = C.um1; v4u o;
#define CONV2(F, qa) cvt_pk_bf16(bf_lo(cb.F) * (w0[qa] * bf_lo(um2.F) + w1[qa] * bf_lo(um1.F) + w2[qa] * bf_lo(u0.F)), bf_hi(cb.F) * (w0[qa + 1] * bf_hi(um2.F) + w1[qa + 1] * bf_hi(um1.F) + w2[qa + 1] * bf_hi(u0.F)))
        o.x = CONV2(x, 0); o.y = CONV2(y, 2); o.z = CONV2(z, 4); o.w = CONV2(w, 6);
#undef CONV2
        if (C.on) { *(v4u*)(C.CB + (size_t)(C.row + r) * 1024 + C.c0) = o; C.um2 = um1; C.um1 = u0; } }
    if (C.on) C.row += 4;
}
template <int SUB> __device__ __forceinline__ void attn_sub(LAS unsigned char* lds, int uu, int un, KVRegs& R, const bf16* Q, const bf16* Kb, const bf16* Vb, bf16* O, float sinkv, int hq, ConvCtx& CV) {
    const int tid = threadIdx.x, lane = tid & 63, r32 = lane & 31, hi = lane >> 5, wid = __builtin_amdgcn_readfirstlane(tid >> 6);
    const int n = uu & 63, b = uu >> 8, tokbase = b * SEQ;
    LAS float* scr = (LAS float*)(lds + L_SC + wid * 128);
    LAS unsigned short* stg = (LAS unsigned short*)(lds + L_ST + wid * 4096);
    {
        const int q0 = 64 * (wid & 1) + 32 * SUB, tb = q0 >> 5;
        const size_t qtok = (size_t)tokbase + 128 * n + q0;
        bf16x8 qf[4];
#pragma unroll
        for (int s = 0; s < 4; ++s) qf[s] = *(const bf16x8*)(Q + (qtok + r32) * 1024 + hq * 64 + 16 * s + 8 * hi);
        if constexpr (SUB == 0) { if (KV_PREFETCH) attn_load(R, un, Kb, Vb); }
        ConvB CBt; conv_issue(CBt, CV);
        f32x16 sc[5];
#pragma unroll
        for (int i = 0; i < 5; ++i) { f32x16 a = {};
#pragma unroll
            for (int s = 0; s < 4; ++s) { const bf16x8 kf = *(const LAS bf16x8*)(lds + L_KS + (32 * (tb + i) + r32) * KS_STRIDE + (16 * s + 8 * hi) * 2);
                a = __builtin_amdgcn_mfma_f32_32x32x16_bf16(kf, qf[s], a, 0, 0, 0); }
            sc[i] = a; }
#pragma unroll
        for (int r = 0; r < 16; ++r) { const int kl = crow(r, hi);
            if (!(kl > r32)) sc[0][r] = -INFINITY;
            if (!(kl <= r32)) sc[4][r] = -INFINITY; }
        if (n == 0) {
#pragma unroll
            for (int i = 0; i < 4; ++i) if (tb + i < 4) {
#pragma unroll
                for (int r = 0; r < 16; ++r) sc[i][r] = -INFINITY; } }
        float mx = sinkv;
#pragma unroll
        for (int i = 0; i < 5; ++i)
#pragma unroll
            for (int r = 0; r < 16; ++r) mx = fmaxf(mx, sc[i][r]);
        mx = fmaxf(mx, __shfl_xor(mx, 32));
        float sum = 0.f;
#pragma unroll
        for (int i = 0; i < 5; ++i)
#pragma unroll
            for (int r = 0; r < 16; ++r) { const float p = __builtin_amdgcn_exp2f(sc[i][r] - mx); sc[i][r] = p; sum += p; }
        sum += __shfl_xor(sum, 32);
        const float denom = sum + __builtin_amdgcn_exp2f(sinkv - mx);
        if (hi == 0) scr[r32] = __builtin_amdgcn_rcpf(denom);
        f32x16 o[2]; o[0] = f32x16{}; o[1] = f32x16{};
#pragma unroll
        for (int i = 0; i < 5; ++i)
#pragma unroll
            for (int s2 = 0; s2 < 2; ++s2) {
                v4u pw; pw.x = cvt_pk_bf16(sc[i][8 * s2 + 0], sc[i][8 * s2 + 1]); pw.y = cvt_pk_bf16(sc[i][8 * s2 + 2], sc[i][8 * s2 + 3]);
                pw.z = cvt_pk_bf16(sc[i][8 * s2 + 4], sc[i][8 * s2 + 5]); pw.w = cvt_pk_bf16(sc[i][8 * s2 + 6], sc[i][8 * s2 + 7]);
                const bf16x8 pa = __builtin_bit_cast(bf16x8, pw);
                const int key0 = 32 * (tb + i) + 16 * s2 + 4 * hi;
#pragma unroll
                for (int dh = 0; dh < 2; ++dh) { const LAS unsigned char* vp = lds + L_VT + (32 * dh + r32) * VT_STRIDE + key0 * 2;
                    const s16x4 lo = *(const LAS s16x4*)vp, h4 = *(const LAS s16x4*)(vp + 16);
                    const bf16x8 vb = {lo[0], lo[1], lo[2], lo[3], h4[0], h4[1], h4[2], h4[3]};
                    o[dh] = __builtin_amdgcn_mfma_f32_32x32x16_bf16(pa, vb, o[dh], 0, 0, 0); } }
#pragma unroll
        for (int r = 0; r < 16; ++r) { const int orow = crow(r, hi); const float rl = scr[orow];
#pragma unroll
            for (int dh = 0; dh < 2; ++dh) stg[orow * 64 + dh * 32 + r32] = (unsigned short)(cvt_pk_bf16(o[dh][r] * rl, 0.f) & 0xffffu); }
        bf16* Ow = O + qtok * 1024 + hq * 64;
#pragma unroll
        for (int i = 0; i < 4; ++i) { const int row = i * 8 + (lane >> 3), ch = lane & 7; const v4u v = *(const LAS v4u*)(stg + row * 64 + ch * 8); *(v4u*)(Ow + (size_t)row * 1024 + ch * 8) = v; }
        conv_finish(CBt, CV);
    }
}
__device__ __forceinline__ void attn_compute(LAS unsigned char* lds, int uu, int un, KVRegs& R, const bf16* Q, const bf16* Kb, const bf16* Vb, bf16* O, const float* sinks, ConvCtx& CV) {
    const int wid = __builtin_amdgcn_readfirstlane(threadIdx.x >> 6), kvh = (uu >> 6) & 3, hq = 4 * kvh + (wid >> 1);
    const float sinkv = sinks[hq] * LOG2E;
    attn_sub<0>(lds, uu, un, R, Q, Kb, Vb, O, sinkv, hq, CV);
    attn_sub<1>(lds, uu, un, R, Q, Kb, Vb, O, sinkv, hq, CV);
    __syncthreads();
}
}

struct Args { const float* in[19]; float* out; unsigned char* ws; int ph_lo, ph_hi, li, pad; };

__global__ void __launch_bounds__(NWAVES * 64, 2) fwd_kernel(Args args) {
    extern __shared__ __attribute__((aligned(16))) unsigned char lds_raw[];
    LAS unsigned char* lds = (LAS unsigned char*)lds_raw;
    volatile LAS unsigned* MISC = (volatile LAS unsigned*)(lds + MISC_OFF);
    const int tid = threadIdx.x, lane = tid & 63, wave = __builtin_amdgcn_readfirstlane(tid >> 6);
    const int G = gridDim.x; const int bx = blockIdx.x; const int vcu = (G % 8 == 0) ? (bx % 8) * (G / 8) + bx / 8 : bx;
    unsigned char* ws = args.ws;
    gu32* ctl = (gu32*)(ws + WS_CTL);
    const float* x = args.in[0]; const float* g_mix = args.in[1]; const float* w_in = args.in[2]; const float* b_in = args.in[3]; const float* sinks = args.in[4];
    const float* w_conv = args.in[5]; const float* w_attn_o = args.in[6]; const float* w_conv_o = args.in[7]; const float* w_out = args.in[8]; const float* g_ffn = args.in[9];
    const float* w_router = args.in[10]; const float* b_router = args.in[11]; const float* w_gate = args.in[12]; const float* b_gate = args.in[13]; const float* w_up = args.in[14];
    const float* b_up = args.in[15]; const float* w_down = args.in[16]; const float* b_down = args.in[17]; const float* g_final = args.in[18];
    float* out = args.out;
    float* rstd0 = (float*)(ws + WS_RSTD0); float* binp = (float*)(ws + WS_BINP); float* bgu = (float*)(ws + WS_BGU); float* cosT = (float*)(ws + WS_COS); float* sinT = (float*)(ws + WS_SIN);
    bf16* Win_t = (bf16*)(ws + WS_WIN); bf16* Wao_t = (bf16*)(ws + WS_WAO); bf16* Wco_t = (bf16*)(ws + WS_WCO); bf16* Wout_t = (bf16*)(ws + WS_WOUT);
    bf16* XN = (bf16*)(ws + WS_XN); bf16* Qb = (bf16*)(ws + WS_Q); bf16* Kb = (bf16*)(ws + WS_K); bf16* Vb = (bf16*)(ws + WS_V); bf16* CB = (bf16*)(ws + WS_CB);
    bf16* MG = (bf16*)(ws + WS_MG); bf16* Ub = (bf16*)(ws + WS_U); bf16* SA = (bf16*)(ws + WS_SA); bf16* SC = (bf16*)(ws + WS_SC);
    bf16* Wgu_t = (bf16*)(ws + WS_WGU); bf16* Wd_t = (bf16*)(ws + WS_WD);
    int* tokrel = (int*)(ws + WS_TOKREL); float* rstdrel = (float*)(ws + WS_RSTDREL); unsigned* route = (unsigned*)(ws + WS_ROUTE); float* routew = (float*)(ws + WS_ROUTEW);
    bf16* ACT = (bf16*)(ws + WS_ACT); bf16* Yb = (bf16*)(ws + WS_Y); bf16* DLb = (bf16*)(ws + WS_DL);

    for (int u = tid; u < (LDS_BYTES - LDSCTL_OFF) / 4; u += NWAVES * 64) ((LAS unsigned*)(lds + LDSCTL_OFF))[u] = 0u;
    __syncthreads();
    XcdBarrier bar; bar.bar = (unsigned*)(ctl + CW_BAR); bar.x = 0; bar.st = nullptr;
    if (N_LAUNCHES != PER_PHASE) bar = xcd_barrier_post((unsigned*)(ctl + CW_BAR), MISC + 8);
#define GRID_BAR(seam) do { if (N_LAUNCHES == PER_PHASE) { if (tid == 0) __hip_atomic_store(ctl + CW_TMO, 0xBADBA0u | (unsigned)(seam), RLX_AGENT); } else { xcd_barrier(bar); } } while (0)
    const int lo = args.ph_lo, hi = args.ph_hi;
#define IN(k) (lo <= (k) && (k) < hi)
#define BOTH(k) (IN(k) && IN((k) + 1))
    const int gw = vcu * NWAVES + wave, NGW = G * NWAVES;
#define STAMP(k) do { if ((DBG_TIME_PH >= 0 || DBG_RVR_PH >= 0) && (k) < 16 && bx == 0 && tid == 0) __hip_atomic_store(ctl + CW_TS + (k), (unsigned)__builtin_amdgcn_s_memrealtime(), RLX_AGENT); } while (0)
    STAMP(0);

    LAS unsigned long long* ptab = (LAS unsigned long long*)(lds + TAB_OFF + 1600);
    if (tid == 0) { ptab[0] = (unsigned long long)w_attn_o; ptab[1] = (unsigned long long)w_conv_o; ptab[2] = (unsigned long long)w_out; ptab[3] = (unsigned long long)w_gate; ptab[4] = (unsigned long long)w_up; ptab[5] = (unsigned long long)w_down;
        ptab[6] = (unsigned long long)Wao_t; ptab[7] = (unsigned long long)Wco_t; ptab[8] = (unsigned long long)Wout_t; ptab[9] = (unsigned long long)Wgu_t; ptab[10] = (unsigned long long)Wgu_t; ptab[11] = (unsigned long long)Wd_t; }
    __syncthreads();
    LAS float* gffl = (LAS float*)(lds + RING_OFF + 69632);
    const CvtSrc CS{w_in, Win_t, ptab, gffl};
    const int HELP = (HELPER_CUS > 0 && G == 256 && N_LAUNCHES == 1) ? HELPER_CUS : 0;
    if (IN(0)) {
        LAS unsigned char* scr = lds + RING_OFF + wave * 8704;
        for (int i = tid; i < 512; i += 512) *(LAS f32x4*)(gffl + 4 * i) = i < 256 ? *(const f32x4*)(g_ffn + 4 * i) : *(const f32x4*)(g_mix + 4 * (i - 256));
        __syncthreads();
        cvt_run<0>(CS, gw, NGW, CVT_IN_ITEMS, scr, lane);
        if (HELP == 0) cvt_run<1>(CS, gw, NGW, CVT_REST_ITEMS - SLACK_P1_ITEMS - SLACK_P6_ITEMS, scr, lane);
        const int gt = vcu * (NWAVES * 64) + tid, NGT = G * NWAVES * 64;
        for (int c = gt; c < NIN; c += NGT) binp[win_dest(c)] = b_in[c];
        for (int i = gt; i < NEXP * DFF; i += NGT) { const int e = i >> 10, c = i & 1023; bgu[e * 2048 + map_dest(2, c)] = b_gate[i]; bgu[e * 2048 + map_dest(3, c)] = b_up[i]; }
        for (int i = gt; i < SEQ * 32; i += NGT) { const int pos = i >> 5, f = i & 31;
            const double inv = exp2(-(double)f * (13.287712379549449 / 32.0));
            const double rev = (double)pos * inv * 0.15915494309189535; const float fr = (float)(rev - rint(rev));
            cosT[i] = __builtin_amdgcn_cosf(fr); sinT[i] = __builtin_amdgcn_sinf(fr); }
        if (FOLD_GMIX) { for (int m = gw; m < M; m += NGW) { const GAS f32x4* xr = (const GAS f32x4*)(x + (size_t)m * D) + lane; f32x4 v[4]; float s_ = 0.f;
#pragma unroll
                for (int j = 0; j < 4; ++j) { v[j] = __builtin_nontemporal_load(xr + 64 * j); s_ += (v[j].x * v[j].x + v[j].y * v[j].y) + (v[j].z * v[j].z + v[j].w * v[j].w); }
                GAS v2u* o8 = (GAS v2u*)(XN + (size_t)m * D) + lane;
#pragma unroll
                for (int j = 0; j < 4; ++j) { v2u w; w.x = cvt_pk_bf16(v[j].x, v[j].y); w.y = cvt_pk_bf16(v[j].z, v[j].w); o8[64 * j] = w; }
                const float rs_ = 1.f / sqrtf(wave_sum(s_) * (1.f / D) + RMS_EPS); if (lane == 0) rstd0[m] = rs_; } }
        else for (int m = gw; m < M; m += NGW) rms_row_to_bf16(x + (size_t)m * D, g_mix, XN + (size_t)m * D, lane);
        if (BOTH(0)) GRID_BAR(0); STAMP(1);
    }

#define STAGGER(S_, total_units) do { if (STAGGER_US > 0) { int nu_ = 0; pg8::Unit u_; while (S_.next(nu_, u_)) ++nu_; const int mx_ = ((total_units) + G - 1) / G; \
        if (nu_ < mx_) { const unsigned long long t0_ = __builtin_amdgcn_s_memrealtime(); while (__builtin_amdgcn_s_memrealtime() - t0_ < (unsigned long long)(STAGGER_US * 100)) __builtin_amdgcn_s_sleep(16); } } } while (0)
    if (IN(1)) {
        if (bx < G - HELP) {
            DenseOrder S{M / 256, NIN / 256, G - HELP, bx, D, (const char*)XN, (const char*)Win_t};
            EpiInProj E{Qb, Kb, Vb, CB, Ub, SA, SC, binp, cosT, sinT, rstd0};
            if (HELP == 0) STAGGER(S, (M / 256) * (NIN / 256));
            for (int i = tid; i < 512; i += 512) *(LAS f32x4*)(gffl + 4 * i) = i < 256 ? *(const f32x4*)(g_ffn + 4 * i) : *(const f32x4*)(g_mix + 4 * (i - 256));
            __syncthreads();
            if (HELP == 0) slack_convert(CS, (M / 256) * (NIN / 256), G, bx, CVT_REST_ITEMS - SLACK_P1_ITEMS - SLACK_P6_ITEMS, SLACK_P1_ITEMS, lds + RING_OFF + wave * 8704, wave, lane);
            __syncthreads();
            pg8::gemm_phase<EpiInProj, DenseOrder, true, false>(lds + RING_OFF, D, S, E, (DBG_KLOOP_PH == 1 && bx == 0) ? (unsigned*)(ctl + CW_TS + 16) : nullptr);
        } else {
            cvt_run<1>(CS, (bx - (G - HELP)) * NWAVES + wave, HELP * NWAVES, CVT_REST_ITEMS, lds + RING_OFF + wave * 8704, lane);
        }
        if (BOTH(1)) GRID_BAR(1); STAMP(2);
    }

    if (IN(2)) {
        const bool cinl = CONV_INLINE && G == 256 && BATCH * NKVH * (SEQ / 128) == 512;
        { constexpr int NU = BATCH * NKVH * (SEQ / 128); att::KVRegs R; int uu = vcu;
            LAS float* wcl = (LAS float*)(lds + RING_OFF + 104448);
            for (int i = tid; i < 768; i += 512) *(LAS f32x4*)(wcl + 4 * i) = *(const f32x4*)(w_conv + 4 * i);
            __syncthreads();
            att::ConvCtx CV; CV.Ub = Ub; CV.CB = CB; CV.w = wcl; CV.c0 = (tid & 127) * 8; CV.row = (cinl ? vcu : 0) * 64 + (tid >> 7) * 16; CV.on = cinl; CV.um2 = (v4u){0u, 0u, 0u, 0u}; CV.um1 = (v4u){0u, 0u, 0u, 0u};
            if (cinl && (CV.row & (SEQ - 1)) >= 2) { CV.um2 = *(const v4u*)(Ub + (size_t)(CV.row - 2) * 1024 + CV.c0); CV.um1 = *(const v4u*)(Ub + (size_t)(CV.row - 1) * 1024 + CV.c0); }
            if (KV_PREFETCH && uu < NU) att::attn_load(R, uu, Kb, Vb);
            while (uu < NU) { if (!KV_PREFETCH) att::attn_load(R, uu, Kb, Vb); att::attn_store(R, lds + RING_OFF); __syncthreads(); const int un = uu + G < NU ? uu + G : uu;
                att::attn_compute(lds + RING_OFF, uu, un, R, Qb, Kb, Vb, Qb, sinks, CV); uu += G; } }
        if (!cinl)
        for (int ch = vcu; ch < M / 64; ch += G) {
            const int c0 = (tid & 127) * 8, row0 = ch * 64 + (tid >> 7) * 16, pos0 = row0 & (SEQ - 1);
            float w0[8], w1[8], w2[8];
#pragma unroll
            for (int q = 0; q < 8; ++q) { w0[q] = w_conv[c0 + q]; w1[q] = w_conv[1024 + c0 + q]; w2[q] = w_conv[2048 + c0 + q]; }
            v4u um2 = {0u, 0u, 0u, 0u}, um1 = {0u, 0u, 0u, 0u};
            if (pos0 >= 2) { um2 = *(const v4u*)(Ub + (size_t)(row0 - 2) * 1024 + c0); um1 = *(const v4u*)(Ub + (size_t)(row0 - 1) * 1024 + c0); }
#pragma unroll 4
            for (int r = 0; r < 16; ++r) { const size_t off = (size_t)(row0 + r) * 1024 + c0;
                const v4u u0 = *(const v4u*)(Ub + off), cb = *(const v4u*)(CB + off); v4u o;
#define CONV2(F, qa) cvt_pk_bf16(bf_lo(cb.F) * (w0[qa] * bf_lo(um2.F) + w1[qa] * bf_lo(um1.F) + w2[qa] * bf_lo(u0.F)), bf_hi(cb.F) * (w0[qa + 1] * bf_hi(um2.F) + w1[qa + 1] * bf_hi(um1.F) + w2[qa + 1] * bf_hi(u0.F)))
                o.x = CONV2(x, 0); o.y = CONV2(y, 2); o.z = CONV2(z, 4); o.w = CONV2(w, 6);
#undef CONV2
                *(v4u*)(CB + off) = o; um2 = um1; um1 = u0; }
        }
        if (BOTH(2)) GRID_BAR(2); STAMP(3);
    }

    if (IN(3)) {
        MergeOrder S{M / 256, D / 256, G, bx, D, (const char*)Qb, (const char*)Wao_t, (const char*)CB, (const char*)Wco_t};
        EpiMerge E{SA, SC, MG};
        pg8::gemm_phase<EpiMerge, MergeOrder, true, false>(lds + RING_OFF, D, S, E, (DBG_KLOOP_PH == 3 && bx == 0) ? (unsigned*)(ctl + CW_TS + 16) : nullptr);
        if (BOTH(3)) GRID_BAR(3); STAMP(4);
    }

    if (IN(4)) {
        DenseOrder S{M / 256, D / 256, G, bx, D, (const char*)MG, (const char*)Wout_t};
        EpiRes E{DLb};
        pg8::gemm_phase<EpiRes, DenseOrder, false, false>(lds + RING_OFF, D, S, E, (DBG_KLOOP_PH == 4 && bx == 0) ? (unsigned*)(ctl + CW_TS + 16) : nullptr);
        if (BOTH(4)) GRID_BAR(4); STAMP(5);
    }

#if P5_MFMA
    if (IN(5)) {
        LAS float* GL = (LAS float*)(lds + RING_OFF);
#define P5_BL_LDS (FOLD_GMIX && FOLD_G)
        LAS float* PL = (LAS float*)(lds + RING_OFF + (P5_BL_LDS ? 65536 : 4096));
        LAS float* PS = P5_BL_LDS ? (LAS float*)(lds + TOK_OFF + 8192) : (LAS float*)(lds + RING_OFF + 4096 + 65536);
        LAS unsigned char* BLs = lds + RING_OFF + wave * 8192 + lane * 16;
        LAS int* lcnt = (LAS int*)(lds + TOK_OFF); LAS int* lbase = lcnt + 32; LAS unsigned* ce = (LAS unsigned*)(lds + TOK_OFF + 256); LAS int* cr = (LAS int*)(lds + TOK_OFF + 256 + 1024); LAS float* cw = (LAS float*)(lds + TOK_OFF + 256 + 2048);
        LAS float* crs = (LAS float*)(lds + TOK_OFF + 256 + 3072);
        for (int i = tid; i < 256; i += 512) *(LAS f32x4*)(GL + 4 * i) = *(const f32x4*)(g_ffn + 4 * i);
        __syncthreads();
        const int r32 = lane & 31, kh = lane >> 5, kb = 128 * wave;
        const float brt = b_router[r32];
        bf16x8 Bh[8], Bl[8];
#pragma unroll
        for (int f = 0; f < 8; ++f) { const int k0 = kb + 32 * (f >> 1) + 16 * kh + 8 * (f & 1);
            const f32x4 g0 = *(const LAS f32x4*)(GL + k0), g1 = *(const LAS f32x4*)(GL + k0 + 4);
            float wv[8];
#pragma unroll
            for (int j = 0; j < 8; ++j) wv[j] = w_router[(size_t)(k0 + j) * 32 + r32] * (j < 4 ? g0[j] : g1[j - 4]);
            v4u hw, lw;
#define SPLIT2(dsth, dstl, a_, b_) do { const unsigned h_ = cvt_pk_bf16(a_, b_); dsth = h_; dstl = cvt_pk_bf16((a_) - bf_lo(h_), (b_) - bf_hi(h_)); } while (0)
            SPLIT2(hw.x, lw.x, wv[0], wv[1]); SPLIT2(hw.y, lw.y, wv[2], wv[3]); SPLIT2(hw.z, lw.z, wv[4], wv[5]); SPLIT2(hw.w, lw.w, wv[6], wv[7]);
            Bh[f] = __builtin_bit_cast(bf16x8, hw); Bl[f] = __builtin_bit_cast(bf16x8, lw); }
        if (P5_BL_LDS) { __syncthreads();
#pragma unroll
            for (int f = 0; f < 8; ++f) *(LAS bf16x8*)(BLs + f * 1024) = Bl[f]; }
#define P5_BLF(f_) (P5_BL_LDS ? *(const LAS bf16x8*)(BLs + (f_) * 1024) : Bl[f_])
        for (int ch = vcu; ch < M / 64; ch += G) {
            if (tid < 32) lcnt[tid] = 0;
            f32x16 acc[2]; acc[0] = f32x16{}; acc[1] = f32x16{}; float ss[2] = {0.f, 0.f};
#define P5M_LOADG(XQ, DQ, mt_, sp_) do { const size_t ro_ = (size_t)(ch * 64 + 32 * (mt_) + r32) * D + kb + 16 * kh + 64 * (sp_); \
                _Pragma("unroll") for (int S_ = 0; S_ < 2; ++S_) { \
                    if (FOLD_GMIX) { XQ##r[S_][0] = *(const v4u*)(XN + ro_ + 32 * S_); XQ##r[S_][1] = *(const v4u*)(XN + ro_ + 32 * S_ + 8); }     \
                    else { _Pragma("unroll") for (int q = 0; q < 4; ++q) XQ[S_][q] = *(const f32x4*)(x + ro_ + 32 * S_ + 4 * q); } \
                    DQ[S_][0] = *(const v4u*)(DLb + ro_ + 32 * S_); DQ[S_][1] = *(const v4u*)(DLb + ro_ + 32 * S_ + 8); } } while (0)
#define P5M_PROC(XQ, DQ, mt_, sp_) do { const size_t ro_ = (size_t)(ch * 64 + 32 * (mt_) + r32) * D + kb + 16 * kh + 64 * (sp_); \
                _Pragma("unroll") for (int S_ = 0; S_ < 2; ++S_) { const int S = 2 * (sp_) + S_; float x1[16]; \
                    if (FOLD_GMIX) { _Pragma("unroll") for (int h = 0; h < 2; ++h) { const v4u b_ = XQ##r[S_][h]; \
                            x1[8 * h + 0] = bf_lo(b_.x); x1[8 * h + 1] = bf_hi(b_.x); x1[8 * h + 2] = bf_lo(b_.y); x1[8 * h + 3] = bf_hi(b_.y); x1[8 * h + 4] = bf_lo(b_.z); x1[8 * h + 5] = bf_hi(b_.z); x1[8 * h + 6] = bf_lo(b_.w); x1[8 * h + 7] = bf_hi(b_.w); } } \
                    else { _Pragma("unroll") for (int q = 0; q < 4; ++q) { x1[4 * q] = XQ[S_][q].x; x1[4 * q + 1] = XQ[S_][q].y; x1[4 * q + 2] = XQ[S_][q].z; x1[4 * q + 3] = XQ[S_][q].w; } } \
                    _Pragma("unroll") for (int h = 0; h < 2; ++h) { const v4u d = DQ[S_][h]; \
                        x1[8 * h + 0] += bf_lo(d.x); x1[8 * h + 1] += bf_hi(d.x); x1[8 * h + 2] += bf_lo(d.y); x1[8 * h + 3] += bf_hi(d.y); \
                        x1[8 * h + 4] += bf_lo(d.z); x1[8 * h + 5] += bf_hi(d.z); x1[8 * h + 6] += bf_lo(d.w); x1[8 * h + 7] += bf_hi(d.w); } \
                    float s_ = 0.f; \
                    _Pragma("unroll") for (int j = 0; j < 16; ++j) s_ += x1[j] * x1[j]; \
                    ss[mt_] += s_; \
                    const int kk = kb + 32 * S + 16 * kh; v4u o0, o1; \
                    { const f32x4 g0 = *(const LAS f32x4*)(GL + kk), g1 = *(const LAS f32x4*)(GL + kk + 4), g2 = *(const LAS f32x4*)(GL + kk + 8), g3 = *(const LAS f32x4*)(GL + kk + 12); \
                      if (FOLD_G) { o0.x = cvt_pk_bf16(x1[0], x1[1]); o0.y = cvt_pk_bf16(x1[2], x1[3]); o0.z = cvt_pk_bf16(x1[4], x1[5]); o0.w = cvt_pk_bf16(x1[6], x1[7]); \
                                    o1.x = cvt_pk_bf16(x1[8], x1[9]); o1.y = cvt_pk_bf16(x1[10], x1[11]); o1.z = cvt_pk_bf16(x1[12], x1[13]); o1.w = cvt_pk_bf16(x1[14], x1[15]); } else { \
                      o0.x = cvt_pk_bf16(x1[0] * g0.x, x1[1] * g0.y); o0.y = cvt_pk_bf16(x1[2] * g0.z, x1[3] * g0.w); o0.z = cvt_pk_bf16(x1[4] * g1.x, x1[5] * g1.y); o0.w = cvt_pk_bf16(x1[6] * g1.z, x1[7] * g1.w); \
                      o1.x = cvt_pk_bf16(x1[8] * g2.x, x1[9] * g2.y); o1.y = cvt_pk_bf16(x1[10] * g2.z, x1[11] * g2.w); o1.z = cvt_pk_bf16(x1[12] * g3.x, x1[13] * g3.y); o1.w = cvt_pk_bf16(x1[14] * g3.z, x1[15] * g3.w); } } \
                    *(v4u*)(XN + ro_ + 32 * S_) = o0; *(v4u*)(XN + ro_ + 32 * S_ + 8) = o1; \
                    _Pragma("unroll") for (int q = 0; q < 2; ++q) { v4u hw, lw; \
                        SPLIT2(hw.x, lw.x, x1[8 * q + 0], x1[8 * q + 1]); SPLIT2(hw.y, lw.y, x1[8 * q + 2], x1[8 * q + 3]); SPLIT2(hw.z, lw.z, x1[8 * q + 4], x1[8 * q + 5]); SPLIT2(hw.w, lw.w, x1[8 * q + 6], x1[8 * q + 7]); \
                        const bf16x8 Ah = __builtin_bit_cast(bf16x8, hw), Al = __builtin_bit_cast(bf16x8, lw); \
                        acc[mt_] = __builtin_amdgcn_mfma_f32_32x32x16_bf16(Ah, Bh[2 * S + q], acc[mt_], 0, 0, 0); \
                        acc[mt_] = __builtin_amdgcn_mfma_f32_32x32x16_bf16(Al, Bh[2 * S + q], acc[mt_], 0, 0, 0); \
                        acc[mt_] = __builtin_amdgcn_mfma_f32_32x32x16_bf16(Ah, P5_BLF(2 * S + q), acc[mt_], 0, 0, 0); } } } while (0)
            { f32x4 xa_[2][4], xb_[2][4]; v4u xa_r[2][2], xb_r[2][2]; v4u da_[2][2], db_[2][2];
#define SB_ __builtin_amdgcn_sched_barrier(0)
              P5M_LOADG(xa_, da_, 0, 0); P5M_LOADG(xb_, db_, 0, 1); SB_;
              P5M_PROC(xa_, da_, 0, 0); SB_; P5M_LOADG(xa_, da_, 1, 0); SB_;
              P5M_PROC(xb_, db_, 0, 1); SB_; P5M_LOADG(xb_, db_, 1, 1); SB_;
              P5M_PROC(xa_, da_, 1, 0); SB_; P5M_PROC(xb_, db_, 1, 1); }
#undef SB_
#undef P5_BLF
#undef P5M_LOADG
#undef P5M_PROC
#undef SPLIT2
#pragma unroll
            for (int mt = 0; mt < 2; ++mt) { const float st = ss[mt] + __shfl_xor(ss[mt], 32); if (kh == 0) PS[wave * 64 + 32 * mt + r32] = st;
#pragma unroll
                for (int r = 0; r < 16; ++r) PL[(wave * 64 + 32 * mt + ((r & 3) + 8 * (r >> 2) + 4 * kh)) * 32 + r32] = acc[mt][r]; }
            __syncthreads();
#define P5_ROWPOST(lgin, tl_) do { float lg = lgin; int te[4]; float tlg[4]; \
                _Pragma("unroll") for (int k = 0; k < 4; ++k) { const float mx = half_max_dpp(lg); const unsigned long long bm = __ballot(lg == mx); const int sel = __builtin_ctzll(bm); te[k] = sel; tlg[k] = mx; if ((lane & 31) == sel) lg = -INFINITY; } \
                const float e1 = __expf(tlg[1] - tlg[0]), e2 = __expf(tlg[2] - tlg[0]), e3 = __expf(tlg[3] - tlg[0]), inv = 1.0f / (1.0f + e1 + e2 + e3); \
                if (lane < 4) { const int ek = lane == 0 ? te[0] : lane == 1 ? te[1] : lane == 2 ? te[2] : te[3]; const float wk = (lane == 0 ? 1.0f : lane == 1 ? e1 : lane == 2 ? e2 : e3) * inv; \
                    const int r = atomicAdd((int*)(lcnt + ek), 1); ce[(tl_) * 4 + lane] = (unsigned)ek; cr[(tl_) * 4 + lane] = r; cw[(tl_) * 4 + lane] = wk; } } while (0)
#pragma unroll 1
            for (int rr = 0; rr < 8; ++rr) { const int tl = wave * 8 + rr; float lgs = 0.f, sq = 0.f;
#pragma unroll
                for (int w2 = 0; w2 < 8; ++w2) { lgs += PL[(w2 * 64 + tl) * 32 + r32]; sq += PS[w2 * 64 + tl]; }
                const float rstd = 1.f / sqrtf(sq * (1.f / D) + RMS_EPS);
                if (lane == 0) crs[tl] = rstd;
                P5_ROWPOST(lgs * rstd + brt, tl); }
#undef P5_ROWPOST
            __syncthreads();
            if (tid < 32) lbase[tid] = (int)__hip_atomic_fetch_add(ctl + CW_CURSOR + 64 * tid, (unsigned)lcnt[tid], RLX_AGENT);
            __syncthreads();
            if (tid < 256) { const int t = ch * 64 + (tid >> 2); const unsigned e = ce[tid]; const int rel = lbase[e] + cr[tid];
                tokrel[e * SLOTCAP + rel] = t; rstdrel[e * SLOTCAP + rel] = crs[tid >> 2]; route[t * 4 + (tid & 3)] = e | ((unsigned)rel << 8); routew[t * 4 + (tid & 3)] = cw[tid]; }
            __syncthreads();
        }
        if (BOTH(5)) GRID_BAR(5); STAMP(6);
    }
#else
    if (IN(5)) {
        LAS float* wT = (LAS float*)(lds + RING_OFF);
        { f32x4 wv[16];
#pragma unroll
          for (int k = 0; k < 16; ++k) { const int idx = tid + 512 * k, c = idx & 1023, e4 = idx >> 10; wv[k] = *(const f32x4*)(w_router + (size_t)c * 32 + e4 * 4); }
#pragma unroll
          for (int k = 0; k < 16; ++k) { const int idx = tid + 512 * k, c = idx & 1023, e4 = idx >> 10;
            wT[(e4 * 4 + 0) * 1024 + c] = wv[k].x; wT[(e4 * 4 + 1) * 1024 + c] = wv[k].y; wT[(e4 * 4 + 2) * 1024 + c] = wv[k].z; wT[(e4 * 4 + 3) * 1024 + c] = wv[k].w; } }
        LAS int* lcnt = (LAS int*)(lds + TOK_OFF); LAS int* lbase = lcnt + 32; LAS unsigned* ce = (LAS unsigned*)(lds + TOK_OFF + 256); LAS int* cr = (LAS int*)(lds + TOK_OFF + 256 + 1024); LAS float* cw = (LAS float*)(lds + TOK_OFF + 256 + 2048);
        const int psrc = 4 * ((lane & 48) | ((lane & 1) << 3) | ((lane & 2) << 1) | ((lane & 4) >> 1) | ((lane & 8) >> 3));
        const float brt = b_router[lane & 31];
        f32x4 gf[4];
#pragma unroll
        for (int j = 0; j < 4; ++j) gf[j] = *(const f32x4*)(g_ffn + 4 * lane + 256 * j);
        for (int ch = vcu; ch < M / 64; ch += G) {
            if (tid < 32) lcnt[tid] = 0;
            __syncthreads();
#define P5_LOADROW(dst, dd, t_) _Pragma("unroll") for (int j = 0; j < 4; ++j) { dst[j] = *(const f32x4*)(x + (size_t)(t_) * D + 4 * lane + 256 * j); dd[j] = *(const v2u*)(DLb + (size_t)(t_) * D + 4 * lane + 256 * j); }
#define P5_ADDD(dst, dd) _Pragma("unroll") for (int j = 0; j < 4; ++j) { dst[j].x += bf_lo(dd[j].x); dst[j].y += bf_hi(dd[j].x); dst[j].z += bf_lo(dd[j].y); dst[j].w += bf_hi(dd[j].y); }
#define P5_BFLY(v, NV, MK) _Pragma("unroll") for (int i = 0; i < NV; ++i) { const bool up = (lane & MK) != 0; const float send = up ? v[i] : v[i + NV], keep = up ? v[i + NV] : v[i]; v[i] = keep + __shfl_xor(send, MK); }
#define P5_ROWPOST(lgin, tl_) do { float lg = __builtin_bit_cast(float, __builtin_amdgcn_ds_bpermute(psrc, __builtin_bit_cast(int, lgin))) + brt; int te[4]; float tlg[4];     \
                _Pragma("unroll") for (int k = 0; k < 4; ++k) { const float mx = half_max_dpp(lg); const unsigned long long bm = __ballot(lg == mx); const int sel = __builtin_ctzll(bm); te[k] = sel; tlg[k] = mx; if ((lane & 31) == sel) lg = -INFINITY; } \
                const float e1 = __expf(tlg[1] - tlg[0]), e2 = __expf(tlg[2] - tlg[0]), e3 = __expf(tlg[3] - tlg[0]), inv = 1.0f / (1.0f + e1 + e2 + e3); \
                if (lane < 4) { const int ek = lane == 0 ? te[0] : lane == 1 ? te[1] : lane == 2 ? te[2] : te[3]; const float wk = (lane == 0 ? 1.0f : lane == 1 ? e1 : lane == 2 ? e2 : e3) * inv; \
                    const int r = atomicAdd((int*)(lcnt + ek), 1); ce[(tl_) * 4 + lane] = (unsigned)ek; cr[(tl_) * 4 + lane] = r; cw[(tl_) * 4 + lane] = wk; } } while (0)
            f32x4 xa[4], xb[4]; v2u da[4], db[4];
            P5_LOADROW(xa, da, ch * 64 + wave * 8); P5_LOADROW(xb, db, ch * 64 + wave * 8 + 1);
#pragma unroll 1
            for (int pp = 0; pp < 4; ++pp) {
                const int tl = wave * 8 + 2 * pp, t = ch * 64 + tl, tn = pp < 3 ? t + 2 : t;
                f32x4 na[4], nb[4]; v2u nda[4], ndb[4];
                P5_LOADROW(na, nda, tn); P5_LOADROW(nb, ndb, tn + 1);
                P5_ADDD(xa, da); P5_ADDD(xb, db);
                float sa = 0.f, sb = 0.f;
#pragma unroll
                for (int j = 0; j < 4; ++j) { sa += (xa[j].x * xa[j].x + xa[j].y * xa[j].y) + (xa[j].z * xa[j].z + xa[j].w * xa[j].w); sb += (xb[j].x * xb[j].x + xb[j].y * xb[j].y) + (xb[j].z * xb[j].z + xb[j].w * xb[j].w); }
                const float rstda = 1.f / sqrtf(wave_sum_dpp(sa) * (1.f / D) + RMS_EPS), rstdb = 1.f / sqrtf(wave_sum_dpp(sb) * (1.f / D) + RMS_EPS);
#pragma unroll
                for (int j = 0; j < 4; ++j) { xa[j] = xa[j] * rstda * gf[j]; xb[j] = xb[j] * rstdb * gf[j];
                    v2u w; w.x = cvt_pk_bf16(xa[j].x, xa[j].y); w.y = cvt_pk_bf16(xa[j].z, xa[j].w); *(v2u*)(XN + (size_t)t * D + 4 * lane + 256 * j) = w;
                    v2u w2; w2.x = cvt_pk_bf16(xb[j].x, xb[j].y); w2.y = cvt_pk_bf16(xb[j].z, xb[j].w); *(v2u*)(XN + (size_t)(t + 1) * D + 4 * lane + 256 * j) = w2; }
                f32x2 x2[4][4];
#pragma unroll
                for (int j = 0; j < 4; ++j) { x2[j][0] = (f32x2){xa[j].x, xb[j].x}; x2[j][1] = (f32x2){xa[j].y, xb[j].y}; x2[j][2] = (f32x2){xa[j].z, xb[j].z}; x2[j][3] = (f32x2){xa[j].w, xb[j].w}; }
                float lga, lgb;
                { float h0a, h0b, h1a, h1b;
#define P5_HALF(E0, ra, rb) do { float va[16], vb[16]; \
                    _Pragma("unroll") for (int e = 0; e < 16; ++e) { f32x2 a2 = {0.f, 0.f}, c2 = {0.f, 0.f};     \
                        _Pragma("unroll") for (int j = 0; j < 4; ++j) { const f32x4 w4 = *(const LAS f32x4*)(wT + ((E0) + e) * 1024 + 4 * lane + 256 * j); \
                            a2 += x2[j][0] * (f32x2){w4.x, w4.x}; c2 += x2[j][1] * (f32x2){w4.y, w4.y}; a2 += x2[j][2] * (f32x2){w4.z, w4.z}; c2 += x2[j][3] * (f32x2){w4.w, w4.w}; } \
                        a2 += c2; va[e] = a2.x; vb[e] = a2.y; } \
                    P5_BFLY(va, 8, 1) P5_BFLY(va, 4, 2) P5_BFLY(va, 2, 4) P5_BFLY(va, 1, 8) P5_BFLY(vb, 8, 1) P5_BFLY(vb, 4, 2) P5_BFLY(vb, 2, 4) P5_BFLY(vb, 1, 8) \
                    float ta = va[0] + __shfl_xor(va[0], 16), tb = vb[0] + __shfl_xor(vb[0], 16); ra = ta + __shfl_xor(ta, 32); rb = tb + __shfl_xor(tb, 32); } while (0)
                  P5_HALF(0, h0a, h0b); __builtin_amdgcn_sched_barrier(0); P5_HALF(16, h1a, h1b); __builtin_amdgcn_sched_barrier(0);
#undef P5_HALF
                  lga = (lane & 16) ? h1a : h0a; lgb = (lane & 16) ? h1b : h0b; }
                P5_ROWPOST(lga, tl); __builtin_amdgcn_sched_barrier(0); P5_ROWPOST(lgb, tl + 1);
#pragma unroll
                for (int j = 0; j < 4; ++j) { xa[j] = na[j]; xb[j] = nb[j]; da[j] = nda[j]; db[j] = ndb[j]; }
            }
#undef P5_LOADROW
#undef P5_ADDD
#undef P5_BFLY
#undef P5_ROWPOST
            __syncthreads();
            if (tid < 32) lbase[tid] = (int)__hip_atomic_fetch_add(ctl + CW_CURSOR + 64 * tid, (unsigned)lcnt[tid], RLX_AGENT);
            __syncthreads();
            if (tid < 256) { const int t = ch * 64 + (tid >> 2); const unsigned e = ce[tid]; const int rel = lbase[e] + cr[tid];
                tokrel[e * SLOTCAP + rel] = t; route[t * 4 + (tid & 3)] = e | ((unsigned)rel << 8); routew[t * 4 + (tid & 3)] = cw[tid]; }
            __syncthreads();
        }
        if (BOTH(5)) GRID_BAR(5); STAMP(6);
    }
#endif


    LAS int* t_cnt = (LAS int*)(lds + TAB_CNT); LAS int* t_start = (LAS int*)(lds + TAB_TSTART); LAS int* t_tile = (LAS int*)(lds + TAB_TILEE);
    if (IN(6) || IN(7) || IN(8)) {
        if (tid < 32) t_cnt[tid] = (int)__hip_atomic_load(ctl + CW_CURSOR + 64 * tid, RLX_AGENT);
        __syncthreads();
        if (tid == 0) { int s = 0; for (int e = 0; e < 32; ++e) { t_start[e] = s; s += (t_cnt[e] + 255) >> 8; } t_start[32] = s; }
        __syncthreads();
        for (int i = tid; i < 320; i += 512) { int e = 0; for (int k = 1; k < 32; ++k) if (i >= t_start[k]) e = k; t_tile[i] = e; }
        __syncthreads();
    }
    const int MT = (IN(6) || IN(7) || IN(8)) ? t_start[32] : 0;

    if (IN(6)) {
        LAS unsigned* tokt = (LAS unsigned*)(lds + TOK_OFF);
        MoeOrder S{MT, G, bx, (const char*)XN, (const char*)ACT, (const char*)Wgu_t, (const char*)Wd_t, t_tile, tokt, (unsigned*)(ctl + CW_MT), (unsigned*)(ctl + CW_TMO), MOE_MERGED ? 0 : 1, 0};
        for (int i0 = 0; i0 < MAXU; i0 += 2) { const int i = i0 + (tid >> 8), r = tid & 255; pg8::Unit u;
            if (i < MAXU && S.next(i, u) && u.aux == 2) { const int e = u.e, rel = (u.pm - t_start[e]) * 256 + r; const int tok = rel < t_cnt[e] ? tokrel[e * SLOTCAP + rel] : 0; tokt[i * 256 + r] = (unsigned)tok * 2048u; } }
        __syncthreads();
        EpiMoe E{EpiGU{ACT, bgu, rstdrel, t_start}, EpiDown{Yb, b_down}};
        if (!MOE_MERGED) STAGGER(S, MT * 8);
        for (int i = tid; i < 512; i += 512) *(LAS f32x4*)(gffl + 4 * i) = i < 256 ? *(const f32x4*)(g_ffn + 4 * i) : *(const f32x4*)(g_mix + 4 * (i - 256));
        __syncthreads();
        slack_convert(CS, MT * 8, G, bx, CVT_REST_ITEMS - SLACK_P6_ITEMS, SLACK_P6_ITEMS, lds + RING_OFF + wave * 8704, wave, lane);
        __syncthreads();
        if (MOE_MERGED) pg8::gemm_phase<EpiMoe, MoeOrder, true, true>(lds + RING_OFF, D, S, E, (DBG_KLOOP_PH == 6 && bx == 0) ? (unsigned*)(ctl + CW_TS + 16) : nullptr);
        else { EpiGU Eg{ACT, bgu, rstdrel, t_start}; pg8::gemm_phase<EpiGU, MoeOrder, true, true, false, PF_P6 != 0>(lds + RING_OFF, D, S, Eg, (DBG_KLOOP_PH == 6 && bx == 0) ? (unsigned*)(ctl + CW_TS + 16) : nullptr); }
        if (MOE_MERGED ? IN(8) : BOTH(6)) GRID_BAR(6); STAMP(7);
    }
    if (IN(7)) {
        if (!MOE_MERGED) {
            const int U7 = MT * 4, full7 = (U7 / G) * G, ntail = U7 - full7; const bool split = HALF_TAIL && ntail > 0 && 2 * ntail <= G;
            MoeOrder S{MT, G, bx, (const char*)XN, (const char*)ACT, (const char*)Wgu_t, (const char*)Wd_t, t_tile, (const LAS unsigned*)(lds + TOK_OFF), (unsigned*)(ctl + CW_MT), (unsigned*)(ctl + CW_TMO), 2, split ? full7 : U7};
            EpiMoe E{EpiGU{ACT, bgu, rstdrel, t_start}, EpiDown{Yb, b_down}};
            STAGGER(S, MT * 4);
            EpiDownX Ed{EpiDown{Yb, b_down}};
            pg8::gemm_phase<EpiDownX, MoeOrder, true, false, false, PF_P7 != 0>(lds + RING_OFF, D, S, Ed, (DBG_KLOOP_PH == 7 && bx == 0) ? (unsigned*)(ctl + CW_TS + 16) : nullptr);
            if (split && bx < 2 * ntail) { TailOrder T{MT, full7, bx, (const char*)ACT, (const char*)Wd_t, t_tile};
                pg8::gemm_phase<EpiDownX, TailOrder, false, false, true>(lds + RING_OFF, D, T, Ed); }
            if (BOTH(7)) GRID_BAR(7);
        }
        STAMP(8);
    }

    if (IN(8)) {
        f32x4 gf[4];
        float dbg_scale = 1.0f;
        if (DBG_RVR_PH >= 0) { const unsigned t0 = __hip_atomic_load(ctl + CW_TS + (DBG_RVR_PH >= 0 ? DBG_RVR_PH : 0), RLX_AGENT), t1 = __hip_atomic_load(ctl + CW_TS + (DBG_RVR_PH >= 0 ? DBG_RVR_PH : 0) + 1, RLX_AGENT);
            const float fr_ = fminf((float)(t1 - t0) * (0.01f / 350.0f), 1.0f); dbg_scale = 1.0f + sqrtf(0.0035f * fr_); }
#pragma unroll
        for (int j = 0; j < 4; ++j) gf[j] = *(const f32x4*)(g_final + 4 * lane + 256 * j);
        for (int t = gw; t < M; t += NGW) {
            f32x4 a[4];
#pragma unroll
            for (int j = 0; j < 4; ++j) {
                if (FOLD_G) { const v2u xv = *(const v2u*)(XN + (size_t)t * D + 4 * lane + 256 * j); a[j] = (f32x4){bf_lo(xv.x), bf_hi(xv.x), bf_lo(xv.y), bf_hi(xv.y)}; }
                else { const f32x4 xv = *(const f32x4*)(x + (size_t)t * D + 4 * lane + 256 * j); const v2u dv = *(const v2u*)(DLb + (size_t)t * D + 4 * lane + 256 * j);
                    a[j] = (f32x4){xv.x + bf_lo(dv.x), xv.y + bf_hi(dv.x), xv.z + bf_lo(dv.y), xv.w + bf_hi(dv.y)}; } }
#pragma unroll
            for (int k = 0; k < 4; ++k) { const unsigned rt = route[t * 4 + k]; const float w = routew[t * 4 + k]; const int e = rt & 255u, rel = rt >> 8;
                const bf16* yr = Yb + ((size_t)t_start[e] * 256 + rel) * 1024 + 4 * lane;
#pragma unroll
                for (int j = 0; j < 4; ++j) { const v2u y = *(const v2u*)(yr + 256 * j); a[j].x += w * bf_lo(y.x); a[j].y += w * bf_hi(y.x); a[j].z += w * bf_lo(y.y); a[j].w += w * bf_hi(y.y); } }
            float s = 0.f;
#pragma unroll
            for (int j = 0; j < 4; ++j) s += (a[j].x * a[j].x + a[j].y * a[j].y) + (a[j].z * a[j].z + a[j].w * a[j].w);
            const float rstd = 1.f / sqrtf(wave_sum(s) * (1.f / D) + RMS_EPS);
#pragma unroll
            for (int j = 0; j < 4; ++j) *(f32x4*)(out + (size_t)t * D + 4 * lane + 256 * j) = a[j] * (rstd * dbg_scale) * gf[j];
        }
        STAMP(9);
        if (DBG_TIME_PH >= 0 && bx == 0 && tid == 0) { const unsigned t0 = __hip_atomic_load(ctl + CW_TS + DBG_TIME_PH, RLX_AGENT), t1 = __hip_atomic_load(ctl + CW_TS + DBG_TIME_PH + 1, RLX_AGENT);
            const unsigned span = 4u * (t1 - t0); const unsigned ts = (unsigned)__builtin_amdgcn_s_memrealtime(); while ((unsigned)__builtin_amdgcn_s_memrealtime() - ts < span) __builtin_amdgcn_s_sleep(8); }
    }
#undef IN
#undef BOTH
#undef GRID_BAR
}

extern "C" void kernel_launch(void* const* d_in, const int* in_sizes, int n_in, void* d_out, int out_size, void* d_ws, size_t ws_size, hipStream_t stream) {
    static int grid = 0;
    if (grid == 0) {
        if (n_in != 19 || in_sizes[0] != M * D || out_size != M * D || ws_size < WS_END) { fprintf(stderr, "kernel_launch: unexpected shapes (n_in %d, in0 %d, out %d, ws %zu)\n", n_in, n_in > 0 ? in_sizes[0] : -1, out_size, ws_size); grid = -1; return; }
        int dev = 0, cus = 0, per_cu = 0;
        if (hipGetDevice(&dev) != hipSuccess || hipDeviceGetAttribute(&cus, hipDeviceAttributeMultiprocessorCount, dev) != hipSuccess) { grid = -1; return; }
        if (hipFuncSetAttribute((const void*)fwd_kernel, hipFuncAttributeMaxDynamicSharedMemorySize, LDS_BYTES) != hipSuccess) { fprintf(stderr, "kernel_launch: hipFuncSetAttribute failed\n"); grid = -1; return; }
        if (hipOccupancyMaxActiveBlocksPerMultiprocessor(&per_cu, (const void*)fwd_kernel, NWAVES * 64, LDS_BYTES) != hipSuccess || per_cu < 1)
            fprintf(stderr, "kernel_launch: note: occupancy query reports %d workgroups per CU\n", per_cu);
        (void)hipGetLastError();
        grid = cus;
    }
    if (grid < 0) return;
    if (hipMemsetAsync((char*)d_ws + WS_CTL, 0, CTL_ZERO_BYTES, stream) != hipSuccess) { fprintf(stderr, "kernel_launch: hipMemsetAsync failed\n"); return; }
    Args a{};
    for (int i = 0; i < 19; ++i) a.in[i] = (const float*)d_in[i];
    a.out = (float*)d_out; a.ws = (unsigned char*)d_ws;
    for (int li = 0; li < N_LAUNCHES; ++li) {
        a.ph_lo = (N_LAUNCHES == PER_PHASE) ? li : 0; a.ph_hi = (N_LAUNCHES == PER_PHASE) ? li + 1 : PER_PHASE; a.li = li;
        hipLaunchKernelGGL(fwd_kernel, dim3(grid), dim3(NWAVES * 64), LDS_BYTES, stream, a);
        const hipError_t le = hipPeekAtLastError();
        if (le != hipSuccess) { fprintf(stderr, "kernel_launch: launch %d failed: %s\n", li, hipGetErrorName(le)); break; }
    }
}
```

```cpp
#include <hip/hip_runtime.h>
#include <cstdio>
#include <cstdint>

#ifndef MK_N_LAUNCHES
#define MK_N_LAUNCHES 1
#endif

#ifndef MOE_MERGED
#define MOE_MERGED 0
#endif
#ifndef RELAX_POST_EPI
#define RELAX_POST_EPI 0
#endif
#ifndef STAGGER_US
#define STAGGER_US 0
#endif
#ifndef P7_REVERSE
#define P7_REVERSE 0
#endif
#ifndef KEEP_WD
#define KEEP_WD 0
#endif
#ifndef P5_MFMA
#define P5_MFMA 1
#endif
#ifndef PF_P6
#define PF_P6 0
#endif
#ifndef PF_P7
#define PF_P7 0
#endif
#ifndef KV_PREFETCH
#define KV_PREFETCH 0
#endif
#ifndef FOLD_G
#define FOLD_G (P5_MFMA)
#endif
#ifndef FUSE_RES
#define FUSE_RES (P5_MFMA)
#endif
#ifndef FOLD_GMIX
#define FOLD_GMIX (P5_MFMA)
#endif
#ifndef CONV_INLINE
#define CONV_INLINE 1
#endif
#ifndef HALF_TAIL
#define HALF_TAIL 1
#endif
#ifndef DBG_TIME_PH
#define DBG_TIME_PH (-1)
#endif
#ifndef DBG_KLOOP_PH
#define DBG_KLOOP_PH (-1)
#endif
#ifndef DBG_RVR_PH
#define DBG_RVR_PH (-1)
#endif
namespace pg8 {
#define PG8_LAS __attribute__((address_space(3)))
typedef unsigned short bf16_t;
typedef short bf16x8 __attribute__((ext_vector_type(8)));
typedef float f32x4 __attribute__((ext_vector_type(4)));
typedef unsigned u32x4 __attribute__((ext_vector_type(4)));
typedef unsigned u32x2 __attribute__((ext_vector_type(2)));
constexpr int BM = 256, BK = 64, HALF = 128, HTB = HALF * BK * 2  , STAGE_BYTES = 8 * HTB, NXCD = 8;
constexpr int PFD = 6;
constexpr int PF_LDS_OFF = 150016 + 4096;
constexpr int BIAS_LDS_OFF = 150016;

__host__ __device__ __forceinline__ int lds_byte(int r, int c) { const int st = (r >> 4) * 2 + (c >> 5), rr = r & 15, cc = c & 31, ob = rr * 64 + cc * 2; return st * 1024 + (ob ^ (((ob >> 9) & 1) << 5)); }
__host__ __device__ __forceinline__ void stage_rc(int b, int& R, int& C) { const int st = b / 1024, sb = b % 1024, swz = sb ^ (((sb >> 9) & 1) << 5); R = (st >> 1) * 16 + swz / 64; C = (st & 1) * 32 + (swz % 64) / 2; }
__host__ __device__ __forceinline__ int perm32(int rho) { const int n = rho >> 4, i = rho & 15; return 8 * (i >> 2) + 4 * n + (i & 3); }

struct Unit { int pm, pn, e, aux; bool keep; const char* a; const char* b; int rofs; };

#ifndef WGM_DENSE
#define WGM_DENSE 4
#endif
#ifndef WGM_MOE
#define WGM_MOE 4
#endif
#ifndef WGM_MOE2
#define WGM_MOE2 4
#endif
__host__ __device__ __forceinline__ bool tile_of(long L, int nM, int nN, int& pm, int& pn, const int WGM = WGM_DENSE) {
    const int nwg = nM * nN; if (L >= nwg) return false;
    int wgid = (int)L; { const int q = nwg / NXCD, r = nwg % NXCD, xcd = wgid % NXCD, off = wgid / NXCD; wgid = (xcd < r ? xcd * (q + 1) : r * (q + 1) + (xcd - r) * q) + off; }
    const int nig = WGM * nN, gid = wgid / nig, fm = gid * WGM, gsz = (nM - fm) < WGM ? (nM - fm) : WGM;
    pm = fm + ((wgid % nig) % gsz); pn = (wgid % nig) / gsz; return true;
}

__device__ __forceinline__ unsigned cvt_pk_bf16(float lo, float hi) { unsigned r; asm volatile("v_cvt_pk_bf16_f32 %0, %1, %2" : "=v"(r) : "v"(lo), "v"(hi)); return r; }
__device__ __forceinline__ float bf_lo(unsigned w) { return __uint_as_float(w << 16); }
__device__ __forceinline__ float bf_hi(unsigned w) { return __uint_as_float(w & 0xffff0000u); }
__device__ __forceinline__ float sigmoidf_(float x) { return __builtin_amdgcn_rcpf(1.0f + __builtin_amdgcn_exp2f(x * -1.4426950408889634f)); }

template <class Epi, class Sched, bool ALIGN_EPI, bool GATHER, bool HALFM = false, bool PF = false>
__device__ __forceinline__ void gemm_phase(PG8_LAS unsigned char* lds, const int K, const Sched& S, const Epi& E, unsigned* dbg = nullptr) {
    const int tid = threadIdx.x, wid = __builtin_amdgcn_readfirstlane(tid >> 6), lane = tid & 63, wr = wid >> 2, wc = wid & 3, fr = lane & 15, fq = lane >> 4;
    const int nt = K / BK;
    unsigned voffA[2], voffB[2]; int RA[2]; unsigned CA2[2];
#pragma unroll
    for (int i = 0; i < 2; ++i) { int R, C; stage_rc(tid * 16 + i * 8192, R, C); const int Rb = Epi::PERM ? ((R & ~31) + perm32(R & 31)) : R;
        voffA[i] = (unsigned)(R * K + C) * 2u; voffB[i] = (unsigned)(Rb * K + C) * 2u; RA[i] = R; CA2[i] = (unsigned)C * 2u; }
    const size_t kstep = (size_t)(BK * 2);
    const size_t hstep = (size_t)HALF * K * 2;
    const unsigned ldsw = (unsigned)wid * 1024u;
    const int aoff = lds_byte(wr * 64 + fr, fq * 8), boff = lds_byte(wc * 32 + fr, fq * 8);
#define PG8_SA(b, h) (((b) * 2 + (h)) * HTB)
#define PG8_SB(b, h) ((4 + (b) * 2 + (h)) * HTB)
#define PG8_GLDS(src, dstoff) __builtin_amdgcn_global_load_lds((const unsigned*)(src), (PG8_LAS unsigned*)(lds + (dstoff)), 16, 0, 0)
#define PG8_STAGE_B(bufoff, gbase) do { PG8_GLDS((const char*)(gbase) + voffB[0], (bufoff) + ldsw); PG8_GLDS((const char*)(gbase) + voffB[1], (bufoff) + ldsw + 8192); } while (0)
#define PG8_STAGE_A(bufoff, gbase, h, o0, o1) do { \
        if constexpr (GATHER) { PG8_GLDS((const char*)(gbase) + (o0), (bufoff) + ldsw); PG8_GLDS((const char*)(gbase) + (o1), (bufoff) + ldsw + 8192); } \
        else { PG8_GLDS((const char*)(gbase) + (h) * hstep + voffA[0], (bufoff) + ldsw); PG8_GLDS((const char*)(gbase) + (h) * hstep + voffA[1], (bufoff) + ldsw + 8192); } } while (0)
#define PG8_LDA(dst, b, h) do { _Pragma("unroll") for (int m = 0; m < 4; ++m) _Pragma("unroll") for (int k = 0; k < 2; ++k) dst[m][k] = *(const PG8_LAS bf16x8*)(lds + PG8_SA(b, h) + aoff + m * 2048 + k * 1024); } while (0)
#define PG8_LDB(dst, b, h) do { _Pragma("unroll") for (int n = 0; n < 2; ++n) _Pragma("unroll") for (int k = 0; k < 2; ++k) dst[n][k] = *(const PG8_LAS bf16x8*)(lds + PG8_SB(b, h) + boff + n * 2048 + k * 1024); } while (0)
#define PG8_MMA(ai, bj, At, Bt) do { __builtin_amdgcn_s_setprio(1); _Pragma("unroll") for (int m = 0; m < 4; ++m) _Pragma("unroll") for (int n = 0; n < 2; ++n) _Pragma("unroll") for (int k = 0; k < 2; ++k) \
        acc[ai][bj][m][n] = __builtin_amdgcn_mfma_f32_16x16x32_bf16(Bt[n][k], At[m][k], acc[ai][bj][m][n], 0, 0, 0); __builtin_amdgcn_s_setprio(0); } while (0)
#define PG8_WAIT_V(n) asm volatile("s_waitcnt vmcnt(" #n ")" ::: "memory")
#define PG8_WAIT_VK do { if constexpr (PF) PG8_WAIT_V(9); else PG8_WAIT_V(8); } while (0)
#define PG8_WAIT_L(n) asm volatile("s_waitcnt lgkmcnt(" #n ")" ::: "memory")
#define PG8_BAR __builtin_amdgcn_s_barrier()
#define PG8_SCHED __builtin_amdgcn_sched_barrier(0)
#define PG8_BIAS_STAGE(u_, par_) do { const float* bp_ = wid < 4 ? E.bias_row(u_) : E.aux_row(u_); if (bp_ != nullptr) \
        __builtin_amdgcn_global_load_lds((const unsigned*)(bp_ + (wid & 3) * 64 + lane), (PG8_LAS unsigned*)(lds + BIAS_LDS_OFF + (par_) * 2048 + wid * 256), 4, 0, 0); } while (0)
    Unit cur, nxt, prv; int ui = 0; unsigned dbg_acc = 0;
    if (!S.next(0, cur)) return;
    prv = cur;
    f32x4 acc[2][2][4][2];
#pragma unroll
    for (int a = 0; a < 2; ++a)
#pragma unroll
        for (int b = 0; b < 2; ++b)
#pragma unroll
            for (int m = 0; m < 4; ++m)
#pragma unroll
                for (int n = 0; n < 2; ++n) acc[a][b][m][n] = (f32x4){0.f, 0.f, 0.f, 0.f};
    bf16x8 At[4][2], B0[2][2], B1[2][2];
    unsigned gA00 = 0, gA01 = 0, gA10 = 0, gA11 = 0, gN00 = 0, gN01 = 0, gN10 = 0, gN11 = 0;
    if constexpr (GATHER) { gA00 = S.tokoff(0, RA[0]) + CA2[0]; gA01 = S.tokoff(0, RA[1]) + CA2[1]; gA10 = S.tokoff(0, HALF + RA[0]) + CA2[0]; gA11 = S.tokoff(0, HALF + RA[1]) + CA2[1]; }
    const char* cA = cur.a; const char* cB = cur.b;
    const int pfrow = wid * 32 + (lane & 31);
#define PG8_PFPTR(u_, ui_) ((lane < 32) ? (u_).b + (size_t)pfrow * K * 2 : (GATHER ? (u_).a + S.tokoff((ui_), pfrow) : (u_).a + (size_t)pfrow * K * 2))
#define PG8_PF(kt_) do { if constexpr (PF) { const int k_ = (kt_); const char* p_ = k_ < nt ? pfc + (size_t)k_ * kstep : pfn + (size_t)(k_ - nt) * kstep; \
        __builtin_amdgcn_global_load_lds((const unsigned*)p_, (PG8_LAS unsigned*)(lds + PF_LDS_OFF + wid * 256), 4, 0, 0); } } while (0)
    const char* pfc = nullptr; const char* pfn = nullptr;
    if constexpr (PF) { pfc = PG8_PFPTR(cur, 0); pfn = pfc; }
    S.a_ready(cur);
    PG8_BIAS_STAGE(cur, 0);
    PG8_STAGE_B(PG8_SB(0, 0), cB); PG8_STAGE_B(PG8_SB(0, 1), cB + hstep); PG8_STAGE_A(PG8_SA(0, 0), cA, 0, gA00, gA01); PG8_STAGE_A(PG8_SA(0, 1), cA, 1, gA10, gA11);
    if (wr == 1) PG8_BAR;
    PG8_WAIT_V(2); PG8_BAR;
    PG8_STAGE_B(PG8_SB(1, 0), cB + kstep); PG8_STAGE_A(PG8_SA(1, 0), cA + kstep, 0, gA00, gA01); PG8_STAGE_B(PG8_SB(1, 1), cB + hstep + kstep);
    PG8_WAIT_V(6); PG8_BAR;
    PG8_PF(PFD);
    for (;;) {
        const bool has_next = S.next(ui + 1, nxt);
        if constexpr (GATHER) { if (has_next) { gN00 = S.tokoff(ui + 1, RA[0]) + CA2[0]; gN01 = S.tokoff(ui + 1, RA[1]) + CA2[1]; gN10 = S.tokoff(ui + 1, HALF + RA[0]) + CA2[0]; gN11 = S.tokoff(ui + 1, HALF + RA[1]) + CA2[1]; } }
        const char* nA = has_next ? nxt.a : cA; const char* nB = has_next ? nxt.b : cB;
        if constexpr (PF) { pfn = has_next ? PG8_PFPTR(nxt, ui + 1) : pfc; }
        unsigned dbg_t0 = 0; if (DBG_KLOOP_PH >= 0 && dbg) dbg_t0 = (unsigned)__builtin_amdgcn_s_memrealtime();
        for (int t = 0; t < nt; t += 2) {
            const bool last = (t == nt - 2);
            const char* a1 = cA + (size_t)(t + 1) * kstep;
            const char* a2 = last ? nA : cA + (size_t)(t + 2) * kstep; const char* b2 = last ? nB : cB + (size_t)(t + 2) * kstep;
            const char* a3 = a2 + kstep; const char* b3 = b2 + kstep;
            unsigned s00 = gA00, s01 = gA01, s10 = gA10, s11 = gA11;
            if constexpr (GATHER) { if (last && has_next) { s00 = gN00; s01 = gN01; s10 = gN10; s11 = gN11; } }
            if (last && has_next) S.a_ready(nxt);
            PG8_LDB(B0, 0, 0); PG8_LDB(B1, 0, 1); PG8_SCHED; PG8_LDA(At, 0, 0); PG8_STAGE_A(PG8_SA(1, 1), a1, 1, gA10, gA11);
            PG8_WAIT_VK; PG8_WAIT_L(0); PG8_BAR; PG8_MMA(0, 0, At, B0); PG8_MMA(0, 1, At, B1); PG8_BAR; PG8_SCHED;
            if constexpr (!HALFM) PG8_LDA(At, 0, 1);
            PG8_STAGE_B(PG8_SB(0, 0), b2); PG8_STAGE_B(PG8_SB(0, 1), b2 + hstep); PG8_STAGE_A(PG8_SA(0, 0), a2, 0, s00, s01); PG8_PF(t + 1 + PFD);
            PG8_WAIT_VK; PG8_WAIT_L(0); PG8_BAR; if constexpr (!HALFM) { PG8_MMA(1, 0, At, B0); PG8_MMA(1, 1, At, B1); } PG8_BAR; PG8_SCHED;
            PG8_LDB(B0, 1, 0); PG8_LDB(B1, 1, 1); PG8_SCHED; PG8_LDA(At, 1, 0); PG8_STAGE_A(PG8_SA(0, 1), a2, 1, s10, s11);
            PG8_WAIT_VK; PG8_WAIT_L(0); PG8_BAR; PG8_MMA(0, 0, At, B0); PG8_MMA(0, 1, At, B1); PG8_BAR; PG8_SCHED;
            if constexpr (!HALFM) PG8_LDA(At, 1, 1);
            PG8_STAGE_B(PG8_SB(1, 0), b3); PG8_STAGE_B(PG8_SB(1, 1), b3 + hstep); PG8_STAGE_A(PG8_SA(1, 0), a3, 0, s00, s01); PG8_PF(t + 2 + PFD);
            PG8_WAIT_VK; PG8_WAIT_L(0); PG8_BAR; if constexpr (!HALFM) { PG8_MMA(1, 0, At, B0); PG8_MMA(1, 1, At, B1); } PG8_BAR; PG8_SCHED;
        }
        if (DBG_KLOOP_PH >= 0 && dbg) { dbg_acc += (unsigned)__builtin_amdgcn_s_memrealtime() - dbg_t0; }
        if constexpr (ALIGN_EPI) { if (wr == 0) PG8_BAR; }
        if (MOE_MERGED && ui > 0) S.done(prv);
        E(acc, cur, wr, wc, fr, fq, (const PG8_LAS float*)(lds + BIAS_LDS_OFF + (ui & 1) * 2048));
        if (has_next) PG8_BIAS_STAGE(nxt, (ui + 1) & 1);
        if (MOE_MERGED) prv = cur;
        if (!has_next) break;
        if (!cur.keep) {
#pragma unroll
            for (int a = 0; a < 2; ++a)
#pragma unroll
                for (int b = 0; b < 2; ++b)
#pragma unroll
                    for (int m = 0; m < 4; ++m)
#pragma unroll
                        for (int n = 0; n < 2; ++n) acc[a][b][m][n] = (f32x4){0.f, 0.f, 0.f, 0.f};
        }
        cur = nxt; cA = nA; cB = nB; ++ui; if constexpr (PF) pfc = pfn;
        if constexpr (GATHER) { gA00 = gN00; gA01 = gN01; gA10 = gN10; gA11 = gN11; }
        if constexpr (ALIGN_EPI) { if (wr == 1) PG8_BAR; }
    }
    PG8_WAIT_V(0);
    if (DBG_KLOOP_PH >= 0 && dbg && threadIdx.x == 0) { dbg[0] = 0u; dbg[1] = dbg_acc; }
    if (MOE_MERGED) S.done(prv);
    if constexpr (!ALIGN_EPI) { if (wr == 0) PG8_BAR; }
    PG8_BAR;
#undef PG8_BIAS_STAGE
#undef PG8_PFPTR
#undef PG8_PF
#undef PG8_WAIT_VK
#undef PG8_SA
#undef PG8_SB
#undef PG8_GLDS
#undef PG8_STAGE_A
#undef PG8_STAGE_B
#undef PG8_LDA
#undef PG8_LDB
#undef PG8_MMA
#undef PG8_WAIT_V
#undef PG8_WAIT_L
#undef PG8_BAR
#undef PG8_SCHED
}
}

constexpr int NWAVES = 8;
constexpr int N_LAUNCHES = MK_N_LAUNCHES;
constexpr int PER_PHASE = 9;
constexpr int BATCH = 2, SEQ = 8192, D = 1024, M = BATCH * SEQ, HD = 64, NQH = 16, NKVH = 4, KVW = 256;
constexpr int NIN = 6656, NEXP = 32, TOPK = 4, DFF = 1024;
constexpr float RMS_EPS = 1e-5f;
constexpr float QSCALE = 0.125f * 1.4426950408889634f;
constexpr float LOG2E = 1.4426950408889634f;
constexpr int MAXTILES = 288;
constexpr int SLOTCAP = 16384;
constexpr int HELPER_CUS = 0;
constexpr int MAXU = 16;

constexpr size_t MiB = 1u << 20;
constexpr size_t WS_CTL = 0, CTL_ZERO_BYTES = MOE_MERGED ? 1 * MiB : 64 * 1024;
constexpr size_t WS_BINP = 1 * MiB;
constexpr size_t WS_BGU = 1 * MiB + 64 * 1024;
constexpr size_t WS_RSTD0 = 1 * MiB + 512 * 1024;
constexpr size_t WS_COS = 2 * MiB, WS_SIN = 3 * MiB;
constexpr size_t WS_WIN = 4 * MiB;
constexpr size_t WS_WAO = 17 * MiB, WS_WCO = 19 * MiB, WS_WOUT = 21 * MiB;
constexpr size_t WS_XN = 24 * MiB;
constexpr size_t WS_Q = 56 * MiB, WS_K = 88 * MiB, WS_V = 96 * MiB, WS_CB = 104 * MiB, WS_MG = 136 * MiB, WS_U = 168 * MiB, WS_SA = 200 * MiB, WS_SC = 232 * MiB;
constexpr size_t WS_WGU = 264 * MiB;
constexpr size_t WS_WD = 392 * MiB;
constexpr size_t WS_TOKREL = 456 * MiB;
constexpr size_t WS_ROUTE = 458 * MiB;
constexpr size_t WS_ROUTEW = 459 * MiB;
constexpr size_t WS_ACT = 56 * MiB;
constexpr size_t WS_Y = 200 * MiB;
constexpr size_t WS_RSTDREL = 460 * MiB;
constexpr size_t WS_DL = 464 * MiB;
constexpr size_t WS_END = 496 * MiB;
static_assert(WS_ACT + (size_t)MAXTILES * 256 * 2048 <= WS_Y && WS_Y + (size_t)MAXTILES * 256 * 2048 <= WS_WD, "MoE overlays");
constexpr int CW_TMO = 0;
constexpr int CW_TS = 512;
constexpr int CW_CURSOR = 1024;
constexpr int CW_BAR = 4096;
constexpr int CW_MT = 16384;
#define XCD_BAR_WORDS_C 3456
static_assert(CW_BAR + 3 * XCD_BAR_WORDS_C <= CW_MT && (CW_BAR + 3 * XCD_BAR_WORDS_C) * 4 <= 64 * 1024 && (!MOE_MERGED || (CW_MT + 64 * MAXTILES) * 4 <= (int)CTL_ZERO_BYTES), "CTL");

constexpr int RING_OFF = 0, RING_BYTES = 131072;
constexpr int LDSCTL_OFF = RING_BYTES, MISC_OFF = LDSCTL_OFF + 320;
constexpr int TAB_OFF = RING_BYTES + 512;
constexpr int TAB_CNT = TAB_OFF, TAB_TSTART = TAB_OFF + 128, TAB_TILEE = TAB_OFF + 128 + 160;
constexpr int TOK_OFF = TAB_OFF + 2048;
constexpr int BIAS_OFF = TOK_OFF + MAXU * 1024;
constexpr int LDS_BYTES = BIAS_OFF + 4096 + 2048;
static_assert(TAB_TILEE + 320 * 4 <= TOK_OFF && LDS_BYTES <= 163840 && BIAS_OFF == pg8::BIAS_LDS_OFF + RING_OFF, "LDS map");

#define GAS __attribute__((address_space(1)))
#define LAS __attribute__((address_space(3)))
typedef unsigned short bf16;
typedef unsigned v4u __attribute__((ext_vector_type(4)));
typedef unsigned v2u __attribute__((ext_vector_type(2)));
typedef float f32x4 __attribute__((ext_vector_type(4)));
typedef float f32x16 __attribute__((ext_vector_type(16)));
typedef float f32x2 __attribute__((ext_vector_type(2)));
typedef short bf16x8 __attribute__((ext_vector_type(8)));
typedef __bf16 bf16x2 __attribute__((ext_vector_type(2)));
typedef short s16x4 __attribute__((ext_vector_type(4)));
typedef GAS unsigned gu32;
#define RLX_AGENT __ATOMIC_RELAXED, __HIP_MEMORY_SCOPE_AGENT
#define LDS_WAIT() asm volatile("s_waitcnt lgkmcnt(0)" ::: "memory")
#define VM_WAIT() asm volatile("s_waitcnt vmcnt(0)" ::: "memory")
using pg8::cvt_pk_bf16; using pg8::bf_lo; using pg8::bf_hi;

#define XB_TMO      128
#define XB_XCNT(j)  (256  + 64 * (j))
#define XB_XSUB(j)  (1280 + 64 * (j))
#define XB_XGEN(j)  (2304 + 64 * (j))
#define XB_TOP      3328
#define XB_TOPGEN   3392
#define XCD_BAR_WORDS 3456
#define XB_SPIN_CAP (1u << 18)
static_assert(XCD_BAR_WORDS == XCD_BAR_WORDS_C, "bar words");

__device__ __forceinline__ unsigned xb_ld(unsigned* p)              { return __hip_atomic_load(p, __ATOMIC_RELAXED, __HIP_MEMORY_SCOPE_AGENT); }
__device__ __forceinline__ unsigned xb_add(unsigned* p, unsigned v) { return __hip_atomic_fetch_add(p, v, __ATOMIC_RELAXED, __HIP_MEMORY_SCOPE_AGENT); }
__device__ __forceinline__ unsigned xb_xcc_id() { return (unsigned)__builtin_amdgcn_s_getreg((3 << 11) | 20) & 0xFu; }
#define XB_SPIN(cond, bar) do { unsigned _sp = 0; while (cond) { __builtin_amdgcn_s_sleep(1); \
    if ((++_sp & 255u) == 0u) { if (xb_ld(&(bar)[XB_TMO])) break; if (_sp > XB_SPIN_CAP) { atomicAdd(&(bar)[XB_TMO], 1u); break; } } } } while (0)

struct XcdBarrier { unsigned* bar; unsigned x; volatile LAS unsigned* st; };

__device__ __forceinline__ XcdBarrier xcd_barrier_post(unsigned* bar, volatile LAS unsigned* st) {
    XcdBarrier b; b.bar = bar; b.x = xb_xcc_id(); b.st = st;
    if (threadIdx.x == 0) (void)xb_add(&bar[XB_XCNT(b.x)], 1u);
    return b;
}
__device__ __forceinline__ void xcd_barrier_complete(unsigned* bar, unsigned x, unsigned& nloc, unsigned& nx) {
    const unsigned G = gridDim.x * gridDim.y * gridDim.z;
    unsigned sum, cnt, mine, sp = 0u;
    for (;;) {
        sum = 0u; cnt = 0u; mine = 0u;
#pragma unroll
        for (unsigned j = 0; j < 16; ++j) { const unsigned c = xb_ld(&bar[XB_XCNT(j)]); sum += c; cnt += (c > 0u) ? 1u : 0u; mine = (j == x) ? c : mine; }
        if (sum == G) break;
        __builtin_amdgcn_s_sleep(1);
        if ((++sp & 255u) == 0u) { if (xb_ld(&bar[XB_TMO])) break; if (sp > XB_SPIN_CAP) { atomicAdd(&bar[XB_TMO], 1u); break; } }
    }
    nloc = mine > 0u ? mine : 1u; nx = cnt > 0u ? cnt : 1u;
}
__device__ __forceinline__ void xcd_barrier(const XcdBarrier& b) {
    asm volatile("s_waitcnt vmcnt(0)" ::: "memory");
    __syncthreads();
    if (threadIdx.x == 0) {
        unsigned* bar = b.bar;
        __builtin_amdgcn_s_waitcnt(0);
        unsigned nloc = b.st[0], nx = b.st[1];
        if (nloc == 0u) { xcd_barrier_complete(bar, b.x, nloc, nx); b.st[0] = nloc; b.st[1] = nx; }
        const unsigned old = xb_add(&bar[XB_XSUB(b.x)], 1u);
        const unsigned gen = old / nloc;
        if (old + 1u == (gen + 1u) * nloc) {
            __builtin_amdgcn_fence(__ATOMIC_RELEASE, "agent");
            asm volatile("s_waitcnt vmcnt(0)" ::: "memory");
            const unsigned og = xb_add(&bar[XB_TOP], 1u);
            const unsigned tg = og / nx;
            if (og + 1u == (tg + 1u) * nx) xb_add(&bar[XB_TOPGEN], 1u);
            else XB_SPIN(xb_ld(&bar[XB_TOPGEN]) == tg, bar);
            __builtin_amdgcn_fence(__ATOMIC_ACQUIRE, "agent");
            xb_add(&bar[XB_XGEN(b.x)], 1u);
            asm volatile("s_waitcnt vmcnt(0)" ::: "memory");
        } else {
            XB_SPIN(xb_ld(&bar[XB_XGEN(b.x)]) == gen, bar);
            __builtin_amdgcn_fence(__ATOMIC_ACQUIRE, "agent");
            asm volatile("s_waitcnt vmcnt(0)" ::: "memory");
        }
    }
    __syncthreads();
}

__device__ __forceinline__ float wave_sum(float v) {
#pragma unroll
    for (int o = 1; o < 64; o <<= 1) v += __shfl_xor(v, o);
    return v;
}
__device__ __forceinline__ float wave_max(float v) {
#pragma unroll
    for (int o = 1; o < 64; o <<= 1) v = fmaxf(v, __shfl_xor(v, o));
    return v;
}
__device__ __forceinline__ int wave_min_i(int v) {
#pragma unroll
    for (int o = 1; o < 64; o <<= 1) { const int w = __shfl_xor(v, o); v = w < v ? w : v; }
    return v;
}

template <int CTRL> __device__ __forceinline__ float dpp_f(float v) { return __builtin_bit_cast(float, __builtin_amdgcn_update_dpp(0, __builtin_bit_cast(int, v), CTRL, 0xF, 0xF, false)); }
__device__ __forceinline__ float rl_f(float v, int l) { return __builtin_bit_cast(float, __builtin_amdgcn_readlane(__builtin_bit_cast(int, v), l)); }
__device__ __forceinline__ float wave_sum_dpp(float v) { v += dpp_f<0xB1>(v); v += dpp_f<0x4E>(v); v += dpp_f<0x141>(v); v += dpp_f<0x140>(v); return (rl_f(v, 0) + rl_f(v, 16)) + (rl_f(v, 32) + rl_f(v, 48)); }
__device__ __forceinline__ float half_max_dpp(float v) { v = fmaxf(v, dpp_f<0xB1>(v)); v = fmaxf(v, dpp_f<0x4E>(v)); v = fmaxf(v, dpp_f<0x141>(v)); v = fmaxf(v, dpp_f<0x140>(v)); return fmaxf(rl_f(v, 0), rl_f(v, 16)); }

__device__ __forceinline__ int win_dest(int c) {
    if (c < 1280) { const int h = c >> 6, d = c & 63, s = d >> 5, i = d & 31; return (h << 6) + 8 * (i >> 2) + 4 * s + (i & 3); }
    if (c < 2560) return c;
    if (c < 3584) { const int i = c - 2560; return 2560 + (i >> 2) * 8 + (i & 3); }
    if (c < 4608) { const int i = c - 3584; return 2560 + (i >> 2) * 8 + 4 + (i & 3); }
    if (c < 5632) { const int i = c - 4608; return 4608 + (i >> 2) * 8 + (i & 3); }
    { const int i = c - 5632; return 4608 + (i >> 2) * 8 + 4 + (i & 3); }
}
__device__ __forceinline__ int map_dest(int mode, int n) {
    if (mode == 0) return n;
    if (mode == 1) return win_dest(n);
    if (mode == 2) return (n >> 2) * 8 + (n & 3);
    return (n >> 2) * 8 + 4 + (n & 3);
}

constexpr int NWAVES_C = 8;
struct CvtItem { const GAS float* W; GAS bf16* WT; int K, N, mode, k0, n0, keep; };
__device__ __forceinline__ void cvt_load(f32x4 (&v)[16], const CvtItem& it, int lane) {
    const GAS float* p = it.W + (size_t)(it.k0 + 4 * (lane >> 4)) * it.N + it.n0 + 4 * (lane & 15);
#pragma unroll
    for (int j = 0; j < 4; ++j)
#pragma unroll
        for (int r = 0; r < 4; ++r) v[j * 4 + r] = __builtin_nontemporal_load((const GAS f32x4*)(p + (size_t)(16 * j + r) * it.N));
}
__device__ __forceinline__ void cvt_store(const f32x4 (&v)[16], const CvtItem& it, LAS unsigned char* scr, int lane, const LAS float* gl) {
    const int kq = lane >> 4, nl = 4 * (lane & 15);
    const bool gs = (FOLD_G && it.mode >= 2) || (FOLD_GMIX && it.mode == 1);
    const int goff = it.mode == 1 ? 1024 : 0;
#pragma unroll
    for (int j = 0; j < 4; ++j) { f32x4 gk = *(const LAS f32x4*)(gl + goff + it.k0 + 16 * j + 4 * kq);
        if (!gs) gk = (f32x4){1.f, 1.f, 1.f, 1.f};
#pragma unroll
        for (int i = 0; i < 4; ++i) { v2u w; w.x = cvt_pk_bf16(v[j * 4 + 0][i] * gk[0], v[j * 4 + 1][i] * gk[1]); w.y = cvt_pk_bf16(v[j * 4 + 2][i] * gk[2], v[j * 4 + 3][i] * gk[3]);
            *(LAS v2u*)(scr + (nl + i) * 136 + (16 * j + 4 * kq) * 2) = w; } }
    LDS_WAIT(); asm volatile("" ::: "memory");
#pragma unroll
    for (int jj = 0; jj < 8; ++jj) { const int n = (lane >> 3) + 8 * jj, c = lane & 7;
        const v2u a = *(const LAS v2u*)(scr + n * 136 + c * 16), b = *(const LAS v2u*)(scr + n * 136 + c * 16 + 8);
        v4u o; o.x = a.x; o.y = a.y; o.z = b.x; o.w = b.y;
        GAS v4u* dp = (GAS v4u*)(it.WT + (size_t)map_dest(it.mode, it.n0 + n) * it.K + it.k0 + 8 * c);
        if (it.keep) *dp = o; else __builtin_nontemporal_store(o, dp); }
    LDS_WAIT(); asm volatile("" ::: "memory");
}
struct CvtSrc { const float* w_in; bf16* Win_t; const LAS unsigned long long* ptab; const LAS float* gl; };
constexpr int CVT_IN_ITEMS = (1024 / 64) * (6656 / 64);
constexpr int CVT_SQ_ITEMS = 256;
constexpr int CVT_REST_ITEMS = (3 + 32 * 3) * CVT_SQ_ITEMS;
#ifndef SLACK_CVT
#define SLACK_CVT 1
#endif
constexpr int SLACK_P1_ITEMS = SLACK_CVT ? 8192 : 0;
constexpr int SLACK_P6_ITEMS = SLACK_CVT ? 8192 : 0;

__device__ __forceinline__ CvtItem cvt_item_in(const CvtSrc& S, int id) { CvtItem it; it.keep = 0; it.W = (const GAS float*)S.w_in; it.WT = (GAS bf16*)S.Win_t; it.K = 1024; it.N = 6656; it.mode = 1; it.k0 = 64 * (id / 104); it.n0 = 64 * (id % 104); return it; }
__device__ __forceinline__ CvtItem cvt_item_rest(const CvtSrc& S, int id) {
    CvtItem it; it.keep = (KEEP_WD && (id >> 8) >= 67) ? 1 : 0; it.K = 1024; it.N = 1024; const int mat = id >> 8, r = id & 255; it.k0 = 64 * (r >> 4); it.n0 = 64 * (r & 15);
    int si = mat, e = 0, which = 2;
    if (mat >= 67) { e = mat - 67; which = 2; si = 5; }
    else if (mat >= 3) { const int q = mat - 3; e = q >> 1; which = q & 1; si = 3 + which; }
    const unsigned long long ps = S.ptab[si], pd = S.ptab[6 + si];
    const unsigned long long psu = ((unsigned long long)__builtin_amdgcn_readfirstlane((unsigned)(ps >> 32)) << 32) | (unsigned)__builtin_amdgcn_readfirstlane((unsigned)ps);
    const unsigned long long pdu = ((unsigned long long)__builtin_amdgcn_readfirstlane((unsigned)(pd >> 32)) << 32) | (unsigned)__builtin_amdgcn_readfirstlane((unsigned)pd);
    it.W = (const GAS float*)psu + (size_t)e * 1048576; it.WT = (GAS bf16*)pdu + (size_t)e * (which < 2 ? 2097152 : 1048576);
    it.mode = mat < 3 ? 0 : (which == 0 ? 2 : which == 1 ? 3 : 0);
    return it;
}
template <int SET> __device__ __forceinline__ void cvt_run(const CvtSrc& S, int first, int stride, int n_items, LAS unsigned char* scr, int lane, int base = 0) {
    f32x4 r0[16], r1[16]; CvtItem i0, i1;
    int id = first; if (id >= n_items) return;
    i0 = SET == 0 ? cvt_item_in(S, id) : cvt_item_rest(S, base + id); cvt_load(r0, i0, lane);
    for (;;) {
        const int idn = id + stride;
        if (idn >= n_items) { cvt_store(r0, i0, scr, lane, S.gl); break; }
        i1 = SET == 0 ? cvt_item_in(S, idn) : cvt_item_rest(S, base + idn); cvt_load(r1, i1, lane); cvt_store(r0, i0, scr, lane, S.gl);
        id = idn + stride;
        if (id >= n_items) { cvt_store(r1, i1, scr, lane, S.gl); break; }
        i0 = SET == 0 ? cvt_item_in(S, id) : cvt_item_rest(S, base + id); cvt_load(r0, i0, lane); cvt_store(r1, i1, scr, lane, S.gl);
    }
}

__device__ __forceinline__ void slack_convert(const CvtSrc& S, int U, int G, int c, int base, int n_items, LAS unsigned char* scr, int wave, int lane) {
    if (n_items <= 0) return;
    int rem = U % G; if (G - rem < G / 4) rem = 0;
    const int ncv = G - rem;
    if (c < rem) return;
    cvt_run<1>(S, (c - rem) * NWAVES_C + wave, ncv * NWAVES_C, n_items, scr, lane, base);
}

__device__ __forceinline__ void rms_row_to_bf16(const float* xrow, const float* g, bf16* orow, int lane) {
    const GAS f32x4* xr = (const GAS f32x4*)xrow + lane; const GAS f32x4* gr = (const GAS f32x4*)g + lane;
    f32x4 v[4]; float s = 0.f;
#pragma unroll
    for (int j = 0; j < 4; ++j) { v[j] = __builtin_nontemporal_load(xr + 64 * j); s += (v[j].x * v[j].x + v[j].y * v[j].y) + (v[j].z * v[j].z + v[j].w * v[j].w); }
    const float rstd = 1.f / sqrtf(wave_sum(s) * (1.f / D) + RMS_EPS);
    GAS v2u* o8 = (GAS v2u*)orow + lane;
#pragma unroll
    for (int j = 0; j < 4; ++j) { const f32x4 gg = gr[64 * j]; v2u w; w.x = cvt_pk_bf16(v[j].x * rstd * gg.x, v[j].y * rstd * gg.y); w.y = cvt_pk_bf16(v[j].z * rstd * gg.z, v[j].w * rstd * gg.w); o8[64 * j] = w; }
}

struct DenseOrder {
    int nM, nN, G, c, K; const char* A; const char* B;
    __device__ __forceinline__ bool next(int i, pg8::Unit& u) const {
        if (!pg8::tile_of((long)i * G + c, nM, nN, u.pm, u.pn)) return false;
        u.e = 0; u.aux = 1; u.keep = false; u.rofs = 0; u.a = A + (size_t)u.pm * 256 * K * 2; u.b = B + (size_t)u.pn * 256 * K * 2; return true; }
    __device__ __forceinline__ unsigned tokoff(int, int) const { return 0u; }
    __device__ __forceinline__ void a_ready(const pg8::Unit&) const {}
    __device__ __forceinline__ void done(const pg8::Unit&) const {}
};
struct MergeOrder {
    int nM, nN, G, c, K; const char* A0; const char* B0; const char* A1; const char* B1;
    __device__ __forceinline__ bool next(int i, pg8::Unit& u) const {
        if (!pg8::tile_of((long)(i >> 1) * G + c, nM, nN, u.pm, u.pn)) return false;
        const int br = i & 1; u.e = 0; u.aux = br; u.keep = (br == 0); u.rofs = 0;
        u.a = (br ? A1 : A0) + (size_t)u.pm * 256 * K * 2; u.b = (br ? B1 : B0) + (size_t)u.pn * 256 * K * 2; return true; }
    __device__ __forceinline__ unsigned tokoff(int, int) const { return 0u; }
    __device__ __forceinline__ void a_ready(const pg8::Unit&) const {}
    __device__ __forceinline__ void done(const pg8::Unit&) const {}
};
struct MoeOrder {
    int MT, G, c; const char* XNb; const char* ACTb; const char* Wgu; const char* Wd; const LAS int* tile_e; const LAS unsigned* tok; unsigned* ready; unsigned* tmo; int part; int ulim;
    __device__ __forceinline__ bool next(int i, pg8::Unit& u) const {
        const long U1 = (long)MT * 8; const long L = (long)i * G + c + (part == 2 ? U1 : 0);
        if (part == 1 && L >= U1) return false;
        if (part == 2 && L - U1 >= ulim) return false;
        if (L < U1) { pg8::tile_of(L, MT, 8, u.pm, u.pn, WGM_MOE); const int e = __builtin_amdgcn_readfirstlane(tile_e[u.pm]);
            u.e = e; u.aux = 2; u.keep = false; u.rofs = 0; u.a = XNb; u.b = Wgu + (size_t)e * (2048 * 1024 * 2) + (size_t)u.pn * (256 * 1024 * 2); return true; }
        if (!pg8::tile_of(L - U1, MT, 4, u.pm, u.pn, WGM_MOE2)) return false;
        if (P7_REVERSE && part == 2) u.pm = MT - 1 - u.pm;
        const int e = __builtin_amdgcn_readfirstlane(tile_e[u.pm]);
        u.e = e; u.aux = 3; u.keep = false; u.rofs = 0; u.a = ACTb + (size_t)u.pm * (256 * 1024 * 2); u.b = Wd + (size_t)e * (1024 * 1024 * 2) + (size_t)u.pn * (256 * 1024 * 2); return true; }
    __device__ __forceinline__ unsigned tokoff(int i, int row) const { return (part != 2 && (long)i * G + c < (long)MT * 8) ? tok[i * 256 + row] : (unsigned)row * 2048u; }
    __device__ __forceinline__ void a_ready(const pg8::Unit& u) const {
        if (u.aux != 3 || part != 0) return;
        if (threadIdx.x < 64) {
            const unsigned long long t0 = __builtin_amdgcn_s_memrealtime(); unsigned polls = 0;
            while ((unsigned)__builtin_amdgcn_readfirstlane(__hip_atomic_load(ready + 64 * u.pm, __ATOMIC_RELAXED, __HIP_MEMORY_SCOPE_AGENT)) < 64u) {
                if ((++polls & 255u) == 0u && __builtin_amdgcn_readfirstlane(__hip_atomic_load(tmo, __ATOMIC_RELAXED, __HIP_MEMORY_SCOPE_AGENT)) != 0u) break;
                if (__builtin_amdgcn_s_memrealtime() - t0 > 2000000ull) { if (threadIdx.x == 0) __hip_atomic_store(tmo, 1u, __ATOMIC_RELAXED, __HIP_MEMORY_SCOPE_AGENT); break; }
                __builtin_amdgcn_s_sleep(2); }
            __builtin_amdgcn_fence(__ATOMIC_ACQUIRE, "agent");
            asm volatile("s_waitcnt vmcnt(0)" ::: "memory");
        }
        asm volatile("" ::: "memory"); __builtin_amdgcn_s_barrier(); asm volatile("" ::: "memory");
    }
    __device__ __forceinline__ void done(const pg8::Unit& u) const {
        if (u.aux != 2 || part != 0) return;
        asm volatile("s_waitcnt vmcnt(0)" ::: "memory");
        if ((threadIdx.x & 63) == 0) __hip_atomic_fetch_add(ready + 64 * u.pm, 1u, __ATOMIC_RELAXED, __HIP_MEMORY_SCOPE_AGENT);
    }
};

struct TailOrder {
    int MT, ubase, c; const char* ACTb; const char* Wd; const LAS int* tile_e;
    __device__ __forceinline__ bool next(int i, pg8::Unit& u) const {
        if (i != 0 || !pg8::tile_of((long)ubase + (c >> 1), MT, 4, u.pm, u.pn, WGM_MOE2)) return false;
        const int e = __builtin_amdgcn_readfirstlane(tile_e[u.pm]);
        u.e = e; u.aux = 4; u.keep = false; u.rofs = 128 * (c & 1); u.a = ACTb + ((size_t)u.pm * 256 + 128 * (c & 1)) * (1024 * 2);     u.b = Wd + (size_t)e * (1024 * 1024 * 2) + (size_t)u.pn * (256 * 1024 * 2); return true; }
    __device__ __forceinline__ unsigned tokoff(int, int row) const { return (unsigned)(128 * (c & 1) + (row & 127)) * 2048u; }
    __device__ __forceinline__ void a_ready(const pg8::Unit&) const {}
    __device__ __forceinline__ void done(const pg8::Unit&) const {}
};

using pg8::f32x4; using pg8::Unit;
struct EpiInProj {
    static constexpr bool PERM = true;
    __device__ static __forceinline__ int nstores(const Unit&) { return 16; }
    bf16 *Q, *Kb, *Vb, *CB, *U, *SA, *SC; const float* bias; const float* cosT; const float* sinT; const float* rstd0;
    __device__ __forceinline__ const float* bias_row(const Unit& u) const { return bias + u.pn * 256; }
    __device__ __forceinline__ const float* aux_row(const Unit& u) const { return FOLD_GMIX ? rstd0 + u.pm * 256 : nullptr; }
    __device__ __forceinline__ void operator()(const f32x4 (&acc)[2][2][4][2], const Unit& u, int wr, int wc, int fr, int fq, const LAS float* bl) const {
        const int pn = u.pn, row0 = u.pm * 256 + wr * 64 + fr, cl0 = wc * 32 + 8 * fq;
        f32x4 bv[2][2];
#pragma unroll
        for (int bj = 0; bj < 2; ++bj)
#pragma unroll
            for (int n = 0; n < 2; ++n) bv[bj][n] = *(const LAS f32x4*)(bl + cl0 + bj * 128 + 4 * n);
        float rsv[2][4];
#pragma unroll
        for (int ai = 0; ai < 2; ++ai)
#pragma unroll
            for (int m = 0; m < 4; ++m) rsv[ai][m] = FOLD_GMIX ? bl[256 + wr * 64 + fr + ai * 128 + m * 16] : 1.0f;
        if (pn < 5) {
            bf16* base = pn < 4 ? Q : Kb; const int ld = pn < 4 ? 1024 : 256, colt = pn < 4 ? pn * 256 : 0; const float sc = pn < 4 ? QSCALE : 1.0f;
            const int i0 = 16 * (wc & 1) + 4 * fq;
#pragma unroll
            for (int ai = 0; ai < 2; ++ai)
#pragma unroll
                for (int m = 0; m < 4; ++m) { const int row = row0 + ai * 128 + m * 16, pos = row & (SEQ - 1);
                    const f32x4 c4 = *(const f32x4*)(cosT + pos * 32 + i0) * sc, s4 = *(const f32x4*)(sinT + pos * 32 + i0) * sc;
#pragma unroll
                    for (int bj = 0; bj < 2; ++bj) { const f32x4 t1 = acc[ai][bj][m][0] * rsv[ai][m] + bv[bj][0], t2 = acc[ai][bj][m][1] * rsv[ai][m] + bv[bj][1];
                        const f32x4 o1 = t1 * c4 - t2 * s4, o2 = t2 * c4 + t1 * s4;
                        v4u w; w.x = cvt_pk_bf16(o1[0], o1[1]); w.y = cvt_pk_bf16(o1[2], o1[3]); w.z = cvt_pk_bf16(o2[0], o2[1]); w.w = cvt_pk_bf16(o2[2], o2[3]);
                        *(v4u*)(base + (size_t)row * ld + colt + cl0 + bj * 128) = w; } }
        } else if (pn >= 10 && pn < 18) {
            const int colt = (pn - 10) * 128 + (cl0 >> 1);
#pragma unroll
            for (int ai = 0; ai < 2; ++ai)
#pragma unroll
                for (int m = 0; m < 4; ++m) { const int row = row0 + ai * 128 + m * 16;
#pragma unroll
                    for (int bj = 0; bj < 2; ++bj) { const f32x4 p = (acc[ai][bj][m][0] * rsv[ai][m] + bv[bj][0]) * (acc[ai][bj][m][1] * rsv[ai][m] + bv[bj][1]);
                        v2u w; w.x = cvt_pk_bf16(p[0], p[1]); w.y = cvt_pk_bf16(p[2], p[3]);
                        *(v2u*)(U + (size_t)row * 1024 + colt + bj * 64) = w; } }
        } else if (pn >= 18) {
            const int colt = (pn - 18) * 128 + (cl0 >> 1);
#pragma unroll
            for (int ai = 0; ai < 2; ++ai)
#pragma unroll
                for (int m = 0; m < 4; ++m) { const int row = row0 + ai * 128 + m * 16;
#pragma unroll
                    for (int bj = 0; bj < 2; ++bj) { const f32x4 a4 = acc[ai][bj][m][0] * rsv[ai][m] + bv[bj][0], c4 = acc[ai][bj][m][1] * rsv[ai][m] + bv[bj][1]; f32x4 r4, s4;
#pragma unroll
                        for (int q = 0; q < 4; ++q) { const float ea = __builtin_amdgcn_exp2f(a4[q] * -1.4426950408889634f), ec = __builtin_amdgcn_exp2f(c4[q] * -1.4426950408889634f);
                            s4[q] = fmaxf(__builtin_amdgcn_rcpf(1.0f + ec), 1e-20f); r4[q] = (1.0f + ec) * __builtin_amdgcn_rcpf(1.0f + ea); r4[q] = fminf(r4[q], 1e20f); }
                        v2u wr_, ws_; wr_.x = cvt_pk_bf16(r4[0], r4[1]); wr_.y = cvt_pk_bf16(r4[2], r4[3]); ws_.x = cvt_pk_bf16(s4[0], s4[1]); ws_.y = cvt_pk_bf16(s4[2], s4[3]);
                        *(v2u*)(SA + (size_t)row * 1024 + colt + bj * 64) = wr_; *(v2u*)(SC + (size_t)row * 1024 + colt + bj * 64) = ws_; } }
        } else {
            bf16* base; int ld = 1024, colt; const bool sg = false;
            if (pn == 5) { base = Vb; ld = 256; colt = 0; }
            else { base = CB; colt = (pn - 6) * 256; }
#pragma unroll
            for (int ai = 0; ai < 2; ++ai)
#pragma unroll
                for (int m = 0; m < 4; ++m) { const int row = row0 + ai * 128 + m * 16;
#pragma unroll
                    for (int bj = 0; bj < 2; ++bj) { f32x4 v0 = acc[ai][bj][m][0] * rsv[ai][m] + bv[bj][0], v1 = acc[ai][bj][m][1] * rsv[ai][m] + bv[bj][1];
                        if (sg) {
#pragma unroll
                            for (int q = 0; q < 4; ++q) { v0[q] = pg8::sigmoidf_(v0[q]); v1[q] = pg8::sigmoidf_(v1[q]); } }
                        v4u w; w.x = cvt_pk_bf16(v0[0], v0[1]); w.y = cvt_pk_bf16(v0[2], v0[3]); w.z = cvt_pk_bf16(v1[0], v1[1]); w.w = cvt_pk_bf16(v1[2], v1[3]);
                        *(v4u*)(base + (size_t)row * ld + colt + cl0 + bj * 128) = w; } }
        }
    }
};
struct EpiMerge {
    static constexpr bool PERM = true;
    __device__ static __forceinline__ int nstores(const Unit& u) { return u.aux == 0 ? 0 : 16; }
    const bf16 *SA, *SC; bf16* MG;
    __device__ __forceinline__ const float* bias_row(const Unit&) const { return nullptr; }
    __device__ __forceinline__ const float* aux_row(const Unit&) const { return nullptr; }
    __device__ __forceinline__ void operator()(f32x4 (&acc)[2][2][4][2], const Unit& u, int wr, int wc, int fr, int fq, const LAS float*) const {
        const int row0 = u.pm * 256 + wr * 64 + fr, col0 = u.pn * 256 + wc * 32 + 8 * fq;
        const bf16* G = u.aux == 0 ? SA : SC;
        v4u gv[2][4][2];
#pragma unroll
        for (int ai = 0; ai < 2; ++ai)
#pragma unroll
            for (int m = 0; m < 4; ++m)
#pragma unroll
                for (int bj = 0; bj < 2; ++bj) gv[ai][m][bj] = *(const v4u*)(G + (size_t)(row0 + ai * 128 + m * 16) * 1024 + col0 + bj * 128);
#pragma unroll
        for (int ai = 0; ai < 2; ++ai)
#pragma unroll
            for (int m = 0; m < 4; ++m)
#pragma unroll
                for (int bj = 0; bj < 2; ++bj) { const v4u c = gv[ai][m][bj];
                    const f32x4 c0 = {bf_lo(c.x), bf_hi(c.x), bf_lo(c.y), bf_hi(c.y)}, c1 = {bf_lo(c.z), bf_hi(c.z), bf_lo(c.w), bf_hi(c.w)};
                    const f32x4 v0 = acc[ai][bj][m][0] * c0, v1 = acc[ai][bj][m][1] * c1;
                    if (u.aux == 0) { acc[ai][bj][m][0] = v0; acc[ai][bj][m][1] = v1; }
                    else { v4u w; w.x = cvt_pk_bf16(v0[0], v0[1]); w.y = cvt_pk_bf16(v0[2], v0[3]); w.z = cvt_pk_bf16(v1[0], v1[1]); w.w = cvt_pk_bf16(v1[2], v1[3]);
                        *(v4u*)(MG + (size_t)(row0 + ai * 128 + m * 16) * 1024 + col0 + bj * 128) = w; } }
    }
};
struct EpiRes {
    static constexpr bool PERM = true;
    __device__ static __forceinline__ int nstores(const Unit&) { return 16; }
    bf16* DL;
    __device__ __forceinline__ const float* bias_row(const Unit&) const { return nullptr; }
    __device__ __forceinline__ const float* aux_row(const Unit&) const { return nullptr; }
    __device__ __forceinline__ void operator()(const f32x4 (&acc)[2][2][4][2], const Unit& u, int wr, int wc, int fr, int fq, const LAS float*) const {
        const int row0 = u.pm * 256 + wr * 64 + fr, col0 = u.pn * 256 + wc * 32 + 8 * fq;
        if (FUSE_RES) {
            v4u xv[2][4][2];
#pragma unroll
            for (int ai = 0; ai < 2; ++ai)
#pragma unroll
                for (int m = 0; m < 4; ++m)
#pragma unroll
                    for (int bj = 0; bj < 2; ++bj) xv[ai][m][bj] = *(const v4u*)(DL + (size_t)(row0 + ai * 128 + m * 16) * 1024 + col0 + bj * 128);
#pragma unroll
            for (int ai = 0; ai < 2; ++ai)
#pragma unroll
                for (int m = 0; m < 4; ++m)
#pragma unroll
                    for (int bj = 0; bj < 2; ++bj) { const v4u c = xv[ai][m][bj];
                        const f32x4 c0 = {bf_lo(c.x), bf_hi(c.x), bf_lo(c.y), bf_hi(c.y)}, c1 = {bf_lo(c.z), bf_hi(c.z), bf_lo(c.w), bf_hi(c.w)};
                        const f32x4 v0 = acc[ai][bj][m][0] + c0, v1 = acc[ai][bj][m][1] + c1;
                        v4u w; w.x = cvt_pk_bf16(v0[0], v0[1]); w.y = cvt_pk_bf16(v0[2], v0[3]); w.z = cvt_pk_bf16(v1[0], v1[1]); w.w = cvt_pk_bf16(v1[2], v1[3]);
                        *(v4u*)(DL + (size_t)(row0 + ai * 128 + m * 16) * 1024 + col0 + bj * 128) = w; }
            return;
        }
#pragma unroll
        for (int ai = 0; ai < 2; ++ai)
#pragma unroll
            for (int m = 0; m < 4; ++m) { bf16* rp = DL + (size_t)(row0 + ai * 128 + m * 16) * 1024 + col0;
#pragma unroll
                for (int bj = 0; bj < 2; ++bj) { const f32x4 v0 = acc[ai][bj][m][0], v1 = acc[ai][bj][m][1];
                    v4u w; w.x = cvt_pk_bf16(v0[0], v0[1]); w.y = cvt_pk_bf16(v0[2], v0[3]); w.z = cvt_pk_bf16(v1[0], v1[1]); w.w = cvt_pk_bf16(v1[2], v1[3]);
                    *(v4u*)(rp + bj * 128) = w; } }
    }
};
struct EpiGU {
    static constexpr bool PERM = true;
    __device__ static __forceinline__ int nstores(const Unit&) { return 16; }
    bf16* ACT; const float* bgu; const float* rstdrel; const LAS int* tst;
    __device__ __forceinline__ const float* bias_row(const Unit& u) const { return bgu + (size_t)u.e * 2048 + u.pn * 256; }
    __device__ __forceinline__ const float* aux_row(const Unit& u) const { return P5_MFMA ? rstdrel + (size_t)u.e * SLOTCAP + (u.pm - tst[u.e]) * 256 : nullptr; }
    __device__ __forceinline__ void operator()(const f32x4 (&acc)[2][2][4][2], const Unit& u, int wr, int wc, int fr, int fq, const LAS float* bl) const {
        const int row0 = u.pm * 256 + wr * 64 + fr, cl0 = u.pn * 256 + wc * 32 + 8 * fq;
        const LAS float* bb = bl + wc * 32 + 8 * fq;
        f32x4 bv[2][2];
#pragma unroll
        for (int bj = 0; bj < 2; ++bj)
#pragma unroll
            for (int n = 0; n < 2; ++n) bv[bj][n] = *(const LAS f32x4*)(bb + bj * 128 + 4 * n);
#pragma unroll
        for (int ai = 0; ai < 2; ++ai)
#pragma unroll
            for (int m = 0; m < 4; ++m) { bf16* rp = ACT + (size_t)(row0 + ai * 128 + m * 16) * 1024 + (cl0 >> 1);
                const float rs = P5_MFMA ? bl[256 + wr * 64 + fr + ai * 128 + m * 16] : 1.0f;
#pragma unroll
                for (int bj = 0; bj < 2; ++bj) { const f32x4 g4 = acc[ai][bj][m][0] * rs + bv[bj][0], u4 = acc[ai][bj][m][1] * rs + bv[bj][1]; f32x4 o;
#pragma unroll
                    for (int q = 0; q < 4; ++q) { const float g = __builtin_amdgcn_fmed3f(g4[q], -3.0e38f, 7.0f), uu = __builtin_amdgcn_fmed3f(u4[q], -7.0f, 7.0f);
                        o[q] = g * __builtin_amdgcn_rcpf(1.0f + __builtin_amdgcn_exp2f(g * -2.4554669595930157f)) * (uu + 1.0f); }
                    if (MOE_MERGED) { const unsigned long long w = (unsigned long long)cvt_pk_bf16(o[0], o[1]) | ((unsigned long long)cvt_pk_bf16(o[2], o[3]) << 32);
                        __hip_atomic_store((unsigned long long*)(rp + bj * 64), w, __ATOMIC_RELAXED, __HIP_MEMORY_SCOPE_AGENT); }
                    else { v2u w; w.x = cvt_pk_bf16(o[0], o[1]); w.y = cvt_pk_bf16(o[2], o[3]); *(v2u*)(rp + bj * 64) = w; } } }
    }
};
struct EpiDown {
    static constexpr bool PERM = true;
    __device__ static __forceinline__ int nstores(const Unit&) { return 16; }
    bf16* Y; const float* bd;
    __device__ __forceinline__ const float* bias_row(const Unit& u) const { return bd + (size_t)u.e * 1024 + u.pn * 256; }
    __device__ __forceinline__ const float* aux_row(const Unit&) const { return nullptr; }
    __device__ __forceinline__ void operator()(const f32x4 (&acc)[2][2][4][2], const Unit& u, int wr, int wc, int fr, int fq, const LAS float* bl) const {
        const int row0 = u.pm * 256 + wr * 64 + fr, cl0 = u.pn * 256 + wc * 32 + 8 * fq;
        const LAS float* bb = bl + wc * 32 + 8 * fq;
        f32x4 bv[2][2];
#pragma unroll
        for (int bj = 0; bj < 2; ++bj)
#pragma unroll
            for (int n = 0; n < 2; ++n) bv[bj][n] = *(const LAS f32x4*)(bb + bj * 128 + 4 * n);
#pragma unroll
        for (int ai = 0; ai < 2; ++ai)
#pragma unroll
            for (int m = 0; m < 4; ++m) { bf16* rp = Y + (size_t)(row0 + ai * 128 + m * 16) * 1024 + cl0;
#pragma unroll
                for (int bj = 0; bj < 2; ++bj) { const f32x4 v0 = acc[ai][bj][m][0] + bv[bj][0], v1 = acc[ai][bj][m][1] + bv[bj][1];
                    v4u w; w.x = cvt_pk_bf16(v0[0], v0[1]); w.y = cvt_pk_bf16(v0[2], v0[3]); w.z = cvt_pk_bf16(v1[0], v1[1]); w.w = cvt_pk_bf16(v1[2], v1[3]);
                    *(v4u*)(rp + bj * 128) = w; } }
    }
    __device__ __forceinline__ void half(const f32x4 (&acc)[2][2][4][2], const Unit& u, int wr, int wc, int fr, int fq, const LAS float* bl) const {
        const int row0 = u.pm * 256 + u.rofs + wr * 64 + fr, cl0 = u.pn * 256 + wc * 32 + 8 * fq;
        const LAS float* bb = bl + wc * 32 + 8 * fq;
        f32x4 bv[2][2];
#pragma unroll
        for (int bj = 0; bj < 2; ++bj)
#pragma unroll
            for (int n = 0; n < 2; ++n) bv[bj][n] = *(const LAS f32x4*)(bb + bj * 128 + 4 * n);
#pragma unroll
        for (int m = 0; m < 4; ++m) { bf16* rp = Y + (size_t)(row0 + m * 16) * 1024 + cl0;
#pragma unroll
            for (int bj = 0; bj < 2; ++bj) { const f32x4 v0 = acc[0][bj][m][0] + bv[bj][0], v1 = acc[0][bj][m][1] + bv[bj][1];
                v4u w; w.x = cvt_pk_bf16(v0[0], v0[1]); w.y = cvt_pk_bf16(v0[2], v0[3]); w.z = cvt_pk_bf16(v1[0], v1[1]); w.w = cvt_pk_bf16(v1[2], v1[3]);
                *(v4u*)(rp + bj * 128) = w; } }
    }
};
struct EpiDownX {
    static constexpr bool PERM = true;
    __device__ static __forceinline__ int nstores(const Unit&) { return 0; }
    EpiDown dn;
    __device__ __forceinline__ const float* bias_row(const Unit& u) const { return dn.bias_row(u); }
    __device__ __forceinline__ const float* aux_row(const Unit&) const { return nullptr; }
    __device__ __forceinline__ void operator()(const f32x4 (&acc)[2][2][4][2], const Unit& u, int wr, int wc, int fr, int fq, const LAS float* bl) const { if (u.aux == 4) dn.half(acc, u, wr, wc, fr, fq, bl); else dn(acc, u, wr, wc, fr, fq, bl); }
};
struct EpiMoe {
    static constexpr bool PERM = true;
    __device__ static __forceinline__ int nstores(const Unit&) { return MOE_MERGED ? 0 : 16; }
    EpiGU gu; EpiDown dn;
    __device__ __forceinline__ const float* bias_row(const Unit& u) const { return u.aux == 2 ? gu.bias_row(u) : dn.bias_row(u); }
    __device__ __forceinline__ const float* aux_row(const Unit& u) const { return u.aux == 2 ? gu.aux_row(u) : nullptr; }
    __device__ __forceinline__ void operator()(const f32x4 (&acc)[2][2][4][2], const Unit& u, int wr, int wc, int fr, int fq, const LAS float* bl) const { if (u.aux == 2) gu(acc, u, wr, wc, fr, fq, bl); else if (u.aux == 4) dn.half(acc, u, wr, wc, fr, fq, bl); else dn(acc, u, wr, wc, fr, fq, bl); }
};

namespace att {
constexpr int KS_STRIDE = 144, VT_STRIDE = 520;
constexpr int L_KS = 0, L_VT = 36864, L_ST = 70144, L_SC = 102912, L_END = 103936;
static_assert(L_VT == 256 * KS_STRIDE && L_ST == L_VT + 64 * VT_STRIDE && L_END <= RING_BYTES, "attention LDS map");
__device__ __forceinline__ int crow(int r, int hi) { return (r & 3) + 8 * (r >> 2) + 4 * hi; }

struct KVRegs { v4u k[4], v[4]; };
__device__ __forceinline__ void attn_load(KVRegs& R, int uu, const bf16* Kb, const bf16* Vb) {
    const int tid = threadIdx.x, n = uu & 63, kvh = (uu >> 6) & 3, b = uu >> 8, tokbase = b * SEQ, r0 = 128 * (n - 1);
#pragma unroll
    for (int it = 0; it < 4; ++it) { const int p = tid + 512 * it, row = p >> 3, ch = p & 7; int pos = r0 + row; pos = pos < 0 ? 0 : pos;
        R.k[it] = *(const v4u*)(Kb + (size_t)(tokbase + pos) * KVW + kvh * 64 + ch * 8); }
#pragma unroll
    for (int it = 0; it < 4; ++it) { const int p = tid + 512 * it, key = p & 255, c = p >> 8; int pos = r0 + key; pos = pos < 0 ? 0 : pos;
        R.v[it] = *(const v4u*)(Vb + (size_t)(tokbase + pos) * KVW + kvh * 64 + c * 8); }
}
__device__ __forceinline__ void attn_store(const KVRegs& R, LAS unsigned char* lds) {
    const int tid = threadIdx.x;
#pragma unroll
    for (int it = 0; it < 4; ++it) { const int p = tid + 512 * it, row = p >> 3, ch = p & 7; *(LAS v4u*)(lds + L_KS + row * KS_STRIDE + ch * 16) = R.k[it]; }
#pragma unroll
    for (int it = 0; it < 4; ++it) { const int p = tid + 512 * it, key = p & 255, c = p >> 8; const v4u v = R.v[it];
        LAS unsigned short* vt = (LAS unsigned short*)(lds + L_VT + (8 * c) * VT_STRIDE + key * 2);
        vt[0 * (VT_STRIDE / 2)] = (unsigned short)(v.x & 0xffffu); vt[1 * (VT_STRIDE / 2)] = (unsigned short)(v.x >> 16);
        vt[2 * (VT_STRIDE / 2)] = (unsigned short)(v.y & 0xffffu); vt[3 * (VT_STRIDE / 2)] = (unsigned short)(v.y >> 16);
        vt[4 * (VT_STRIDE / 2)] = (unsigned short)(v.z & 0xffffu); vt[5 * (VT_STRIDE / 2)] = (unsigned short)(v.z >> 16);
        vt[6 * (VT_STRIDE / 2)] = (unsigned short)(v.w & 0xffffu); vt[7 * (VT_STRIDE / 2)] = (unsigned short)(v.w >> 16); }
}
struct ConvCtx { const bf16* Ub; bf16* CB; const LAS float* w; int c0, row; bool on; v4u um2, um1; };
struct ConvB { v4u u[4], cb[4]; };
__device__ __forceinline__ void conv_issue(ConvB& B, const ConvCtx& C) {
#pragma unroll
    for (int r = 0; r < 4; ++r) { const size_t off = (size_t)(C.row + r) * 1024 + C.c0; B.u[r] = *(const v4u*)(C.Ub + off); B.cb[r] = *(const v4u*)(C.CB + off); }
}
__device__ __forceinline__ void conv_finish(const ConvB& B, ConvCtx& C) {
    float w0[8], w1[8], w2[8];
    { const f32x4 a0 = *(const LAS f32x4*)(C.w + C.c0), a1 = *(const LAS f32x4*)(C.w + C.c0 + 4), b0 = *(const LAS f32x4*)(C.w + 1024 + C.c0), b1 = *(const LAS f32x4*)(C.w + 1024 + C.c0 + 4),
                  c0_ = *(const LAS f32x4*)(C.w + 2048 + C.c0), c1_ = *(const LAS f32x4*)(C.w + 2048 + C.c0 + 4);
#pragma unroll
      for (int q = 0; q < 4; ++q) { w0[q] = a0[q]; w0[q + 4] = a1[q]; w1[q] = b0[q]; w1[q + 4] = b1[q]; w2[q] = c0_[q]; w2[q + 4] = c1_[q]; } }
#pragma unroll
    for (int r = 0; r < 4; ++r) { const v4u u0 = B.u[r], cb = B.cb[r], um2 = C.um2, um1 = C.um1; v4u o;
#define CONV2(F, qa) cvt_pk_bf16(bf_lo(cb.F) * (w0[qa] * bf_lo(um2.F) + w1[qa] * bf_lo(um1.F) + w2[qa] * bf_lo(u0.F)), bf_hi(cb.F) * (w0[qa + 1] * bf_hi(um2.F) + w1[qa + 1] * bf_hi(um1.F) + w2[qa + 1] * bf_hi(u0.F)))
        o.x = CONV2(x, 0); o.y = CONV2(y, 2); o.z = CONV2(z, 4); o.w = CONV2(w, 6);
#undef CONV2
        if (C.on) { *(v4u*)(C.CB + (size_t)(C.row + r) * 1024 + C.c0) = o; C.um2 = um1; C.um1 = u0; } }
    if (C.on) C.row += 4;
}
template <int SUB> __device__ __forceinline__ void attn_sub(LAS unsigned char* lds, int uu, int un, KVRegs& R, const bf16* Q, const bf16* Kb, const bf16* Vb, bf16* O, float sinkv, int hq, ConvCtx& CV) {
    const int tid = threadIdx.x, lane = tid & 63, r32 = lane & 31, hi = lane >> 5, wid = __builtin_amdgcn_readfirstlane(tid >> 6);
    const int n = uu & 63, b = uu >> 8, tokbase = b * SEQ;
    LAS float* scr = (LAS float*)(lds + L_SC + wid * 128);
    LAS unsigned short* stg = (LAS unsigned short*)(lds + L_ST + wid * 4096);
    {
        const int q0 = 64 * (wid & 1) + 32 * SUB, tb = q0 >> 5;
        const size_t qtok = (size_t)tokbase + 128 * n + q0;
        bf16x8 qf[4];
#pragma unroll
        for (int s = 0; s < 4; ++s) qf[s] = *(const bf16x8*)(Q + (qtok + r32) * 1024 + hq * 64 + 16 * s + 8 * hi);
        if constexpr (SUB == 0) { if (KV_PREFETCH) attn_load(R, un, Kb, Vb); }
        ConvB CBt; conv_issue(CBt, CV);
        f32x16 sc[5];
#pragma unroll
        for (int i = 0; i < 5; ++i) { f32x16 a = {};
#pragma unroll
            for (int s = 0; s < 4; ++s) { const bf16x8 kf = *(const LAS bf16x8*)(lds + L_KS + (32 * (tb + i) + r32) * KS_STRIDE + (16 * s + 8 * hi) * 2);
                a = __builtin_amdgcn_mfma_f32_32x32x16_bf16(kf, qf[s], a, 0, 0, 0); }
            sc[i] = a; }
#pragma unroll
        for (int r = 0; r < 16; ++r) { const int kl = crow(r, hi);
            if (!(kl > r32)) sc[0][r] = -INFINITY;
            if (!(kl <= r32)) sc[4][r] = -INFINITY; }
        if (n == 0) {
#pragma unroll
            for (int i = 0; i < 4; ++i) if (tb + i < 4) {
#pragma unroll
                for (int r = 0; r < 16; ++r) sc[i][r] = -INFINITY; } }
        float mx = sinkv;
#pragma unroll
        for (int i = 0; i < 5; ++i)
#pragma unroll
            for (int r = 0; r < 16; ++r) mx = fmaxf(mx, sc[i][r]);
        mx = fmaxf(mx, __shfl_xor(mx, 32));
        float sum = 0.f;
#pragma unroll
        for (int i = 0; i < 5; ++i)
#pragma unroll
            for (int r = 0; r < 16; ++r) { const float p = __builtin_amdgcn_exp2f(sc[i][r] - mx); sc[i][r] = p; sum += p; }
        sum += __shfl_xor(sum, 32);
        const float denom = sum + __builtin_amdgcn_exp2f(sinkv - mx);
        if (hi == 0) scr[r32] = __builtin_amdgcn_rcpf(denom);
        f32x16 o[2]; o[0] = f32x16{}; o[1] = f32x16{};
#pragma unroll
        for (int i = 0; i < 5; ++i)
#pragma unroll
            for (int s2 = 0; s2 < 2; ++s2) {
                v4u pw; pw.x = cvt_pk_bf16(sc[i][8 * s2 + 0], sc[i][8 * s2 + 1]); pw.y = cvt_pk_bf16(sc[i][8 * s2 + 2], sc[i][8 * s2 + 3]);
                pw.z = cvt_pk_bf16(sc[i][8 * s2 + 4], sc[i][8 * s2 + 5]); pw.w = cvt_pk_bf16(sc[i][8 * s2 + 6], sc[i][8 * s2 + 7]);
                const bf16x8 pa = __builtin_bit_cast(bf16x8, pw);
                const int key0 = 32 * (tb + i) + 16 * s2 + 4 * hi;
#pragma unroll
                for (int dh = 0; dh < 2; ++dh) { const LAS unsigned char* vp = lds + L_VT + (32 * dh + r32) * VT_STRIDE + key0 * 2;
                    const s16x4 lo = *(const LAS s16x4*)vp, h4 = *(const LAS s16x4*)(vp + 16);
                    const bf16x8 vb = {lo[0], lo[1], lo[2], lo[3], h4[0], h4[1], h4[2], h4[3]};
                    o[dh] = __builtin_amdgcn_mfma_f32_32x32x16_bf16(pa, vb, o[dh], 0, 0, 0); } }
#pragma unroll
        for (int r = 0; r < 16; ++r) { const int orow = crow(r, hi); const float rl = scr[orow];
#pragma unroll
            for (int dh = 0; dh < 2; ++dh) stg[orow * 64 + dh * 32 + r32] = (unsigned short)(cvt_pk_bf16(o[dh][r] * rl, 0.f) & 0xffffu); }
        bf16* Ow = O + qtok * 1024 + hq * 64;
#pragma unroll
        for (int i = 0; i < 4; ++i) { const int row = i * 8 + (lane >> 3), ch = lane & 7; const v4u v = *(const LAS v4u*)(stg + row * 64 + ch * 8); *(v4u*)(Ow + (size_t)row * 1024 + ch * 8) = v; }
        conv_finish(CBt, CV);
    }
}
__device__ __forceinline__ void attn_compute(LAS unsigned char* lds, int uu, int un, KVRegs& R, const bf16* Q, const bf16* Kb, const bf16* Vb, bf16* O, const float* sinks, ConvCtx& CV) {
    const int wid = __builtin_amdgcn_readfirstlane(threadIdx.x >> 6), kvh = (uu >> 6) & 3, hq = 4 * kvh + (wid >> 1);
    const float sinkv = sinks[hq] * LOG2E;
    attn_sub<0>(lds, uu, un, R, Q, Kb, Vb, O, sinkv, hq, CV);
    attn_sub<1>(lds, uu, un, R, Q, Kb, Vb, O, sinkv, hq, CV);
    __syncthreads();
}
}

struct Args { const float* in[19]; float* out; unsigned char* ws; int ph_lo, ph_hi, li, pad; };

__global__ void __launch_bounds__(NWAVES * 64, 2) fwd_kernel(Args args) {
    extern __shared__ __attribute__((aligned(16))) unsigned char lds_raw[];
    LAS unsigned char* lds = (LAS unsigned char*)lds_raw;
    volatile LAS unsigned* MISC = (volatile LAS unsigned*)(lds + MISC_OFF);
    const int tid = threadIdx.x, lane = tid & 63, wave = __builtin_amdgcn_readfirstlane(tid >> 6);
    const int G = gridDim.x; const int bx = blockIdx.x; const int vcu = (G % 8 == 0) ? (bx % 8) * (G / 8) + bx / 8 : bx;
    unsigned char* ws = args.ws;
    gu32* ctl = (gu32*)(ws + WS_CTL);
    const float* x = args.in[0]; const float* g_mix = args.in[1]; const float* w_in = args.in[2]; const float* b_in = args.in[3]; const float* sinks = args.in[4];
    const float* w_conv = args.in[5]; const float* w_attn_o = args.in[6]; const float* w_conv_o = args.in[7]; const float* w_out = args.in[8]; const float* g_ffn = args.in[9];
    const float* w_router = args.in[10]; const float* b_router = args.in[11]; const float* w_gate = args.in[12]; const float* b_gate = args.in[13]; const float* w_up = args.in[14];
    const float* b_up = args.in[15]; const float* w_down = args.in[16]; const float* b_down = args.in[17]; const float* g_final = args.in[18];
    float* out = args.out;
    float* rstd0 = (float*)(ws + WS_RSTD0); float* binp = (float*)(ws + WS_BINP); float* bgu = (float*)(ws + WS_BGU); float* cosT = (float*)(ws + WS_COS); float* sinT = (float*)(ws + WS_SIN);
    bf16* Win_t = (bf16*)(ws + WS_WIN); bf16* Wao_t = (bf16*)(ws + WS_WAO); bf16* Wco_t = (bf16*)(ws + WS_WCO); bf16* Wout_t = (bf16*)(ws + WS_WOUT);
    bf16* XN = (bf16*)(ws + WS_XN); bf16* Qb = (bf16*)(ws + WS_Q); bf16* Kb = (bf16*)(ws + WS_K); bf16* Vb = (bf16*)(ws + WS_V); bf16* CB = (bf16*)(ws + WS_CB);
    bf16* MG = (bf16*)(ws + WS_MG); bf16* Ub = (bf16*)(ws + WS_U); bf16* SA = (bf16*)(ws + WS_SA); bf16* SC = (bf16*)(ws + WS_SC);
    bf16* Wgu_t = (bf16*)(ws + WS_WGU); bf16* Wd_t = (bf16*)(ws + WS_WD);
    int* tokrel = (int*)(ws + WS_TOKREL); float* rstdrel = (float*)(ws + WS_RSTDREL); unsigned* route = (unsigned*)(ws + WS_ROUTE); float* routew = (float*)(ws + WS_ROUTEW);
    bf16* ACT = (bf16*)(ws + WS_ACT); bf16* Yb = (bf16*)(ws + WS_Y); bf16* DLb = (bf16*)(ws + WS_DL);

    for (int u = tid; u < (LDS_BYTES - LDSCTL_OFF) / 4; u += NWAVES * 64) ((LAS unsigned*)(lds + LDSCTL_OFF))[u] = 0u;
    __syncthreads();
    XcdBarrier bar; bar.bar = (unsigned*)(ctl + CW_BAR); bar.x = 0; bar.st = nullptr;
    if (N_LAUNCHES != PER_PHASE) bar = xcd_barrier_post((unsigned*)(ctl + CW_BAR), MISC + 8);
#define GRID_BAR(seam) do { if (N_LAUNCHES == PER_PHASE) { if (tid == 0) __hip_atomic_store(ctl + CW_TMO, 0xBADBA0u | (unsigned)(seam), RLX_AGENT); } else { xcd_barrier(bar); } } while (0)
    const int lo = args.ph_lo, hi = args.ph_hi;
#define IN(k) (lo <= (k) && (k) < hi)
#define BOTH(k) (IN(k) && IN((k) + 1))
    const int gw = vcu * NWAVES + wave, NGW = G * NWAVES;
#define STAMP(k) do { if ((DBG_TIME_PH >= 0 || DBG_RVR_PH >= 0) && (k) < 16 && bx == 0 && tid == 0) __hip_atomic_store(ctl + CW_TS + (k), (unsigned)__builtin_amdgcn_s_memrealtime(), RLX_AGENT); } while (0)
    STAMP(0);

    LAS unsigned long long* ptab = (LAS unsigned long long*)(lds + TAB_OFF + 1600);
    if (tid == 0) { ptab[0] = (unsigned long long)w_attn_o; ptab[1] = (unsigned long long)w_conv_o; ptab[2] = (unsigned long long)w_out; ptab[3] = (unsigned long long)w_gate; ptab[4] = (unsigned long long)w_up; ptab[5] = (unsigned long long)w_down;
        ptab[6] = (unsigned long long)Wao_t; ptab[7] = (unsigned long long)Wco_t; ptab[8] = (unsigned long long)Wout_t; ptab[9] = (unsigned long long)Wgu_t; ptab[10] = (unsigned long long)Wgu_t; ptab[11] = (unsigned long long)Wd_t; }
    __syncthreads();
    LAS float* gffl = (LAS float*)(lds + RING_OFF + 69632);
    const CvtSrc CS{w_in, Win_t, ptab, gffl};
    const int HELP = (HELPER_CUS > 0 && G == 256 && N_LAUNCHES == 1) ? HELPER_CUS : 0;
    if (IN(0)) {
        LAS unsigned char* scr = lds + RING_OFF + wave * 8704;
        for (int i = tid; i < 512; i += 512) *(LAS f32x4*)(gffl + 4 * i) = i < 256 ? *(const f32x4*)(g_ffn + 4 * i) : *(const f32x4*)(g_mix + 4 * (i - 256));
        __syncthreads();
        cvt_run<0>(CS, gw, NGW, CVT_IN_ITEMS, scr, lane);
        if (HELP == 0) cvt_run<1>(CS, gw, NGW, CVT_REST_ITEMS - SLACK_P1_ITEMS - SLACK_P6_ITEMS, scr, lane);
        const int gt = vcu * (NWAVES * 64) + tid, NGT = G * NWAVES * 64;
        for (int c = gt; c < NIN; c += NGT) binp[win_dest(c)] = b_in[c];
        for (int i = gt; i < NEXP * DFF; i += NGT) { const int e = i >> 10, c = i & 1023; bgu[e * 2048 + map_dest(2, c)] = b_gate[i]; bgu[e * 2048 + map_dest(3, c)] = b_up[i]; }
        for (int i = gt; i < SEQ * 32; i += NGT) { const int pos = i >> 5, f = i & 31;
            const double inv = exp2(-(double)f * (13.287712379549449 / 32.0));
            const double rev = (double)pos * inv * 0.15915494309189535; const float fr = (float)(rev - rint(rev));
            cosT[i] = __builtin_amdgcn_cosf(fr); sinT[i] = __builtin_amdgcn_sinf(fr); }
        if (FOLD_GMIX) { for (int m = gw; m < M; m += NGW) { const GAS f32x4* xr = (const GAS f32x4*)(x + (size_t)m * D) + lane; f32x4 v[4]; float s_ = 0.f;
#pragma unroll
                for (int j = 0; j < 4; ++j) { v[j] = __builtin_nontemporal_load(xr + 64 * j); s_ += (v[j].x * v[j].x + v[j].y * v[j].y) + (v[j].z * v[j].z + v[j].w * v[j].w); }
                GAS v2u* o8 = (GAS v2u*)(XN + (size_t)m * D) + lane;
#pragma unroll
                for (int j = 0; j < 4; ++j) { v2u w; w.x = cvt_pk_bf16(v[j].x, v[j].y); w.y = cvt_pk_bf16(v[j].z, v[j].w); o8[64 * j] = w; }
                const float rs_ = 1.f / sqrtf(wave_sum(s_) * (1.f / D) + RMS_EPS); if (lane == 0) rstd0[m] = rs_; } }
        else for (int m = gw; m < M; m += NGW) rms_row_to_bf16(x + (size_t)m * D, g_mix, XN + (size_t)m * D, lane);
        if (BOTH(0)) GRID_BAR(0); STAMP(1);
    }

#define STAGGER(S_, total_units) do { if (STAGGER_US > 0) { int nu_ = 0; pg8::Unit u_; while (S_.next(nu_, u_)) ++nu_; const int mx_ = ((total_units) + G - 1) / G; \
        if (nu_ < mx_) { const unsigned long long t0_ = __builtin_amdgcn_s_memrealtime(); while (__builtin_amdgcn_s_memrealtime() - t0_ < (unsigned long long)(STAGGER_US * 100)) __builtin_amdgcn_s_sleep(16); } } } while (0)
    if (IN(1)) {
        if (bx < G - HELP) {
            DenseOrder S{M / 256, NIN / 256, G - HELP, bx, D, (const char*)XN, (const char*)Win_t};
            EpiInProj E{Qb, Kb, Vb, CB, Ub, SA, SC, binp, cosT, sinT, rstd0};
            if (HELP == 0) STAGGER(S, (M / 256) * (NIN / 256));
            for (int i = tid; i < 512; i += 512) *(LAS f32x4*)(gffl + 4 * i) = i < 256 ? *(const f32x4*)(g_ffn + 4 * i) : *(const f32x4*)(g_mix + 4 * (i - 256));
            __syncthreads();
            if (HELP == 0) slack_convert(CS, (M / 256) * (NIN / 256), G, bx, CVT_REST_ITEMS - SLACK_P1_ITEMS - SLACK_P6_ITEMS, SLACK_P1_ITEMS, lds + RING_OFF + wave * 8704, wave, lane);
            __syncthreads();
            pg8::gemm_phase<EpiInProj, DenseOrder, true, false>(lds + RING_OFF, D, S, E, (DBG_KLOOP_PH == 1 && bx == 0) ? (unsigned*)(ctl + CW_TS + 16) : nullptr);
        } else {
            cvt_run<1>(CS, (bx - (G - HELP)) * NWAVES + wave, HELP * NWAVES, CVT_REST_ITEMS, lds + RING_OFF + wave * 8704, lane);
        }
        if (BOTH(1)) GRID_BAR(1); STAMP(2);
    }

    if (IN(2)) {
        const bool cinl = CONV_INLINE && G == 256 && BATCH * NKVH * (SEQ / 128) == 512;
        { constexpr int NU = BATCH * NKVH * (SEQ / 128); att::KVRegs R; int uu = vcu;
            LAS float* wcl = (LAS float*)(lds + RING_OFF + 104448);
            for (int i = tid; i < 768; i += 512) *(LAS f32x4*)(wcl + 4 * i) = *(const f32x4*)(w_conv + 4 * i);
            __syncthreads();
            att::ConvCtx CV; CV.Ub = Ub; CV.CB = CB; CV.w = wcl; CV.c0 = (tid & 127) * 8; CV.row = (cinl ? vcu : 0) * 64 + (tid >> 7) * 16; CV.on = cinl; CV.um2 = (v4u){0u, 0u, 0u, 0u}; CV.um1 = (v4u){0u, 0u, 0u, 0u};
            if (cinl && (CV.row & (SEQ - 1)) >= 2) { CV.um2 = *(const v4u*)(Ub + (size_t)(CV.row - 2) * 1024 + CV.c0); CV.um1 = *(const v4u*)(Ub + (size_t)(CV.row - 1) * 1024 + CV.c0); }
            if (KV_PREFETCH && uu < NU) att::attn_load(R, uu, Kb, Vb);
            while (uu < NU) { if (!KV_PREFETCH) att::attn_load(R, uu, Kb, Vb); att::attn_store(R, lds + RING_OFF); __syncthreads(); const int un = uu + G < NU ? uu + G : uu;
                att::attn_compute(lds + RING_OFF, uu, un, R, Qb, Kb, Vb, Qb, sinks, CV); uu += G; } }
        if (!cinl)
        for (int ch = vcu; ch < M / 64; ch += G) {
            const int c0 = (tid & 127) * 8, row0 = ch * 64 + (tid >> 7) * 16, pos0 = row0 & (SEQ - 1);
            float w0[8], w1[8], w2[8];
#pragma unroll
            for (int q = 0; q < 8; ++q) { w0[q] = w_conv[c0 + q]; w1[q] = w_conv[1024 + c0 + q]; w2[q] = w_conv[2048 + c0 + q]; }
            v4u um2 = {0u, 0u, 0u, 0u}, um1 = {0u, 0u, 0u, 0u};
            if (pos0 >= 2) { um2 = *(const v4u*)(Ub + (size_t)(row0 - 2) * 1024 + c0); um1 = *(const v4u*)(Ub + (size_t)(row0 - 1) * 1024 + c0); }
#pragma unroll 4
            for (int r = 0; r < 16; ++r) { const size_t off = (size_t)(row0 + r) * 1024 + c0;
                const v4u u0 = *(const v4u*)(Ub + off), cb = *(const v4u*)(CB + off); v4u o;
#define CONV2(F, qa) cvt_pk_bf16(bf_lo(cb.F) * (w0[qa] * bf_lo(um2.F) + w1[qa] * bf_lo(um1.F) + w2[qa] * bf_lo(u0.F)), bf_hi(cb.F) * (w0[qa + 1] * bf_hi(um2.F) + w1[qa + 1] * bf_hi(um1.F) + w2[qa + 1] * bf_hi(u0.F)))
                o.x = CONV2(x, 0); o.y = CONV2(y, 2); o.z = CONV2(z, 4); o.w = CONV2(w, 6);
#undef CONV2
                *(v4u*)(CB + off) = o; um2 = um1; um1 = u0; }
        }
        if (BOTH(2)) GRID_BAR(2); STAMP(3);
    }

    if (IN(3)) {
        MergeOrder S{M / 256, D / 256, G, bx, D, (const char*)Qb, (const char*)Wao_t, (const char*)CB, (const char*)Wco_t};
        EpiMerge E{SA, SC, MG};
        pg8::gemm_phase<EpiMerge, MergeOrder, true, false>(lds + RING_OFF, D, S, E, (DBG_KLOOP_PH == 3 && bx == 0) ? (unsigned*)(ctl + CW_TS + 16) : nullptr);
        if (BOTH(3)) GRID_BAR(3); STAMP(4);
    }

    if (IN(4)) {
        DenseOrder S{M / 256, D / 256, G, bx, D, (const char*)MG, (const char*)Wout_t};
        EpiRes E{FUSE_RES ? XN : DLb};
        pg8::gemm_phase<EpiRes, DenseOrder, false, false>(lds + RING_OFF, D, S, E, (DBG_KLOOP_PH == 4 && bx == 0) ? (unsigned*)(ctl + CW_TS + 16) : nullptr);
        if (BOTH(4)) GRID_BAR(4); STAMP(5);
    }

#if P5_MFMA
    if (IN(5)) {
        LAS float* GL = (LAS float*)(lds + RING_OFF);
#define P5_BL_LDS (FOLD_GMIX && FOLD_G && !FUSE_RES)
        LAS float* PL = (LAS float*)(lds + RING_OFF + (P5_BL_LDS ? 65536 : 4096));
        LAS float* PS = P5_BL_LDS ? (LAS float*)(lds + TOK_OFF + 8192) : (LAS float*)(lds + RING_OFF + 4096 + 65536);
        LAS unsigned char* BLs = lds + RING_OFF + wave * 8192 + lane * 16;
        LAS int* lcnt = (LAS int*)(lds + TOK_OFF); LAS int* lbase = lcnt + 32; LAS unsigned* ce = (LAS unsigned*)(lds + TOK_OFF + 256); LAS int* cr = (LAS int*)(lds + TOK_OFF + 256 + 1024); LAS float* cw = (LAS float*)(lds + TOK_OFF + 256 + 2048);
        LAS float* crs = (LAS float*)(lds + TOK_OFF + 256 + 3072);
        for (int i = tid; i < 256; i += 512) *(LAS f32x4*)(GL + 4 * i) = *(const f32x4*)(g_ffn + 4 * i);
        __syncthreads();
        const int r32 = lane & 31, kh = lane >> 5, kb = 128 * wave;
        const float brt = b_router[r32];
        bf16x8 Bh[8], Bl[8];
#pragma unroll
        for (int f = 0; f < 8; ++f) { const int k0 = kb + 32 * (f >> 1) + 16 * kh + 8 * (f & 1);
            const f32x4 g0 = *(const LAS f32x4*)(GL + k0), g1 = *(const LAS f32x4*)(GL + k0 + 4);
            float wv[8];
#pragma unroll
            for (int j = 0; j < 8; ++j) wv[j] = w_router[(size_t)(k0 + j) * 32 + r32] * (j < 4 ? g0[j] : g1[j - 4]);
            v4u hw, lw;
#define SPLIT2(dsth, dstl, a_, b_) do { const unsigned h_ = cvt_pk_bf16(a_, b_); dsth = h_; dstl = cvt_pk_bf16((a_) - bf_lo(h_), (b_) - bf_hi(h_)); } while (0)
            SPLIT2(hw.x, lw.x, wv[0], wv[1]); SPLIT2(hw.y, lw.y, wv[2], wv[3]); SPLIT2(hw.z, lw.z, wv[4], wv[5]); SPLIT2(hw.w, lw.w, wv[6], wv[7]);
            Bh[f] = __builtin_bit_cast(bf16x8, hw); Bl[f] = __builtin_bit_cast(bf16x8, lw); }
        if (P5_BL_LDS) { __syncthreads();
#pragma unroll
            for (int f = 0; f < 8; ++f) *(LAS bf16x8*)(BLs + f * 1024) = Bl[f]; }
#define P5_BLF(f_) (P5_BL_LDS ? *(const LAS bf16x8*)(BLs + (f_) * 1024) : Bl[f_])
        for (int ch = vcu; ch < M / 64; ch += G) {
            if (tid < 32) lcnt[tid] = 0;
            f32x16 acc[2]; acc[0] = f32x16{}; acc[1] = f32x16{}; float ss[2] = {0.f, 0.f};
            if (FUSE_RES) {
                v4u xr[2][4][2];
#pragma unroll
                for (int mt = 0; mt < 2; ++mt)
#pragma unroll
                    for (int S = 0; S < 4; ++S)
#pragma unroll
                        for (int q = 0; q < 2; ++q) xr[mt][S][q] = *(const v4u*)(XN + (size_t)(ch * 64 + 32 * mt + r32) * D + kb + 16 * kh + 32 * S + 8 * q);
#pragma unroll
                for (int mt = 0; mt < 2; ++mt)
#pragma unroll
                    for (int S = 0; S < 4; ++S)
#pragma unroll
                        for (int q = 0; q < 2; ++q) { const v4u r = xr[mt][S][q]; const bf16x8 Ah = __builtin_bit_cast(bf16x8, r);
                            acc[mt] = __builtin_amdgcn_mfma_f32_32x32x16_bf16(Ah, Bh[2 * S + q], acc[mt], 0, 0, 0);
                            acc[mt] = __builtin_amdgcn_mfma_f32_32x32x16_bf16(Ah, P5_BLF(2 * S + q), acc[mt], 0, 0, 0);
                            float s_ = ss[mt];
                            s_ = __builtin_amdgcn_fdot2_f32_bf16(__builtin_bit_cast(bf16x2, r.x), __builtin_bit_cast(bf16x2, r.x), s_, false); s_ = __builtin_amdgcn_fdot2_f32_bf16(__builtin_bit_cast(bf16x2, r.y), __builtin_bit_cast(bf16x2, r.y), s_, false);
                            s_ = __builtin_amdgcn_fdot2_f32_bf16(__builtin_bit_cast(bf16x2, r.z), __builtin_bit_cast(bf16x2, r.z), s_, false); s_ = __builtin_amdgcn_fdot2_f32_bf16(__builtin_bit_cast(bf16x2, r.w), __builtin_bit_cast(bf16x2, r.w), s_, false);
                            ss[mt] = s_; }
            } else
#define P5M_LOADG(XQ, DQ, mt_, sp_) do { const size_t ro_ = (size_t)(ch * 64 + 32 * (mt_) + r32) * D + kb + 16 * kh + 64 * (sp_); \
                _Pragma("unroll") for (int S_ = 0; S_ < 2; ++S_) { \
                    if (FOLD_GMIX) { XQ##r[S_][0] = *(const v4u*)(XN + ro_ + 32 * S_); XQ##r[S_][1] = *(const v4u*)(XN + ro_ + 32 * S_ + 8); }     \
                    else { _Pragma("unroll") for (int q = 0; q < 4; ++q) XQ[S_][q] = *(const f32x4*)(x + ro_ + 32 * S_ + 4 * q); } \
                    DQ[S_][0] = *(const v4u*)(DLb + ro_ + 32 * S_); DQ[S_][1] = *(const v4u*)(DLb + ro_ + 32 * S_ + 8); } } while (0)
#define P5M_PROC(XQ, DQ, mt_, sp_) do { const size_t ro_ = (size_t)(ch * 64 + 32 * (mt_) + r32) * D + kb + 16 * kh + 64 * (sp_); \
                _Pragma("unroll") for (int S_ = 0; S_ < 2; ++S_) { const int S = 2 * (sp_) + S_; float x1[16]; \
                    if (FOLD_GMIX) { _Pragma("unroll") for (int h = 0; h < 2; ++h) { const v4u b_ = XQ##r[S_][h]; \
                            x1[8 * h + 0] = bf_lo(b_.x); x1[8 * h + 1] = bf_hi(b_.x); x1[8 * h + 2] = bf_lo(b_.y); x1[8 * h + 3] = bf_hi(b_.y); x1[8 * h + 4] = bf_lo(b_.z); x1[8 * h + 5] = bf_hi(b_.z); x1[8 * h + 6] = bf_lo(b_.w); x1[8 * h + 7] = bf_hi(b_.w); } } \
                    else { _Pragma("unroll") for (int q = 0; q < 4; ++q) { x1[4 * q] = XQ[S_][q].x; x1[4 * q + 1] = XQ[S_][q].y; x1[4 * q + 2] = XQ[S_][q].z; x1[4 * q + 3] = XQ[S_][q].w; } } \
                    _Pragma("unroll") for (int h = 0; h < 2; ++h) { const v4u d = DQ[S_][h]; \
                        x1[8 * h + 0] += bf_lo(d.x); x1[8 * h + 1] += bf_hi(d.x); x1[8 * h + 2] += bf_lo(d.y); x1[8 * h + 3] += bf_hi(d.y); \
                        x1[8 * h + 4] += bf_lo(d.z); x1[8 * h + 5] += bf_hi(d.z); x1[8 * h + 6] += bf_lo(d.w); x1[8 * h + 7] += bf_hi(d.w); } \
                    float s_ = 0.f; \
                    _Pragma("unroll") for (int j = 0; j < 16; ++j) s_ += x1[j] * x1[j]; \
                    ss[mt_] += s_; \
                    const int kk = kb + 32 * S + 16 * kh; v4u o0, o1; \
                    { const f32x4 g0 = *(const LAS f32x4*)(GL + kk), g1 = *(const LAS f32x4*)(GL + kk + 4), g2 = *(const LAS f32x4*)(GL + kk + 8), g3 = *(const LAS f32x4*)(GL + kk + 12); \
                      if (FOLD_G) { o0.x = cvt_pk_bf16(x1[0], x1[1]); o0.y = cvt_pk_bf16(x1[2], x1[3]); o0.z = cvt_pk_bf16(x1[4], x1[5]); o0.w = cvt_pk_bf16(x1[6], x1[7]); \
                                    o1.x = cvt_pk_bf16(x1[8], x1[9]); o1.y = cvt_pk_bf16(x1[10], x1[11]); o1.z = cvt_pk_bf16(x1[12], x1[13]); o1.w = cvt_pk_bf16(x1[14], x1[15]); } else { \
                      o0.x = cvt_pk_bf16(x1[0] * g0.x, x1[1] * g0.y); o0.y = cvt_pk_bf16(x1[2] * g0.z, x1[3] * g0.w); o0.z = cvt_pk_bf16(x1[4] * g1.x, x1[5] * g1.y); o0.w = cvt_pk_bf16(x1[6] * g1.z, x1[7] * g1.w); \
                      o1.x = cvt_pk_bf16(x1[8] * g2.x, x1[9] * g2.y); o1.y = cvt_pk_bf16(x1[10] * g2.z, x1[11] * g2.w); o1.z = cvt_pk_bf16(x1[12] * g3.x, x1[13] * g3.y); o1.w = cvt_pk_bf16(x1[14] * g3.z, x1[15] * g3.w); } } \
                    *(v4u*)(XN + ro_ + 32 * S_) = o0; *(v4u*)(XN + ro_ + 32 * S_ + 8) = o1; \
                    _Pragma("unroll") for (int q = 0; q < 2; ++q) { v4u hw, lw; \
                        SPLIT2(hw.x, lw.x, x1[8 * q + 0], x1[8 * q + 1]); SPLIT2(hw.y, lw.y, x1[8 * q + 2], x1[8 * q + 3]); SPLIT2(hw.z, lw.z, x1[8 * q + 4], x1[8 * q + 5]); SPLIT2(hw.w, lw.w, x1[8 * q + 6], x1[8 * q + 7]); \
                        const bf16x8 Ah = __builtin_bit_cast(bf16x8, hw), Al = __builtin_bit_cast(bf16x8, lw); \
                        acc[mt_] = __builtin_amdgcn_mfma_f32_32x32x16_bf16(Ah, Bh[2 * S + q], acc[mt_], 0, 0, 0); \
                        acc[mt_] = __builtin_amdgcn_mfma_f32_32x32x16_bf16(Al, Bh[2 * S + q], acc[mt_], 0, 0, 0); \
                        acc[mt_] = __builtin_amdgcn_mfma_f32_32x32x16_bf16(Ah, P5_BLF(2 * S + q), acc[mt_], 0, 0, 0); } } } while (0)
            { f32x4 xa_[2][4], xb_[2][4]; v4u xa_r[2][2], xb_r[2][2]; v4u da_[2][2], db_[2][2];
#define SB_ __builtin_amdgcn_sched_barrier(0)
              P5M_LOADG(xa_, da_, 0, 0); P5M_LOADG(xb_, db_, 0, 1); SB_;
              P5M_PROC(xa_, da_, 0, 0); SB_; P5M_LOADG(xa_, da_, 1, 0); SB_;
              P5M_PROC(xb_, db_, 0, 1); SB_; P5M_LOADG(xb_, db_, 1, 1); SB_;
              P5M_PROC(xa_, da_, 1, 0); SB_; P5M_PROC(xb_, db_, 1, 1); }
#undef SB_
#undef P5_BLF
#undef P5M_LOADG
#undef P5M_PROC
#undef SPLIT2
#pragma unroll
            for (int mt = 0; mt < 2; ++mt) { const float st = ss[mt] + __shfl_xor(ss[mt], 32); if (kh == 0) PS[wave * 64 + 32 * mt + r32] = st;
#pragma unroll
                for (int r = 0; r < 16; ++r) PL[(wave * 64 + 32 * mt + ((r & 3) + 8 * (r >> 2) + 4 * kh)) * 32 + r32] = acc[mt][r]; }
            __syncthreads();
#define P5_ROWPOST(lgin, tl_) do { float lg = lgin; int te[4]; float tlg[4]; \
                _Pragma("unroll") for (int k = 0; k < 4; ++k) { const float mx = half_max_dpp(lg); const unsigned long long bm = __ballot(lg == mx); const int sel = __builtin_ctzll(bm); te[k] = sel; tlg[k] = mx; if ((lane & 31) == sel) lg = -INFINITY; } \
                const float e1 = __expf(tlg[1] - tlg[0]), e2 = __expf(tlg[2] - tlg[0]), e3 = __expf(tlg[3] - tlg[0]), inv = 1.0f / (1.0f + e1 + e2 + e3); \
                if (lane < 4) { const int ek = lane == 0 ? te[0] : lane == 1 ? te[1] : lane == 2 ? te[2] : te[3]; const float wk = (lane == 0 ? 1.0f : lane == 1 ? e1 : lane == 2 ? e2 : e3) * inv; \
                    const int r = atomicAdd((int*)(lcnt + ek), 1); ce[(tl_) * 4 + lane] = (unsigned)ek; cr[(tl_) * 4 + lane] = r; cw[(tl_) * 4 + lane] = wk; } } while (0)
#pragma unroll 1
            for (int rr = 0; rr < 8; ++rr) { const int tl = wave * 8 + rr; float lgs = 0.f, sq = 0.f;
#pragma unroll
                for (int w2 = 0; w2 < 8; ++w2) { lgs += PL[(w2 * 64 + tl) * 32 + r32]; sq += PS[w2 * 64 + tl]; }
                const float rstd = 1.f / sqrtf(sq * (1.f / D) + RMS_EPS);
                if (lane == 0) crs[tl] = rstd;
                P5_ROWPOST(lgs * rstd + brt, tl); }
#undef P5_ROWPOST
            __syncthreads();
            if (tid < 32) lbase[tid] = (int)__hip_atomic_fetch_add(ctl + CW_CURSOR + 64 * tid, (unsigned)lcnt[tid], RLX_AGENT);
            __syncthreads();
            if (tid < 256) { const int t = ch * 64 + (tid >> 2); const unsigned e = ce[tid]; const int rel = lbase[e] + cr[tid];
                tokrel[e * SLOTCAP + rel] = t; rstdrel[e * SLOTCAP + rel] = crs[tid >> 2]; route[t * 4 + (tid & 3)] = e | ((unsigned)rel << 8); routew[t * 4 + (tid & 3)] = cw[tid]; }
            __syncthreads();
        }
        if (BOTH(5)) GRID_BAR(5); STAMP(6);
    }
#else
    if (IN(5)) {
        LAS float* wT = (LAS float*)(lds + RING_OFF);
        { f32x4 wv[16];
#pragma unroll
          for (int k = 0; k < 16; ++k) { const int idx = tid + 512 * k, c = idx & 1023, e4 = idx >> 10; wv[k] = *(const f32x4*)(w_router + (size_t)c * 32 + e4 * 4); }
#pragma unroll
          for (int k = 0; k < 16; ++k) { const int idx = tid + 512 * k, c = idx & 1023, e4 = idx >> 10;
            wT[(e4 * 4 + 0) * 1024 + c] = wv[k].x; wT[(e4 * 4 + 1) * 1024 + c] = wv[k].y; wT[(e4 * 4 + 2) * 1024 + c] = wv[k].z; wT[(e4 * 4 + 3) * 1024 + c] = wv[k].w; } }
        LAS int* lcnt = (LAS int*)(lds + TOK_OFF); LAS int* lbase = lcnt + 32; LAS unsigned* ce = (LAS unsigned*)(lds + TOK_OFF + 256); LAS int* cr = (LAS int*)(lds + TOK_OFF + 256 + 1024); LAS float* cw = (LAS float*)(lds + TOK_OFF + 256 + 2048);
        const int psrc = 4 * ((lane & 48) | ((lane & 1) << 3) | ((lane & 2) << 1) | ((lane & 4) >> 1) | ((lane & 8) >> 3));
        const float brt = b_router[lane & 31];
        f32x4 gf[4];
#pragma unroll
        for (int j = 0; j < 4; ++j) gf[j] = *(const f32x4*)(g_ffn + 4 * lane + 256 * j);
        for (int ch = vcu; ch < M / 64; ch += G) {
            if (tid < 32) lcnt[tid] = 0;
            __syncthreads();
#define P5_LOADROW(dst, dd, t_) _Pragma("unroll") for (int j = 0; j < 4; ++j) { dst[j] = *(const f32x4*)(x + (size_t)(t_) * D + 4 * lane + 256 * j); dd[j] = *(const v2u*)(DLb + (size_t)(t_) * D + 4 * lane + 256 * j); }
#define P5_ADDD(dst, dd) _Pragma("unroll") for (int j = 0; j < 4; ++j) { dst[j].x += bf_lo(dd[j].x); dst[j].y += bf_hi(dd[j].x); dst[j].z += bf_lo(dd[j].y); dst[j].w += bf_hi(dd[j].y); }
#define P5_BFLY(v, NV, MK) _Pragma("unroll") for (int i = 0; i < NV; ++i) { const bool up = (lane & MK) != 0; const float send = up ? v[i] : v[i + NV], keep = up ? v[i + NV] : v[i]; v[i] = keep + __shfl_xor(send, MK); }
#define P5_ROWPOST(lgin, tl_) do { float lg = __builtin_bit_cast(float, __builtin_amdgcn_ds_bpermute(psrc, __builtin_bit_cast(int, lgin))) + brt; int te[4]; float tlg[4];     \
                _Pragma("unroll") for (int k = 0; k < 4; ++k) { const float mx = half_max_dpp(lg); const unsigned long long bm = __ballot(lg == mx); const int sel = __builtin_ctzll(bm); te[k] = sel; tlg[k] = mx; if ((lane & 31) == sel) lg = -INFINITY; } \
                const float e1 = __expf(tlg[1] - tlg[0]), e2 = __expf(tlg[2] - tlg[0]), e3 = __expf(tlg[3] - tlg[0]), inv = 1.0f / (1.0f + e1 + e2 + e3); \
                if (lane < 4) { const int ek = lane == 0 ? te[0] : lane == 1 ? te[1] : lane == 2 ? te[2] : te[3]; const float wk = (lane == 0 ? 1.0f : lane == 1 ? e1 : lane == 2 ? e2 : e3) * inv; \
                    const int r = atomicAdd((int*)(lcnt + ek), 1); ce[(tl_) * 4 + lane] = (unsigned)ek; cr[(tl_) * 4 + lane] = r; cw[(tl_) * 4 + lane] = wk; } } while (0)
            f32x4 xa[4], xb[4]; v2u da[4], db[4];
            P5_LOADROW(xa, da, ch * 64 + wave * 8); P5_LOADROW(xb, db, ch * 64 + wave * 8 + 1);
#pragma unroll 1
            for (int pp = 0; pp < 4; ++pp) {
                const int tl = wave * 8 + 2 * pp, t = ch * 64 + tl, tn = pp < 3 ? t + 2 : t;
                f32x4 na[4], nb[4]; v2u nda[4], ndb[4];
                P5_LOADROW(na, nda, tn); P5_LOADROW(nb, ndb, tn + 1);
                P5_ADDD(xa, da); P5_ADDD(xb, db);
                float sa = 0.f, sb = 0.f;
#pragma unroll
                for (int j = 0; j < 4; ++j) { sa += (xa[j].x * xa[j].x + xa[j].y * xa[j].y) + (xa[j].z * xa[j].z + xa[j].w * xa[j].w); sb += (xb[j].x * xb[j].x + xb[j].y * xb[j].y) + (xb[j].z * xb[j].z + xb[j].w * xb[j].w); }
                const float rstda = 1.f / sqrtf(wave_sum_dpp(sa) * (1.f / D) + RMS_EPS), rstdb = 1.f / sqrtf(wave_sum_dpp(sb) * (1.f / D) + RMS_EPS);
#pragma unroll
                for (int j = 0; j < 4; ++j) { xa[j] = xa[j] * rstda * gf[j]; xb[j] = xb[j] * rstdb * gf[j];
                    v2u w; w.x = cvt_pk_bf16(xa[j].x, xa[j].y); w.y = cvt_pk_bf16(xa[j].z, xa[j].w); *(v2u*)(XN + (size_t)t * D + 4 * lane + 256 * j) = w;
                    v2u w2; w2.x = cvt_pk_bf16(xb[j].x, xb[j].y); w2.y = cvt_pk_bf16(xb[j].z, xb[j].w); *(v2u*)(XN + (size_t)(t + 1) * D + 4 * lane + 256 * j) = w2; }
                f32x2 x2[4][4];
#pragma unroll
                for (int j = 0; j < 4; ++j) { x2[j][0] = (f32x2){xa[j].x, xb[j].x}; x2[j][1] = (f32x2){xa[j].y, xb[j].y}; x2[j][2] = (f32x2){xa[j].z, xb[j].z}; x2[j][3] = (f32x2){xa[j].w, xb[j].w}; }
                float lga, lgb;
                { float h0a, h0b, h1a, h1b;
#define P5_HALF(E0, ra, rb) do { float va[16], vb[16]; \
                    _Pragma("unroll") for (int e = 0; e < 16; ++e) { f32x2 a2 = {0.f, 0.f}, c2 = {0.f, 0.f};     \
                        _Pragma("unroll") for (int j = 0; j < 4; ++j) { const f32x4 w4 = *(const LAS f32x4*)(wT + ((E0) + e) * 1024 + 4 * lane + 256 * j); \
                            a2 += x2[j][0] * (f32x2){w4.x, w4.x}; c2 += x2[j][1] * (f32x2){w4.y, w4.y}; a2 += x2[j][2] * (f32x2){w4.z, w4.z}; c2 += x2[j][3] * (f32x2){w4.w, w4.w}; } \
                        a2 += c2; va[e] = a2.x; vb[e] = a2.y; } \
                    P5_BFLY(va, 8, 1) P5_BFLY(va, 4, 2) P5_BFLY(va, 2, 4) P5_BFLY(va, 1, 8) P5_BFLY(vb, 8, 1) P5_BFLY(vb, 4, 2) P5_BFLY(vb, 2, 4) P5_BFLY(vb, 1, 8) \
                    float ta = va[0] + __shfl_xor(va[0], 16), tb = vb[0] + __shfl_xor(vb[0], 16); ra = ta + __shfl_xor(ta, 32); rb = tb + __shfl_xor(tb, 32); } while (0)
                  P5_HALF(0, h0a, h0b); __builtin_amdgcn_sched_barrier(0); P5_HALF(16, h1a, h1b); __builtin_amdgcn_sched_barrier(0);
#undef P5_HALF
                  lga = (lane & 16) ? h1a : h0a; lgb = (lane & 16) ? h1b : h0b; }
                P5_ROWPOST(lga, tl); __builtin_amdgcn_sched_barrier(0); P5_ROWPOST(lgb, tl + 1);
#pragma unroll
                for (int j = 0; j < 4; ++j) { xa[j] = na[j]; xb[j] = nb[j]; da[j] = nda[j]; db[j] = ndb[j]; }
            }
#undef P5_LOADROW
#undef P5_ADDD
#undef P5_BFLY
#undef P5_ROWPOST
            __syncthreads();
            if (tid < 32) lbase[tid] = (int)__hip_atomic_fetch_add(ctl + CW_CURSOR + 64 * tid, (unsigned)lcnt[tid], RLX_AGENT);
            __syncthreads();
            if (tid < 256) { const int t = ch * 64 + (tid >> 2); const unsigned e = ce[tid]; const int rel = lbase[e] + cr[tid];
                tokrel[e * SLOTCAP + rel] = t; route[t * 4 + (tid & 3)] = e | ((unsigned)rel << 8); routew[t * 4 + (tid & 3)] = cw[tid]; }
            __syncthreads();
        }
        if (BOTH(5)) GRID_BAR(5); STAMP(6);
    }
#endif


    LAS int* t_cnt = (LAS int*)(lds + TAB_CNT); LAS int* t_start = (LAS int*)(lds + TAB_TSTART); LAS int* t_tile = (LAS int*)(lds + TAB_TILEE);
    if (IN(6) || IN(7) || IN(8)) {
        if (tid < 32) t_cnt[tid] = (int)__hip_atomic_load(ctl + CW_CURSOR + 64 * tid, RLX_AGENT);
        __syncthreads();
        if (tid == 0) { int s = 0; for (int e = 0; e < 32; ++e) { t_start[e] = s; s += (t_cnt[e] + 255) >> 8; } t_start[32] = s; }
        __syncthreads();
        for (int i = tid; i < 320; i += 512) { int e = 0; for (int k = 1; k < 32; ++k) if (i >= t_start[k]) e = k; t_tile[i] = e; }
        __syncthreads();
    }
    const int MT = (IN(6) || IN(7) || IN(8)) ? t_start[32] : 0;

    if (IN(6)) {
        LAS unsigned* tokt = (LAS unsigned*)(lds + TOK_OFF);
        MoeOrder S{MT, G, bx, (const char*)XN, (const char*)ACT, (const char*)Wgu_t, (const char*)Wd_t, t_tile, tokt, (unsigned*)(ctl + CW_MT), (unsigned*)(ctl + CW_TMO), MOE_MERGED ? 0 : 1, 0};
        for (int i0 = 0; i0 < MAXU; i0 += 2) { const int i = i0 + (tid >> 8), r = tid & 255; pg8::Unit u;
            if (i < MAXU && S.next(i, u) && u.aux == 2) { const int e = u.e, rel = (u.pm - t_start[e]) * 256 + r; const int tok = rel < t_cnt[e] ? tokrel[e * SLOTCAP + rel] : 0; tokt[i * 256 + r] = (unsigned)tok * 2048u; } }
        __syncthreads();
        EpiMoe E{EpiGU{ACT, bgu, rstdrel, t_start}, EpiDown{Yb, b_down}};
        if (!MOE_MERGED) STAGGER(S, MT * 8);
        for (int i = tid; i < 512; i += 512) *(LAS f32x4*)(gffl + 4 * i) = i < 256 ? *(const f32x4*)(g_ffn + 4 * i) : *(const f32x4*)(g_mix + 4 * (i - 256));
        __syncthreads();
        slack_convert(CS, MT * 8, G, bx, CVT_REST_ITEMS - SLACK_P6_ITEMS, SLACK_P6_ITEMS, lds + RING_OFF + wave * 8704, wave, lane);
        __syncthreads();
        if (MOE_MERGED) pg8::gemm_phase<EpiMoe, MoeOrder, true, true>(lds + RING_OFF, D, S, E, (DBG_KLOOP_PH == 6 && bx == 0) ? (unsigned*)(ctl + CW_TS + 16) : nullptr);
        else { EpiGU Eg{ACT, bgu, rstdrel, t_start}; pg8::gemm_phase<EpiGU, MoeOrder, true, true, false, PF_P6 != 0>(lds + RING_OFF, D, S, Eg, (DBG_KLOOP_PH == 6 && bx == 0) ? (unsigned*)(ctl + CW_TS + 16) : nullptr); }
        if (MOE_MERGED ? IN(8) : BOTH(6)) GRID_BAR(6); STAMP(7);
    }
    if (IN(7)) {
        if (!MOE_MERGED) {
            const int U7 = MT * 4, full7 = (U7 / G) * G, ntail = U7 - full7; const bool split = HALF_TAIL && ntail > 0 && 2 * ntail <= G;
            MoeOrder S{MT, G, bx, (const char*)XN, (const char*)ACT, (const char*)Wgu_t, (const char*)Wd_t, t_tile, (const LAS unsigned*)(lds + TOK_OFF), (unsigned*)(ctl + CW_MT), (unsigned*)(ctl + CW_TMO), 2, split ? full7 : U7};
            EpiMoe E{EpiGU{ACT, bgu, rstdrel, t_start}, EpiDown{Yb, b_down}};
            STAGGER(S, MT * 4);
            EpiDownX Ed{EpiDown{Yb, b_down}};
            pg8::gemm_phase<EpiDownX, MoeOrder, true, false, false, PF_P7 != 0>(lds + RING_OFF, D, S, Ed, (DBG_KLOOP_PH == 7 && bx == 0) ? (unsigned*)(ctl + CW_TS + 16) : nullptr);
            if (split && bx < 2 * ntail) { TailOrder T{MT, full7, bx, (const char*)ACT, (const char*)Wd_t, t_tile};
                pg8::gemm_phase<EpiDownX, TailOrder, false, false, true>(lds + RING_OFF, D, T, Ed); }
            if (BOTH(7)) GRID_BAR(7);
        }
        STAMP(8);
    }

    if (IN(8)) {
        f32x4 gf[4];
        float dbg_scale = 1.0f;
        if (DBG_RVR_PH >= 0) { const unsigned t0 = __hip_atomic_load(ctl + CW_TS + (DBG_RVR_PH >= 0 ? DBG_RVR_PH : 0), RLX_AGENT), t1 = __hip_atomic_load(ctl + CW_TS + (DBG_RVR_PH >= 0 ? DBG_RVR_PH : 0) + 1, RLX_AGENT);
            const float fr_ = fminf((float)(t1 - t0) * (0.01f / 350.0f), 1.0f); dbg_scale = 1.0f + sqrtf(0.0035f * fr_); }
#pragma unroll
        for (int j = 0; j < 4; ++j) gf[j] = *(const f32x4*)(g_final + 4 * lane + 256 * j);
        for (int t = gw; t < M; t += NGW) {
            f32x4 a[4];
#pragma unroll
            for (int j = 0; j < 4; ++j) {
                if (FOLD_G) { const v2u xv = *(const v2u*)(XN + (size_t)t * D + 4 * lane + 256 * j); a[j] = (f32x4){bf_lo(xv.x), bf_hi(xv.x), bf_lo(xv.y), bf_hi(xv.y)}; }
                else { const f32x4 xv = *(const f32x4*)(x + (size_t)t * D + 4 * lane + 256 * j); const v2u dv = *(const v2u*)(DLb + (size_t)t * D + 4 * lane + 256 * j);
                    a[j] = (f32x4){xv.x + bf_lo(dv.x), xv.y + bf_hi(dv.x), xv.z + bf_lo(dv.y), xv.w + bf_hi(dv.y)}; } }
#pragma unroll
            for (int k = 0; k < 4; ++k) { const unsigned rt = route[t * 4 + k]; const float w = routew[t * 4 + k]; const int e = rt & 255u, rel = rt >> 8;
                const bf16* yr = Yb + ((size_t)t_start[e] * 256 + rel) * 1024 + 4 * lane;
#pragma unroll
                for (int j = 0; j < 4; ++j) { const v2u y = *(const v2u*)(yr + 256 * j); a[j].x += w * bf_lo(y.x); a[j].y += w * bf_hi(y.x); a[j].z += w * bf_lo(y.y); a[j].w += w * bf_hi(y.y); } }
            float s = 0.f;
#pragma unroll
            for (int j = 0; j < 4; ++j) s += (a[j].x * a[j].x + a[j].y * a[j].y) + (a[j].z * a[j].z + a[j].w * a[j].w);
            const float rstd = 1.f / sqrtf(wave_sum(s) * (1.f / D) + RMS_EPS);
#pragma unroll
            for (int j = 0; j < 4; ++j) *(f32x4*)(out + (size_t)t * D + 4 * lane + 256 * j) = a[j] * (rstd * dbg_scale) * gf[j];
        }
        STAMP(9);
        if (DBG_TIME_PH >= 0 && bx == 0 && tid == 0) { const unsigned t0 = __hip_atomic_load(ctl + CW_TS + DBG_TIME_PH, RLX_AGENT), t1 = __hip_atomic_load(ctl + CW_TS + DBG_TIME_PH + 1, RLX_AGENT);
            const unsigned span = 4u * (t1 - t0); const unsigned ts = (unsigned)__builtin_amdgcn_s_memrealtime(); while ((unsigned)__builtin_amdgcn_s_memrealtime() - ts < span) __builtin_amdgcn_s_sleep(8); }
    }
#undef IN
#undef BOTH
#undef GRID_BAR
}

extern "C" void kernel_launch(void* const* d_in, const int* in_sizes, int n_in, void* d_out, int out_size, void* d_ws, size_t ws_size, hipStream_t stream) {
    static int grid = 0;
    if (grid == 0) {
        if (n_in != 19 || in_sizes[0] != M * D || out_size != M * D || ws_size < WS_END) { fprintf(stderr, "kernel_launch: unexpected shapes (n_in %d, in0 %d, out %d, ws %zu)\n", n_in, n_in > 0 ? in_sizes[0] : -1, out_size, ws_size); grid = -1; return; }
        int dev = 0, cus = 0, per_cu = 0;
        if (hipGetDevice(&dev) != hipSuccess || hipDeviceGetAttribute(&cus, hipDeviceAttributeMultiprocessorCount, dev) != hipSuccess) { grid = -1; return; }
        if (hipFuncSetAttribute((const void*)fwd_kernel, hipFuncAttributeMaxDynamicSharedMemorySize, LDS_BYTES) != hipSuccess) { fprintf(stderr, "kernel_launch: hipFuncSetAttribute failed\n"); grid = -1; return; }
        if (hipOccupancyMaxActiveBlocksPerMultiprocessor(&per_cu, (const void*)fwd_kernel, NWAVES * 64, LDS_BYTES) != hipSuccess || per_cu < 1)
            fprintf(stderr, "kernel_launch: note: occupancy query reports %d workgroups per CU\n", per_cu);
        (void)hipGetLastError();
        grid = cus;
    }
    if (grid < 0) return;
    if (hipMemsetAsync((char*)d_ws + WS_CTL, 0, CTL_ZERO_BYTES, stream) != hipSuccess) { fprintf(stderr, "kernel_launch: hipMemsetAsync failed\n"); return; }
    Args a{};
    for (int i = 0; i < 19; ++i) a.in[i] = (const float*)d_in[i];
    a.out = (float*)d_out; a.ws = (unsigned char*)d_ws;
    for (int li = 0; li < N_LAUNCHES; ++li) {
        a.ph_lo = (N_LAUNCHES == PER_PHASE) ? li : 0; a.ph_hi = (N_LAUNCHES == PER_PHASE) ? li + 1 : PER_PHASE; a.li = li;
        hipLaunchKernelGGL(fwd_kernel, dim3(grid), dim3(NWAVES * 64), LDS_BYTES, stream, a);
        const hipError_t le = hipPeekAtLastError();
        if (le != hipSuccess) { fprintf(stderr, "kernel_launch: launch %d failed: %s\n", li, hipGetErrorName(le)); break; }
    }
}
```

```cpp
#include <hip/hip_runtime.h>
#include <cstdio>
#include <cstdint>

#ifndef MK_N_LAUNCHES
#define MK_N_LAUNCHES 1
#endif

#ifndef MOE_MERGED
#define MOE_MERGED 0
#endif
#ifndef RELAX_POST_EPI
#define RELAX_POST_EPI 0
#endif
#ifndef STAGGER_US
#define STAGGER_US 0
#endif
#ifndef P7_REVERSE
#define P7_REVERSE 0
#endif
#ifndef KEEP_WD
#define KEEP_WD 0
#endif
#ifndef P5_MFMA
#define P5_MFMA 1
#endif
#ifndef PF_P6
#define PF_P6 0
#endif
#ifndef PF_P7
#define PF_P7 0
#endif
#ifndef KV_PREFETCH
#define KV_PREFETCH 0
#endif
#ifndef FOLD_G
#define FOLD_G (P5_MFMA)
#endif
#ifndef FUSE_RES
#define FUSE_RES (P5_MFMA)
#endif
#ifndef FOLD_GMIX
#define FOLD_GMIX (P5_MFMA)
#endif
#ifndef CONV_INLINE
#define CONV_INLINE 1
#endif
#ifndef HALF_TAIL
#define HALF_TAIL 1
#endif
#ifndef DBG_TIME_PH
#define DBG_TIME_PH (-1)
#endif
#ifndef DBG_KLOOP_PH
#define DBG_KLOOP_PH (-1)
#endif
#ifndef ROPE_SB
#define ROPE_SB __builtin_amdgcn_sched_barrier(0)
#endif
#ifndef ADJ_DOWN
#define ADJ_DOWN 0
#endif
#ifndef HALF_PAIR
#define HALF_PAIR 1
#endif
#ifndef CVT_NT_LOAD
#define CVT_NT_LOAD 1
#endif
#ifndef DBG_SLACK_WAVES
#define DBG_SLACK_WAVES 8
#endif
#ifndef DBG_SLACK_REM
#define DBG_SLACK_REM 0
#endif
#ifndef DBG_BUSY_PH
#define DBG_BUSY_PH 1
#endif
#ifndef DBG_SPAN_ID
#define DBG_SPAN_ID (-1)
#endif
#ifndef DBG_BLK
#define DBG_BLK 0
#endif
#ifndef DBG_KMODE
#define DBG_KMODE 0
#endif
#ifndef DBG_RVR_US
#define DBG_RVR_US 350.0f
#endif
#ifndef DBG_RVR_PH
#define DBG_RVR_PH (-1)
#endif
namespace pg8 {
#define PG8_LAS __attribute__((address_space(3)))
typedef unsigned short bf16_t;
typedef short bf16x8 __attribute__((ext_vector_type(8)));
typedef float f32x4 __attribute__((ext_vector_type(4)));
typedef unsigned u32x4 __attribute__((ext_vector_type(4)));
typedef unsigned u32x2 __attribute__((ext_vector_type(2)));
constexpr int BM = 256, BK = 64, HALF = 128, HTB = HALF * BK * 2  , STAGE_BYTES = 8 * HTB, NXCD = 8;
constexpr int PFD = 6;
constexpr int PF_LDS_OFF = 150016 + 4096;
constexpr int BIAS_LDS_OFF = 150016;

__host__ __device__ __forceinline__ int lds_byte(int r, int c) { const int st = (r >> 4) * 2 + (c >> 5), rr = r & 15, cc = c & 31, ob = rr * 64 + cc * 2; return st * 1024 + (ob ^ (((ob >> 9) & 1) << 5)); }
__host__ __device__ __forceinline__ void stage_rc(int b, int& R, int& C) { const int st = b / 1024, sb = b % 1024, swz = sb ^ (((sb >> 9) & 1) << 5); R = (st >> 1) * 16 + swz / 64; C = (st & 1) * 32 + (swz % 64) / 2; }
__host__ __device__ __forceinline__ int perm32(int rho) { const int n = rho >> 4, i = rho & 15; return 8 * (i >> 2) + 4 * n + (i & 3); }

struct Unit { int pm, pn, e, aux; bool keep; const char* a; const char* b; int rofs; };

#ifndef WGM_DENSE
#define WGM_DENSE 4
#endif
#ifndef WGM_MOE
#define WGM_MOE 3
#endif
#ifndef WGM_MOE2
#define WGM_MOE2 4
#endif
__host__ __device__ __forceinline__ bool tile_of(long L, int nM, int nN, int& pm, int& pn, const int WGM = WGM_DENSE) {
    const int nwg = nM * nN; if (L >= nwg) return false;
    int wgid = (int)L; { const int q = nwg / NXCD, r = nwg % NXCD, xcd = wgid % NXCD, off = wgid / NXCD; wgid = (xcd < r ? xcd * (q + 1) : r * (q + 1) + (xcd - r) * q) + off; }
    const int nig = WGM * nN, gid = wgid / nig, fm = gid * WGM, gsz = (nM - fm) < WGM ? (nM - fm) : WGM;
    pm = fm + ((wgid % nig) % gsz); pn = (wgid % nig) / gsz; return true;
}

__device__ __forceinline__ unsigned cvt_pk_bf16(float lo, float hi) { unsigned r; asm volatile("v_cvt_pk_bf16_f32 %0, %1, %2" : "=v"(r) : "v"(lo), "v"(hi)); return r; }
__device__ __forceinline__ float bf_lo(unsigned w) { return __uint_as_float(w << 16); }
__device__ __forceinline__ float bf_hi(unsigned w) { return __uint_as_float(w & 0xffff0000u); }
__device__ __forceinline__ float sigmoidf_(float x) { return __builtin_amdgcn_rcpf(1.0f + __builtin_amdgcn_exp2f(x * -1.4426950408889634f)); }

template <class Epi, class Sched, bool ALIGN_EPI, bool GATHER, bool HALFM = false, bool PF = false>
__device__ __forceinline__ void gemm_phase(PG8_LAS unsigned char* lds, const int K, const Sched& S, const Epi& E, unsigned* dbg = nullptr) {
    const int tid = threadIdx.x, wid = __builtin_amdgcn_readfirstlane(tid >> 6), lane = tid & 63, wr = wid >> 2, wc = wid & 3, fr = lane & 15, fq = lane >> 4;
    const int nt = K / BK;
    unsigned voffA[2], voffB[2]; int RA[2]; unsigned CA2[2];
#pragma unroll
    for (int i = 0; i < 2; ++i) { int R, C; stage_rc(tid * 16 + i * 8192, R, C); const int Rb = Epi::PERM ? ((R & ~31) + perm32(R & 31)) : R;
        voffA[i] = (unsigned)(R * K + C) * 2u; voffB[i] = (unsigned)(Rb * K + C) * 2u; RA[i] = R; CA2[i] = (unsigned)C * 2u; }
    const size_t kstep = (size_t)(BK * 2);
    const size_t hstep = (size_t)HALF * K * 2;
    const unsigned ldsw = (unsigned)wid * 1024u;
    const int aoff = lds_byte(wr * 64 + fr, fq * 8), boff = lds_byte(wc * 32 + fr, fq * 8);
#define PG8_SA(b, h) (((b) * 2 + (h)) * HTB)
#define PG8_SB(b, h) ((4 + (b) * 2 + (h)) * HTB)
#define PG8_GLDS(src, dstoff) __builtin_amdgcn_global_load_lds((const unsigned*)(src), (PG8_LAS unsigned*)(lds + (dstoff)), 16, 0, 0)
#define PG8_STAGE_B(bufoff, gbase) do { __builtin_amdgcn_s_setprio(2); PG8_GLDS((const char*)(gbase) + voffB[0], (bufoff) + ldsw); PG8_GLDS((const char*)(gbase) + voffB[1], (bufoff) + ldsw + 8192); __builtin_amdgcn_s_setprio(0); } while (0)
#define PG8_STAGE_A(bufoff, gbase, h, o0, o1) do { __builtin_amdgcn_s_setprio(2); \
        if constexpr (GATHER) { PG8_GLDS((const char*)(gbase) + (o0), (bufoff) + ldsw); PG8_GLDS((const char*)(gbase) + (o1), (bufoff) + ldsw + 8192); } \
        else { PG8_GLDS((const char*)(gbase) + (h) * hstep + voffA[0], (bufoff) + ldsw); PG8_GLDS((const char*)(gbase) + (h) * hstep + voffA[1], (bufoff) + ldsw + 8192); } __builtin_amdgcn_s_setprio(0); } while (0)
#define PG8_LDA(dst, b, h) do { _Pragma("unroll") for (int m = 0; m < 4; ++m) _Pragma("unroll") for (int k = 0; k < 2; ++k) dst[m][k] = *(const PG8_LAS bf16x8*)(lds + PG8_SA(b, h) + aoff + m * 2048 + k * 1024); } while (0)
#define PG8_LDB(dst, b, h) do { _Pragma("unroll") for (int n = 0; n < 2; ++n) _Pragma("unroll") for (int k = 0; k < 2; ++k) dst[n][k] = *(const PG8_LAS bf16x8*)(lds + PG8_SB(b, h) + boff + n * 2048 + k * 1024); } while (0)
#define PG8_MMA(ai, bj, At, Bt) do { __builtin_amdgcn_s_setprio(1); _Pragma("unroll") for (int m = 0; m < 4; ++m) _Pragma("unroll") for (int n = 0; n < 2; ++n) _Pragma("unroll") for (int k = 0; k < 2; ++k) \
        acc[ai][bj][m][n] = __builtin_amdgcn_mfma_f32_16x16x32_bf16(Bt[n][k], At[m][k], acc[ai][bj][m][n], 0, 0, 0); __builtin_amdgcn_s_setprio(0); } while (0)
#define PG8_WAIT_V(n) asm volatile("s_waitcnt vmcnt(" #n ")" ::: "memory")
#define PG8_WAIT_VK do { if constexpr (PF) PG8_WAIT_V(9); else PG8_WAIT_V(8); } while (0)
#define PG8_WAIT_L(n) asm volatile("s_waitcnt lgkmcnt(" #n ")" ::: "memory")
#define PG8_BAR __builtin_amdgcn_s_barrier()
#define PG8_SCHED __builtin_amdgcn_sched_barrier(0)
#define PG8_BIAS_STAGE(u_, par_) do { const float* bp_ = wid < 4 ? E.bias_row(u_) : E.aux_row(u_); if (bp_ != nullptr) \
        __builtin_amdgcn_global_load_lds((const unsigned*)(bp_ + (wid & 3) * 64 + lane), (PG8_LAS unsigned*)(lds + BIAS_LDS_OFF + (par_) * 2048 + wid * 256), 4, 0, 0); } while (0)
    Unit cur, nxt, prv; int ui = 0; unsigned dbg_acc = 0;
    const unsigned dbg_te = (DBG_KLOOP_PH >= 0 && DBG_KMODE == 2 && dbg) ? (unsigned)__builtin_amdgcn_s_memrealtime() : 0u;
    if (!S.next(0, cur)) return;
    prv = cur;
    f32x4 acc[2][2][4][2];
#pragma unroll
    for (int a = 0; a < 2; ++a)
#pragma unroll
        for (int b = 0; b < 2; ++b)
#pragma unroll
            for (int m = 0; m < 4; ++m)
#pragma unroll
                for (int n = 0; n < 2; ++n) acc[a][b][m][n] = (f32x4){0.f, 0.f, 0.f, 0.f};
    bf16x8 At[4][2], B0[2][2], B1[2][2];
    unsigned gA00 = 0, gA01 = 0, gA10 = 0, gA11 = 0, gN00 = 0, gN01 = 0, gN10 = 0, gN11 = 0;
    if constexpr (GATHER) { gA00 = S.tokoff(0, RA[0]) + CA2[0]; gA01 = S.tokoff(0, RA[1]) + CA2[1]; gA10 = S.tokoff(0, HALF + RA[0]) + CA2[0]; gA11 = S.tokoff(0, HALF + RA[1]) + CA2[1]; }
    const char* cA = cur.a; const char* cB = cur.b;
    const int pfrow = wid * 32 + (lane & 31);
#define PG8_PFPTR(u_, ui_) ((lane < 32) ? (u_).b + (size_t)pfrow * K * 2 : (GATHER ? (u_).a + S.tokoff((ui_), pfrow) : (u_).a + (size_t)pfrow * K * 2))
#define PG8_PF(kt_) do { if constexpr (PF) { const int k_ = (kt_); const char* p_ = k_ < nt ? pfc + (size_t)k_ * kstep : pfn + (size_t)(k_ - nt) * kstep; \
        __builtin_amdgcn_global_load_lds((const unsigned*)p_, (PG8_LAS unsigned*)(lds + PF_LDS_OFF + wid * 256), 4, 0, 0); } } while (0)
    const char* pfc = nullptr; const char* pfn = nullptr;
    if constexpr (PF) { pfc = PG8_PFPTR(cur, 0); pfn = pfc; }
    S.a_ready(cur);
    PG8_BIAS_STAGE(cur, 0);
    PG8_STAGE_B(PG8_SB(0, 0), cB); PG8_STAGE_B(PG8_SB(0, 1), cB + hstep); PG8_STAGE_A(PG8_SA(0, 0), cA, 0, gA00, gA01); PG8_STAGE_A(PG8_SA(0, 1), cA, 1, gA10, gA11);
    if (wr == 1) PG8_BAR;
    PG8_WAIT_V(2); PG8_BAR;
    PG8_STAGE_B(PG8_SB(1, 0), cB + kstep); PG8_STAGE_A(PG8_SA(1, 0), cA + kstep, 0, gA00, gA01); PG8_STAGE_B(PG8_SB(1, 1), cB + hstep + kstep);
    PG8_WAIT_V(6); PG8_BAR;
    PG8_PF(PFD);
    for (;;) {
        const bool has_next = S.next(ui + 1, nxt);
        if constexpr (GATHER) { if (has_next) { gN00 = S.tokoff(ui + 1, RA[0]) + CA2[0]; gN01 = S.tokoff(ui + 1, RA[1]) + CA2[1]; gN10 = S.tokoff(ui + 1, HALF + RA[0]) + CA2[0]; gN11 = S.tokoff(ui + 1, HALF + RA[1]) + CA2[1]; } }
        const char* nA = has_next ? nxt.a : cA; const char* nB = has_next ? nxt.b : cB;
        if constexpr (PF) { pfn = has_next ? PG8_PFPTR(nxt, ui + 1) : pfc; }
        unsigned dbg_t0 = 0; if (DBG_KLOOP_PH >= 0 && dbg) dbg_t0 = (unsigned)__builtin_amdgcn_s_memrealtime();
        for (int t = 0; t < nt; t += 2) {
            const bool last = (t == nt - 2);
            const char* a1 = cA + (size_t)(t + 1) * kstep;
            const char* a2 = last ? nA : cA + (size_t)(t + 2) * kstep; const char* b2 = last ? nB : cB + (size_t)(t + 2) * kstep;
            const char* a3 = a2 + kstep; const char* b3 = b2 + kstep;
            unsigned s00 = gA00, s01 = gA01, s10 = gA10, s11 = gA11;
            if constexpr (GATHER) { if (last && has_next) { s00 = gN00; s01 = gN01; s10 = gN10; s11 = gN11; } }
            if (last && has_next) S.a_ready(nxt);
            PG8_LDB(B0, 0, 0); PG8_LDB(B1, 0, 1); PG8_SCHED; PG8_LDA(At, 0, 0); PG8_STAGE_A(PG8_SA(1, 1), a1, 1, gA10, gA11);
            PG8_WAIT_VK; PG8_WAIT_L(0); PG8_BAR; PG8_MMA(0, 0, At, B0); PG8_MMA(0, 1, At, B1); PG8_BAR; PG8_SCHED;
            if constexpr (!HALFM) PG8_LDA(At, 0, 1);
            PG8_STAGE_B(PG8_SB(0, 0), b2); PG8_STAGE_B(PG8_SB(0, 1), b2 + hstep); PG8_STAGE_A(PG8_SA(0, 0), a2, 0, s00, s01); PG8_PF(t + 1 + PFD);
            PG8_WAIT_VK; PG8_WAIT_L(0); PG8_BAR; if constexpr (!HALFM) { PG8_MMA(1, 0, At, B0); PG8_MMA(1, 1, At, B1); } PG8_BAR; PG8_SCHED;
            PG8_LDB(B0, 1, 0); PG8_LDB(B1, 1, 1); PG8_SCHED; PG8_LDA(At, 1, 0); PG8_STAGE_A(PG8_SA(0, 1), a2, 1, s10, s11);
            PG8_WAIT_VK; PG8_WAIT_L(0); PG8_BAR; PG8_MMA(0, 0, At, B0); PG8_MMA(0, 1, At, B1); PG8_BAR; PG8_SCHED;
            if constexpr (!HALFM) PG8_LDA(At, 1, 1);
            PG8_STAGE_B(PG8_SB(1, 0), b3); PG8_STAGE_B(PG8_SB(1, 1), b3 + hstep); PG8_STAGE_A(PG8_SA(1, 0), a3, 0, s00, s01); PG8_PF(t + 2 + PFD);
            PG8_WAIT_VK; PG8_WAIT_L(0); PG8_BAR; if constexpr (!HALFM) { PG8_MMA(1, 0, At, B0); PG8_MMA(1, 1, At, B1); } PG8_BAR; PG8_SCHED;
        }
        unsigned dbg_t1 = 0; if (DBG_KLOOP_PH >= 0 && dbg) { dbg_t1 = (unsigned)__builtin_amdgcn_s_memrealtime(); if (DBG_KMODE == 0) dbg_acc += dbg_t1 - dbg_t0; }
        if constexpr (ALIGN_EPI) { if (wr == 0) PG8_BAR; }
        if (MOE_MERGED && ui > 0) S.done(prv);
        E(acc, cur, wr, wc, fr, fq, (const PG8_LAS float*)(lds + BIAS_LDS_OFF + (ui & 1) * 2048));
        if (DBG_KLOOP_PH >= 0 && DBG_KMODE == 1 && dbg) { asm volatile("" ::: "memory"); dbg_acc += (unsigned)__builtin_amdgcn_s_memrealtime() - dbg_t1; }
        if (has_next) PG8_BIAS_STAGE(nxt, (ui + 1) & 1);
        if (MOE_MERGED) prv = cur;
        if (!has_next) break;
        if (!cur.keep) {
#pragma unroll
            for (int a = 0; a < 2; ++a)
#pragma unroll
                for (int b = 0; b < 2; ++b)
#pragma unroll
                    for (int m = 0; m < 4; ++m)
#pragma unroll
                        for (int n = 0; n < 2; ++n) acc[a][b][m][n] = (f32x4){0.f, 0.f, 0.f, 0.f};
        }
        cur = nxt; cA = nA; cB = nB; ++ui; if constexpr (PF) pfc = pfn;
        if constexpr (GATHER) { gA00 = gN00; gA01 = gN01; gA10 = gN10; gA11 = gN11; }
        if constexpr (ALIGN_EPI) { if (wr == 1) PG8_BAR; }
    }
    PG8_WAIT_V(0);
    if (DBG_KLOOP_PH >= 0 && DBG_KMODE == 2 && dbg) dbg_acc = (unsigned)__builtin_amdgcn_s_memrealtime() - dbg_te;
    if (DBG_KLOOP_PH >= 0 && dbg && threadIdx.x == 0) { dbg[0] = 0u; dbg[1] = dbg_acc; }
    if (MOE_MERGED) S.done(prv);
    if constexpr (!ALIGN_EPI) { if (wr == 0) PG8_BAR; }
    PG8_BAR;
#undef PG8_BIAS_STAGE
#undef PG8_PFPTR
#undef PG8_PF
#undef PG8_WAIT_VK
#undef PG8_SA
#undef PG8_SB
#undef PG8_GLDS
#undef PG8_STAGE_A
#undef PG8_STAGE_B
#undef PG8_LDA
#undef PG8_LDB
#undef PG8_MMA
#undef PG8_WAIT_V
#undef PG8_WAIT_L
#undef PG8_BAR
#undef PG8_SCHED
}
}

constexpr int NWAVES = 8;
constexpr int N_LAUNCHES = MK_N_LAUNCHES;
constexpr int PER_PHASE = 9;
constexpr int BATCH = 2, SEQ = 8192, D = 1024, M = BATCH * SEQ, HD = 64, NQH = 16, NKVH = 4, KVW = 256;
constexpr int NIN = 6656, NEXP = 32, TOPK = 4, DFF = 1024;
constexpr float RMS_EPS = 1e-5f;
constexpr float QSCALE = 0.125f * 1.4426950408889634f;
constexpr float LOG2E = 1.4426950408889634f;
constexpr int MAXTILES = 288;
constexpr int SLOTCAP = 16384;
constexpr int HELPER_CUS = 0;
constexpr int MAXU = 16;

constexpr size_t MiB = 1u << 20;
constexpr size_t WS_CTL = 0, CTL_ZERO_BYTES = MOE_MERGED ? 1 * MiB : 64 * 1024;
constexpr size_t WS_BINP = 1 * MiB;
constexpr size_t WS_BGU = 1 * MiB + 64 * 1024;
constexpr size_t WS_RFRAG = 1 * MiB + 640 * 1024;
constexpr size_t WS_RSTD0 = 1 * MiB + 512 * 1024;
constexpr size_t WS_COS = 2 * MiB, WS_SIN = 3 * MiB;
constexpr size_t WS_WIN = 4 * MiB;
constexpr size_t WS_WAO = 17 * MiB, WS_WCO = 19 * MiB, WS_WOUT = 21 * MiB;
constexpr size_t WS_XN = 24 * MiB;
constexpr size_t WS_Q = 56 * MiB, WS_K = 88 * MiB, WS_V = 96 * MiB, WS_CB = 104 * MiB, WS_MG = 136 * MiB, WS_U = 168 * MiB, WS_SA = 200 * MiB, WS_SC = 232 * MiB;
constexpr size_t WS_WGU = 264 * MiB;
constexpr size_t WS_WD = 392 * MiB;
constexpr size_t WS_TOKREL = 456 * MiB;
constexpr size_t WS_ROUTE = 458 * MiB;
constexpr size_t WS_ROUTEW = 459 * MiB;
constexpr size_t WS_ACT = 56 * MiB;
constexpr size_t WS_Y = 200 * MiB;
constexpr size_t WS_RSTDREL = 460 * MiB;
constexpr size_t WS_DL = 464 * MiB;
constexpr size_t WS_END = 496 * MiB;
static_assert(WS_ACT + (size_t)MAXTILES * 256 * 2048 <= WS_Y && WS_Y + (size_t)MAXTILES * 256 * 2048 <= WS_WD, "MoE overlays");
constexpr int CW_TMO = 0;
constexpr int CW_TS = 512;
constexpr int CW_CURSOR = 1024;
constexpr int CW_POOL = 3200;
constexpr int CW_BAR = 4096;
constexpr int CW_MT = 16384;
#define XCD_BAR_WORDS_C 3456
static_assert(CW_BAR + 3 * XCD_BAR_WORDS_C <= CW_MT && (CW_BAR + 3 * XCD_BAR_WORDS_C) * 4 <= 64 * 1024 && (!MOE_MERGED || (CW_MT + 64 * MAXTILES) * 4 <= (int)CTL_ZERO_BYTES), "CTL");

constexpr int RING_OFF = 0, RING_BYTES = 131072;
constexpr int LDSCTL_OFF = RING_BYTES, MISC_OFF = LDSCTL_OFF + 320;
constexpr int TAB_OFF = RING_BYTES + 512;
constexpr int TAB_CNT = TAB_OFF, TAB_TSTART = TAB_OFF + 128, TAB_TILEE = TAB_OFF + 128 + 160;
constexpr int TOK_OFF = TAB_OFF + 2048;
constexpr int BIAS_OFF = TOK_OFF + MAXU * 1024;
constexpr int LDS_BYTES = BIAS_OFF + 4096 + 2048;
static_assert(TAB_TILEE + 320 * 4 <= TOK_OFF && LDS_BYTES <= 163840 && BIAS_OFF == pg8::BIAS_LDS_OFF + RING_OFF, "LDS map");

#define GAS __attribute__((address_space(1)))
#define LAS __attribute__((address_space(3)))
typedef unsigned short bf16;
typedef unsigned v4u __attribute__((ext_vector_type(4)));
typedef unsigned v2u __attribute__((ext_vector_type(2)));
typedef float f32x4 __attribute__((ext_vector_type(4)));
typedef float f32x16 __attribute__((ext_vector_type(16)));
typedef float f32x2 __attribute__((ext_vector_type(2)));
typedef short bf16x8 __attribute__((ext_vector_type(8)));
typedef __bf16 bf16x2 __attribute__((ext_vector_type(2)));
typedef short s16x4 __attribute__((ext_vector_type(4)));
typedef GAS unsigned gu32;
#define RLX_AGENT __ATOMIC_RELAXED, __HIP_MEMORY_SCOPE_AGENT
#define LDS_WAIT() asm volatile("s_waitcnt lgkmcnt(0)" ::: "memory")
#define VM_WAIT() asm volatile("s_waitcnt vmcnt(0)" ::: "memory")
using pg8::cvt_pk_bf16; using pg8::bf_lo; using pg8::bf_hi;

#define XB_TMO      128
#define XB_XCNT(j)  (256  + 64 * (j))
#define XB_XSUB(j)  (1280 + 64 * (j))
#define XB_XGEN(j)  (2304 + 64 * (j))
#define XB_TOP      3328
#define XB_TOPGEN   3392
#define XCD_BAR_WORDS 3456
#define XB_SPIN_CAP (1u << 18)
static_assert(XCD_BAR_WORDS == XCD_BAR_WORDS_C, "bar words");

__device__ __forceinline__ unsigned xb_ld(unsigned* p)              { return __hip_atomic_load(p, __ATOMIC_RELAXED, __HIP_MEMORY_SCOPE_AGENT); }
__device__ __forceinline__ unsigned xb_add(unsigned* p, unsigned v) { return __hip_atomic_fetch_add(p, v, __ATOMIC_RELAXED, __HIP_MEMORY_SCOPE_AGENT); }
__device__ __forceinline__ unsigned xb_xcc_id() { return (unsigned)__builtin_amdgcn_s_getreg((3 << 11) | 20) & 0xFu; }
#define XB_SPIN(cond, bar) do { unsigned _sp = 0; while (cond) { __builtin_amdgcn_s_sleep(1); \
    if ((++_sp & 255u) == 0u) { if (xb_ld(&(bar)[XB_TMO])) break; if (_sp > XB_SPIN_CAP) { atomicAdd(&(bar)[XB_TMO], 1u); break; } } } } while (0)

struct XcdBarrier { unsigned* bar; unsigned x; volatile LAS unsigned* st; };

__device__ __forceinline__ XcdBarrier xcd_barrier_post(unsigned* bar, volatile LAS unsigned* st) {
    XcdBarrier b; b.bar = bar; b.x = xb_xcc_id(); b.st = st;
    if (threadIdx.x == 0) (void)xb_add(&bar[XB_XCNT(b.x)], 1u);
    return b;
}
__device__ __forceinline__ void xcd_barrier_complete(unsigned* bar, unsigned x, unsigned& nloc, unsigned& nx) {
    const unsigned G = gridDim.x * gridDim.y * gridDim.z;
    unsigned sum, cnt, mine, sp = 0u;
    for (;;) {
        sum = 0u; cnt = 0u; mine = 0u;
#pragma unroll
        for (unsigned j = 0; j < 16; ++j) { const unsigned c = xb_ld(&bar[XB_XCNT(j)]); sum += c; cnt += (c > 0u) ? 1u : 0u; mine = (j == x) ? c : mine; }
        if (sum == G) break;
        __builtin_amdgcn_s_sleep(1);
        if ((++sp & 255u) == 0u) { if (xb_ld(&bar[XB_TMO])) break; if (sp > XB_SPIN_CAP) { atomicAdd(&bar[XB_TMO], 1u); break; } }
    }
    nloc = mine > 0u ? mine : 1u; nx = cnt > 0u ? cnt : 1u;
}
__device__ __forceinline__ void xcd_barrier(const XcdBarrier& b) {
    asm volatile("s_waitcnt vmcnt(0)" ::: "memory");
    __syncthreads();
    if (threadIdx.x == 0) {
        unsigned* bar = b.bar;
        __builtin_amdgcn_s_waitcnt(0);
        unsigned nloc = b.st[0], nx = b.st[1];
        if (nloc == 0u) { xcd_barrier_complete(bar, b.x, nloc, nx); b.st[0] = nloc; b.st[1] = nx; }
        const unsigned old = xb_add(&bar[XB_XSUB(b.x)], 1u);
        const unsigned gen = old / nloc;
        if (old + 1u == (gen + 1u) * nloc) {
            __builtin_amdgcn_fence(__ATOMIC_RELEASE, "agent");
            asm volatile("s_waitcnt vmcnt(0)" ::: "memory");
            const unsigned og = xb_add(&bar[XB_TOP], 1u);
            const unsigned tg = og / nx;
            if (og + 1u == (tg + 1u) * nx) xb_add(&bar[XB_TOPGEN], 1u);
            else XB_SPIN(xb_ld(&bar[XB_TOPGEN]) == tg, bar);
            __builtin_amdgcn_fence(__ATOMIC_ACQUIRE, "agent");
            xb_add(&bar[XB_XGEN(b.x)], 1u);
            asm volatile("s_waitcnt vmcnt(0)" ::: "memory");
        } else {
            XB_SPIN(xb_ld(&bar[XB_XGEN(b.x)]) == gen, bar);
            __builtin_amdgcn_fence(__ATOMIC_ACQUIRE, "agent");
            asm volatile("s_waitcnt vmcnt(0)" ::: "memory");
        }
    }
    __syncthreads();
}

__device__ __forceinline__ float wave_sum(float v) {
#pragma unroll
    for (int o = 1; o < 64; o <<= 1) v += __shfl_xor(v, o);
    return v;
}
__device__ __forceinline__ float wave_max(float v) {
#pragma unroll
    for (int o = 1; o < 64; o <<= 1) v = fmaxf(v, __shfl_xor(v, o));
    return v;
}
__device__ __forceinline__ int wave_min_i(int v) {
#pragma unroll
    for (int o = 1; o < 64; o <<= 1) { const int w = __shfl_xor(v, o); v = w < v ? w : v; }
    return v;
}

template <int CTRL> __device__ __forceinline__ float dpp_f(float v) { return __builtin_bit_cast(float, __builtin_amdgcn_update_dpp(0, __builtin_bit_cast(int, v), CTRL, 0xF, 0xF, false)); }
__device__ __forceinline__ float rl_f(float v, int l) { return __builtin_bit_cast(float, __builtin_amdgcn_readlane(__builtin_bit_cast(int, v), l)); }
__device__ __forceinline__ float wave_sum_dpp(float v) { v += dpp_f<0xB1>(v); v += dpp_f<0x4E>(v); v += dpp_f<0x141>(v); v += dpp_f<0x140>(v); return (rl_f(v, 0) + rl_f(v, 16)) + (rl_f(v, 32) + rl_f(v, 48)); }
__device__ __forceinline__ float half_max_dpp(float v) { v = fmaxf(v, dpp_f<0xB1>(v)); v = fmaxf(v, dpp_f<0x4E>(v)); v = fmaxf(v, dpp_f<0x141>(v)); v = fmaxf(v, dpp_f<0x140>(v)); return fmaxf(rl_f(v, 0), rl_f(v, 16)); }

__device__ __forceinline__ int win_dest(int c) {
    if (c < 1280) { const int h = c >> 6, d = c & 63, s = d >> 5, i = d & 31; return (h << 6) + 8 * (i >> 2) + 4 * s + (i & 3); }
    if (c < 2560) return c;
    if (HALF_PAIR) {
        if (c < 3584) { const int i = c - 2560; return 2560 + (i >> 7) * 256 + (i & 127); }
        if (c < 4608) { const int i = c - 3584; return 2560 + (i >> 7) * 256 + 128 + (i & 127); }
        if (c < 5632) { const int i = c - 4608; return 4608 + (i >> 7) * 256 + (i & 127); }
        { const int i = c - 5632; return 4608 + (i >> 7) * 256 + 128 + (i & 127); }
    }
    if (c < 3584) { const int i = c - 2560; return 2560 + (i >> 2) * 8 + (i & 3); }
    if (c < 4608) { const int i = c - 3584; return 2560 + (i >> 2) * 8 + 4 + (i & 3); }
    if (c < 5632) { const int i = c - 4608; return 4608 + (i >> 2) * 8 + (i & 3); }
    { const int i = c - 5632; return 4608 + (i >> 2) * 8 + 4 + (i & 3); }
}
__device__ __forceinline__ int map_dest(int mode, int n) {
    if (mode == 0) return n;
    if (mode == 1) return win_dest(n);
    if (mode == 4) return (n & ~255) + 128 * ((n >> 5) & 1) + 32 * ((n >> 6) & 3) + (n & 31);
    if (HALF_PAIR) return (n >> 7) * 256 + (mode == 2 ? 0 : 128) + (n & 127);
    if (mode == 2) return (n >> 2) * 8 + (n & 3);
    return (n >> 2) * 8 + 4 + (n & 3);
}

constexpr int NWAVES_C = 8;
struct CvtItem { const GAS float* W; GAS bf16* WT; int K, N, mode, k0, n0, keep; };
__device__ __forceinline__ void cvt_load(f32x4 (&v)[16], const CvtItem& it, int lane) {
    const GAS float* p = it.W + (size_t)(it.k0 + 4 * (lane >> 4)) * it.N + it.n0 + 4 * (lane & 15);
#pragma unroll
    for (int j = 0; j < 4; ++j)
#pragma unroll
        for (int r = 0; r < 4; ++r) v[j * 4 + r] = CVT_NT_LOAD ? __builtin_nontemporal_load((const GAS f32x4*)(p + (size_t)(16 * j + r) * it.N)) : *(const GAS f32x4*)(p + (size_t)(16 * j + r) * it.N);
}
__device__ __forceinline__ void cvt_store(const f32x4 (&v)[16], const CvtItem& it, LAS unsigned char* scr, int lane, const LAS float* gl) {
    const int kq = lane >> 4, nl = 4 * (lane & 15);
    const bool gs = (FOLD_G && (it.mode == 2 || it.mode == 3)) || (FOLD_GMIX && it.mode == 1);
    const int goff = it.mode == 1 ? 1024 : 0;
#pragma unroll
    for (int j = 0; j < 4; ++j) { f32x4 gk = *(const LAS f32x4*)(gl + goff + it.k0 + 16 * j + 4 * kq);
        if (!gs) gk = (f32x4){1.f, 1.f, 1.f, 1.f};
#pragma unroll
        for (int i = 0; i < 4; ++i) { v2u w; w.x = cvt_pk_bf16(v[j * 4 + 0][i] * gk[0], v[j * 4 + 1][i] * gk[1]); w.y = cvt_pk_bf16(v[j * 4 + 2][i] * gk[2], v[j * 4 + 3][i] * gk[3]);
            *(LAS v2u*)(scr + (nl + i) * 136 + (16 * j + 4 * kq) * 2) = w; } }
    LDS_WAIT(); asm volatile("" ::: "memory");
#pragma unroll
    for (int jj = 0; jj < 8; ++jj) { const int n = (lane >> 3) + 8 * jj, c = lane & 7;
        const v2u a = *(const LAS v2u*)(scr + n * 136 + c * 16), b = *(const LAS v2u*)(scr + n * 136 + c * 16 + 8);
        v4u o; o.x = a.x; o.y = a.y; o.z = b.x; o.w = b.y;
        GAS v4u* dp = (GAS v4u*)(it.WT + (size_t)map_dest(it.mode, it.n0 + n) * it.K + it.k0 + 8 * c);
        if (it.keep) *dp = o; else __builtin_nontemporal_store(o, dp); }
    LDS_WAIT(); asm volatile("" ::: "memory");
}
struct CvtSrc { const float* w_in; bf16* Win_t; const LAS unsigned long long* ptab; const LAS float* gl; };
constexpr int CVT_IN_ITEMS = (1024 / 64) * (6656 / 64);
constexpr int CVT_SQ_ITEMS = 256;
constexpr int CVT_REST_ITEMS = (3 + 32 * 3) * CVT_SQ_ITEMS;
#ifndef SLACK_CVT
#define SLACK_CVT 1
#endif
#ifndef POOL_CVT
#define POOL_CVT 1
#endif
#ifndef POOL_P1
#define POOL_P1 0
#endif
#ifndef SLACK_P6A
#define SLACK_P6A 6144
#endif
#ifndef CVT_P0_REST
#define CVT_P0_REST 0
#endif
#ifndef SLACK_P1A
#define SLACK_P1A 10496
#endif
constexpr int SLACK_P6_ITEMS = SLACK_CVT ? 8192 : 0;
constexpr int CVT_P0_ITEMS = SLACK_CVT ? CVT_P0_REST : (3 + 32 * 3) * 256;
constexpr int SLACK_P1A_ITEMS = SLACK_CVT ? SLACK_P1A : 0;
constexpr int SLACK_P6A_ITEMS = SLACK_CVT ? SLACK_P6A : 0;
constexpr int SLACK_P1B_ITEMS = SLACK_CVT ? (3 + 32 * 3) * 256 - SLACK_P6_ITEMS - CVT_P0_ITEMS - SLACK_P1A_ITEMS : 0;
static_assert(SLACK_P1B_ITEMS >= 0, "slack split");

__device__ __forceinline__ CvtItem cvt_item_in(const CvtSrc& S, int id) { CvtItem it; it.keep = 0; it.W = (const GAS float*)S.w_in; it.WT = (GAS bf16*)S.Win_t; it.K = 1024; it.N = 6656; it.mode = 1; it.k0 = 64 * (id / 104); it.n0 = 64 * (id % 104); return it; }
__device__ __forceinline__ CvtItem cvt_item_rest(const CvtSrc& S, int id) {
    CvtItem it; it.keep = (KEEP_WD && (id >> 8) >= 67) ? 1 : 0; it.K = 1024; it.N = 1024; const int mat = id >> 8, r = id & 255; it.k0 = 64 * (r >> 4); it.n0 = 64 * (r & 15);
    int si = mat, e = 0, which = 2;
    if (mat >= 67) { e = mat - 67; which = 2; si = 5; }
    else if (mat >= 3) { const int q = mat - 3; e = q >> 1; which = q & 1; si = 3 + which; }
    const unsigned long long ps = S.ptab[si], pd = S.ptab[6 + si];
    const unsigned long long psu = ((unsigned long long)__builtin_amdgcn_readfirstlane((unsigned)(ps >> 32)) << 32) | (unsigned)__builtin_amdgcn_readfirstlane((unsigned)ps);
    const unsigned long long pdu = ((unsigned long long)__builtin_amdgcn_readfirstlane((unsigned)(pd >> 32)) << 32) | (unsigned)__builtin_amdgcn_readfirstlane((unsigned)pd);
    it.W = (const GAS float*)psu + (size_t)e * 1048576; it.WT = (GAS bf16*)pdu + (size_t)e * (which < 2 ? 2097152 : 1048576);
    it.mode = mat < 3 ? 0 : (which == 0 ? 2 : which == 1 ? 3 : (ADJ_DOWN ? 4 : 0));
    return it;
}
template <int SET> __device__ __forceinline__ void cvt_run(const CvtSrc& S, int first, int stride, int n_items, LAS unsigned char* scr, int lane, int base = 0) {
    f32x4 r0[16], r1[16]; CvtItem i0, i1;
    int id = first; if (id >= n_items) return;
    i0 = SET == 0 ? cvt_item_in(S, id) : cvt_item_rest(S, base + id); cvt_load(r0, i0, lane);
    for (;;) {
        const int idn = id + stride;
        if (idn >= n_items) { cvt_store(r0, i0, scr, lane, S.gl); break; }
        i1 = SET == 0 ? cvt_item_in(S, idn) : cvt_item_rest(S, base + idn); cvt_load(r1, i1, lane); cvt_store(r0, i0, scr, lane, S.gl);
        id = idn + stride;
        if (id >= n_items) { cvt_store(r1, i1, scr, lane, S.gl); break; }
        i0 = SET == 0 ? cvt_item_in(S, id) : cvt_item_rest(S, base + id); cvt_load(r0, i0, lane); cvt_store(r1, i1, scr, lane, S.gl);
    }
}

__device__ __forceinline__ void cvt_run_pool(const CvtSrc& S, unsigned* counter, int x, int nx, int n_items, LAS unsigned char* scr, int lane, int base) {
    f32x4 r0[16], r1[16]; CvtItem i0, i1;
#define POOL_PULL() ((lane == 0) ? __hip_atomic_fetch_add(counter, 1u, __ATOMIC_RELAXED, __HIP_MEMORY_SCOPE_AGENT) : 0u)
#define POOL_ID(v_) ((int)__builtin_amdgcn_readfirstlane(v_) * nx + x)
    unsigned pa = POOL_PULL();
    int id = POOL_ID(pa); if (id >= n_items) return;
    pa = POOL_PULL();
    i0 = cvt_item_rest(S, base + id); cvt_load(r0, i0, lane);
    for (;;) {
        const int id1 = POOL_ID(pa); pa = POOL_PULL();
        if (id1 >= n_items) { cvt_store(r0, i0, scr, lane, S.gl); break; }
        i1 = cvt_item_rest(S, base + id1); cvt_load(r1, i1, lane); cvt_store(r0, i0, scr, lane, S.gl);
        const int id0 = POOL_ID(pa); pa = POOL_PULL();
        if (id0 >= n_items) { cvt_store(r1, i1, scr, lane, S.gl); break; }
        i0 = cvt_item_rest(S, base + id0); cvt_load(r0, i0, lane); cvt_store(r1, i1, scr, lane, S.gl);
    }
#undef POOL_PULL
#undef POOL_ID
}

__device__ __forceinline__ void slack_convert(const CvtSrc& S, int U, int G, int c, int base, int n_items, LAS unsigned char* scr, int wave, int lane, bool others = false) {
    if (n_items <= 0) return;
    int rem = U % G; if (G - rem < G / 4) rem = 0;
    if (DBG_SLACK_REM > 0 && !others) rem = DBG_SLACK_REM;
    if (others) {
        if (rem == 0) { cvt_run<1>(S, c * NWAVES_C + wave, G * NWAVES_C, n_items, scr, lane, base); return; }
        if (c >= rem) return;
        cvt_run<1>(S, c * NWAVES_C + wave, rem * NWAVES_C, n_items, scr, lane, base); return; }
    const int ncv = G - rem;
    if (c < rem) return;
    if (DBG_SLACK_WAVES < 8) { if (wave >= DBG_SLACK_WAVES) return; cvt_run<1>(S, (c - rem) * DBG_SLACK_WAVES + wave, ncv * DBG_SLACK_WAVES, n_items, scr, lane, base); return; }
    cvt_run<1>(S, (c - rem) * NWAVES_C + wave, ncv * NWAVES_C, n_items, scr, lane, base);
}

__device__ __forceinline__ void rms_row_to_bf16(const float* xrow, const float* g, bf16* orow, int lane) {
    const GAS f32x4* xr = (const GAS f32x4*)xrow + lane; const GAS f32x4* gr = (const GAS f32x4*)g + lane;
    f32x4 v[4]; float s = 0.f;
#pragma unroll
    for (int j = 0; j < 4; ++j) { v[j] = __builtin_nontemporal_load(xr + 64 * j); s += (v[j].x * v[j].x + v[j].y * v[j].y) + (v[j].z * v[j].z + v[j].w * v[j].w); }
    const float rstd = 1.f / sqrtf(wave_sum(s) * (1.f / D) + RMS_EPS);
    GAS v2u* o8 = (GAS v2u*)orow + lane;
#pragma unroll
    for (int j = 0; j < 4; ++j) { const f32x4 gg = gr[64 * j]; v2u w; w.x = cvt_pk_bf16(v[j].x * rstd * gg.x, v[j].y * rstd * gg.y); w.y = cvt_pk_bf16(v[j].z * rstd * gg.z, v[j].w * rstd * gg.w); o8[64 * j] = w; }
}

struct DenseOrder {
    int nM, nN, G, c, K; const char* A; const char* B;
    __device__ __forceinline__ bool next(int i, pg8::Unit& u) const {
        if (!pg8::tile_of((long)i * G + c, nM, nN, u.pm, u.pn)) return false;
        u.e = 0; u.aux = 1; u.keep = false; u.rofs = 0; u.a = A + (size_t)u.pm * 256 * K * 2; u.b = B + (size_t)u.pn * 256 * K * 2; return true; }
    __device__ __forceinline__ unsigned tokoff(int, int) const { return 0u; }
    __device__ __forceinline__ void a_ready(const pg8::Unit&) const {}
    __device__ __forceinline__ void done(const pg8::Unit&) const {}
};
struct MergeOrder {
    int nM, nN, G, c, K; const char* A0; const char* B0; const char* A1; const char* B1;
    __device__ __forceinline__ bool next(int i, pg8::Unit& u) const {
        if (!pg8::tile_of((long)(i >> 1) * G + c, nM, nN, u.pm, u.pn)) return false;
        const int br = i & 1; u.e = 0; u.aux = br; u.keep = (br == 0); u.rofs = 0;
        u.a = (br ? A1 : A0) + (size_t)u.pm * 256 * K * 2; u.b = (br ? B1 : B0) + (size_t)u.pn * 256 * K * 2; return true; }
    __device__ __forceinline__ unsigned tokoff(int, int) const { return 0u; }
    __device__ __forceinline__ void a_ready(const pg8::Unit&) const {}
    __device__ __forceinline__ void done(const pg8::Unit&) const {}
};
struct MoeOrder {
    int MT, G, c; const char* XNb; const char* ACTb; const char* Wgu; const char* Wd; const LAS int* tile_e; const LAS unsigned* tok; unsigned* ready; unsigned* tmo; int part; int ulim;
    __device__ __forceinline__ bool next(int i, pg8::Unit& u) const {
        const long U1 = (long)MT * 8; const long L = (long)i * G + c + (part == 2 ? U1 : 0);
        if (part == 1 && L >= U1) return false;
        if (part == 2 && L - U1 >= ulim) return false;
        if (L < U1) { pg8::tile_of(L, MT, 8, u.pm, u.pn, WGM_MOE); const int e = __builtin_amdgcn_readfirstlane(tile_e[u.pm]);
            u.e = e; u.aux = 2; u.keep = false; u.rofs = 0; u.a = XNb; u.b = Wgu + (size_t)e * (2048 * 1024 * 2) + (size_t)u.pn * (256 * 1024 * 2); return true; }
        if (!pg8::tile_of(L - U1, MT, 4, u.pm, u.pn, WGM_MOE2)) return false;
        if (P7_REVERSE && part == 2) u.pm = MT - 1 - u.pm;
        const int e = __builtin_amdgcn_readfirstlane(tile_e[u.pm]);
        u.e = e; u.aux = 3; u.keep = false; u.rofs = 0; u.a = ACTb + (size_t)u.pm * (256 * 1024 * 2); u.b = Wd + (size_t)e * (1024 * 1024 * 2) + (size_t)u.pn * (256 * 1024 * 2); return true; }
    __device__ __forceinline__ unsigned tokoff(int i, int row) const { return (part != 2 && (long)i * G + c < (long)MT * 8) ? tok[i * 256 + row] : (unsigned)row * 2048u; }
    __device__ __forceinline__ void a_ready(const pg8::Unit& u) const {
        if (u.aux != 3 || part != 0) return;
        if (threadIdx.x < 64) {
            const unsigned long long t0 = __builtin_amdgcn_s_memrealtime(); unsigned polls = 0;
            while ((unsigned)__builtin_amdgcn_readfirstlane(__hip_atomic_load(ready + 64 * u.pm, __ATOMIC_RELAXED, __HIP_MEMORY_SCOPE_AGENT)) < 64u) {
                if ((++polls & 255u) == 0u && __builtin_amdgcn_readfirstlane(__hip_atomic_load(tmo, __ATOMIC_RELAXED, __HIP_MEMORY_SCOPE_AGENT)) != 0u) break;
                if (__builtin_amdgcn_s_memrealtime() - t0 > 2000000ull) { if (threadIdx.x == 0) __hip_atomic_store(tmo, 1u, __ATOMIC_RELAXED, __HIP_MEMORY_SCOPE_AGENT); break; }
                __builtin_amdgcn_s_sleep(2); }
            __builtin_amdgcn_fence(__ATOMIC_ACQUIRE, "agent");
            asm volatile("s_waitcnt vmcnt(0)" ::: "memory");
        }
        asm volatile("" ::: "memory"); __builtin_amdgcn_s_barrier(); asm volatile("" ::: "memory");
    }
    __device__ __forceinline__ void done(const pg8::Unit& u) const {
        if (u.aux != 2 || part != 0) return;
        asm volatile("s_waitcnt vmcnt(0)" ::: "memory");
        if ((threadIdx.x & 63) == 0) __hip_atomic_fetch_add(ready + 64 * u.pm, 1u, __ATOMIC_RELAXED, __HIP_MEMORY_SCOPE_AGENT);
    }
};

struct TailOrder {
    int MT, ubase, c; const char* ACTb; const char* Wd; const LAS int* tile_e;
    __device__ __forceinline__ bool next(int i, pg8::Unit& u) const {
        if (i != 0 || !pg8::tile_of((long)ubase + (c >> 1), MT, 4, u.pm, u.pn, WGM_MOE2)) return false;
        const int e = __builtin_amdgcn_readfirstlane(tile_e[u.pm]);
        u.e = e; u.aux = 4; u.keep = false; u.rofs = 128 * (c & 1); u.a = ACTb + ((size_t)u.pm * 256 + 128 * (c & 1)) * (1024 * 2);     u.b = Wd + (size_t)e * (1024 * 1024 * 2) + (size_t)u.pn * (256 * 1024 * 2); return true; }
    __device__ __forceinline__ unsigned tokoff(int, int row) const { return (unsigned)(128 * (c & 1) + (row & 127)) * 2048u; }
    __device__ __forceinline__ void a_ready(const pg8::Unit&) const {}
    __device__ __forceinline__ void done(const pg8::Unit&) const {}
};

using pg8::f32x4; using pg8::Unit;
struct EpiInProj {
    static constexpr bool PERM = true;
    __device__ static __forceinline__ int nstores(const Unit&) { return 16; }
    bf16 *Q, *Kb, *Vb, *CB, *U, *SA, *SC; const float* bias; const float* cosT; const float* sinT; const float* rstd0;
    __device__ __forceinline__ const float* bias_row(const Unit& u) const { return bias + u.pn * 256; }
    __device__ __forceinline__ const float* aux_row(const Unit& u) const { return FOLD_GMIX ? rstd0 + u.pm * 256 : nullptr; }
    __device__ __forceinline__ void operator()(const f32x4 (&acc)[2][2][4][2], const Unit& u, int wr, int wc, int fr, int fq, const LAS float* bl) const {
        const int pn = u.pn, row0 = u.pm * 256 + wr * 64 + fr, cl0 = wc * 32 + 8 * fq;
        f32x4 bv[2][2];
#pragma unroll
        for (int bj = 0; bj < 2; ++bj)
#pragma unroll
            for (int n = 0; n < 2; ++n) bv[bj][n] = *(const LAS f32x4*)(bl + cl0 + bj * 128 + 4 * n);
        float rsv[2][4];
#pragma unroll
        for (int ai = 0; ai < 2; ++ai)
#pragma unroll
            for (int m = 0; m < 4; ++m) rsv[ai][m] = FOLD_GMIX ? bl[256 + wr * 64 + fr + ai * 128 + m * 16] : 1.0f;
        if (pn < 5) {
            bf16* base = pn < 4 ? Q : Kb; const int ld = pn < 4 ? 1024 : 256, colt = pn < 4 ? pn * 256 : 0; const float sc = pn < 4 ? QSCALE : 1.0f;
            const int i0 = 16 * (wc & 1) + 4 * fq;
#pragma unroll
            for (int ai = 0; ai < 2; ++ai) {
                f32x4 c4a[4], s4a[4];
#pragma unroll
                for (int m = 0; m < 4; ++m) { const int pos = (row0 + ai * 128 + m * 16) & (SEQ - 1); c4a[m] = *(const f32x4*)(cosT + pos * 32 + i0); s4a[m] = *(const f32x4*)(sinT + pos * 32 + i0); }
                ROPE_SB;
#pragma unroll
                for (int m = 0; m < 4; ++m) { const int row = row0 + ai * 128 + m * 16;
                    const f32x4 c4 = c4a[m] * sc, s4 = s4a[m] * sc;
#pragma unroll
                    for (int bj = 0; bj < 2; ++bj) { const f32x4 t1 = acc[ai][bj][m][0] * rsv[ai][m] + bv[bj][0], t2 = acc[ai][bj][m][1] * rsv[ai][m] + bv[bj][1];
                        const f32x4 o1 = t1 * c4 - t2 * s4, o2 = t2 * c4 + t1 * s4;
                        v4u w; w.x = cvt_pk_bf16(o1[0], o1[1]); w.y = cvt_pk_bf16(o1[2], o1[3]); w.z = cvt_pk_bf16(o2[0], o2[1]); w.w = cvt_pk_bf16(o2[2], o2[3]);
                        *(v4u*)(base + (size_t)row * ld + colt + cl0 + bj * 128) = w; } } }
        } else if (HALF_PAIR && pn >= 10 && pn < 18) {
            const int colt = (pn - 10) * 128 + cl0;
#pragma unroll
            for (int ai = 0; ai < 2; ++ai)
#pragma unroll
                for (int m = 0; m < 4; ++m) { const int row = row0 + ai * 128 + m * 16;
                    const f32x4 p0 = (acc[ai][0][m][0] * rsv[ai][m] + bv[0][0]) * (acc[ai][1][m][0] * rsv[ai][m] + bv[1][0]), p1 = (acc[ai][0][m][1] * rsv[ai][m] + bv[0][1]) * (acc[ai][1][m][1] * rsv[ai][m] + bv[1][1]);
                    v4u w; w.x = cvt_pk_bf16(p0[0], p0[1]); w.y = cvt_pk_bf16(p0[2], p0[3]); w.z = cvt_pk_bf16(p1[0], p1[1]); w.w = cvt_pk_bf16(p1[2], p1[3]);
                    *(v4u*)(U + (size_t)row * 1024 + colt) = w; }
        } else if (HALF_PAIR && pn >= 18) {
            const int colt = (pn - 18) * 128 + cl0;
#pragma unroll
            for (int ai = 0; ai < 2; ++ai)
#pragma unroll
                for (int m = 0; m < 4; ++m) { const int row = row0 + ai * 128 + m * 16; v4u wr_, ws_;
#pragma unroll
                    for (int n = 0; n < 2; ++n) { const f32x4 a4 = acc[ai][0][m][n] * rsv[ai][m] + bv[0][n], c4 = acc[ai][1][m][n] * rsv[ai][m] + bv[1][n]; f32x4 r4, s4;
#pragma unroll
                        for (int q = 0; q < 4; ++q) { const float ea = __builtin_amdgcn_exp2f(a4[q] * -1.4426950408889634f), ec = __builtin_amdgcn_exp2f(c4[q] * -1.4426950408889634f);
                            s4[q] = fmaxf(__builtin_amdgcn_rcpf(1.0f + ec), 1e-20f); r4[q] = (1.0f + ec) * __builtin_amdgcn_rcpf(1.0f + ea); r4[q] = fminf(r4[q], 1e20f); }
                        if (n == 0) { wr_.x = cvt_pk_bf16(r4[0], r4[1]); wr_.y = cvt_pk_bf16(r4[2], r4[3]); ws_.x = cvt_pk_bf16(s4[0], s4[1]); ws_.y = cvt_pk_bf16(s4[2], s4[3]); }
                        else { wr_.z = cvt_pk_bf16(r4[0], r4[1]); wr_.w = cvt_pk_bf16(r4[2], r4[3]); ws_.z = cvt_pk_bf16(s4[0], s4[1]); ws_.w = cvt_pk_bf16(s4[2], s4[3]); } }
                    *(v4u*)(SA + (size_t)row * 1024 + colt) = wr_; *(v4u*)(SC + (size_t)row * 1024 + colt) = ws_; }
        } else if (pn >= 10 && pn < 18) {
            const int colt = (pn - 10) * 128 + (cl0 >> 1);
#pragma unroll
            for (int ai = 0; ai < 2; ++ai)
#pragma unroll
                for (int m = 0; m < 4; ++m) { const int row = row0 + ai * 128 + m * 16;
#pragma unroll
                    for (int bj = 0; bj < 2; ++bj) { const f32x4 p = (acc[ai][bj][m][0] * rsv[ai][m] + bv[bj][0]) * (acc[ai][bj][m][1] * rsv[ai][m] + bv[bj][1]);
                        v2u w; w.x = cvt_pk_bf16(p[0], p[1]); w.y = cvt_pk_bf16(p[2], p[3]);
                        *(v2u*)(U + (size_t)row * 1024 + colt + bj * 64) = w; } }
        } else if (pn >= 18) {
            const int colt = (pn - 18) * 128 + (cl0 >> 1);
#pragma unroll
            for (int ai = 0; ai < 2; ++ai)
#pragma unroll
                for (int m = 0; m < 4; ++m) { const int row = row0 + ai * 128 + m * 16;
#pragma unroll
                    for (int bj = 0; bj < 2; ++bj) { const f32x4 a4 = acc[ai][bj][m][0] * rsv[ai][m] + bv[bj][0], c4 = acc[ai][bj][m][1] * rsv[ai][m] + bv[bj][1]; f32x4 r4, s4;
#pragma unroll
                        for (int q = 0; q < 4; ++q) { const float ea = __builtin_amdgcn_exp2f(a4[q] * -1.4426950408889634f), ec = __builtin_amdgcn_exp2f(c4[q] * -1.4426950408889634f);
                            s4[q] = fmaxf(__builtin_amdgcn_rcpf(1.0f + ec), 1e-20f); r4[q] = (1.0f + ec) * __builtin_amdgcn_rcpf(1.0f + ea); r4[q] = fminf(r4[q], 1e20f); }
                        v2u wr_, ws_; wr_.x = cvt_pk_bf16(r4[0], r4[1]); wr_.y = cvt_pk_bf16(r4[2], r4[3]); ws_.x = cvt_pk_bf16(s4[0], s4[1]); ws_.y = cvt_pk_bf16(s4[2], s4[3]);
                        *(v2u*)(SA + (size_t)row * 1024 + colt + bj * 64) = wr_; *(v2u*)(SC + (size_t)row * 1024 + colt + bj * 64) = ws_; } }
        } else {
            bf16* base; int ld = 1024, colt; const bool sg = false;
            if (pn == 5) { base = Vb; ld = 256; colt = 0; }
            else { base = CB; colt = (pn - 6) * 256; }
#pragma unroll
            for (int ai = 0; ai < 2; ++ai)
#pragma unroll
                for (int m = 0; m < 4; ++m) { const int row = row0 + ai * 128 + m * 16;
#pragma unroll
                    for (int bj = 0; bj < 2; ++bj) { f32x4 v0 = acc[ai][bj][m][0] * rsv[ai][m] + bv[bj][0], v1 = acc[ai][bj][m][1] * rsv[ai][m] + bv[bj][1];
                        if (sg) {
#pragma unroll
                            for (int q = 0; q < 4; ++q) { v0[q] = pg8::sigmoidf_(v0[q]); v1[q] = pg8::sigmoidf_(v1[q]); } }
                        v4u w; w.x = cvt_pk_bf16(v0[0], v0[1]); w.y = cvt_pk_bf16(v0[2], v0[3]); w.z = cvt_pk_bf16(v1[0], v1[1]); w.w = cvt_pk_bf16(v1[2], v1[3]);
                        *(v4u*)(base + (size_t)row * ld + colt + cl0 + bj * 128) = w; } }
        }
    }
};
struct EpiMerge {
    static constexpr bool PERM = true;
    __device__ static __forceinline__ int nstores(const Unit& u) { return u.aux == 0 ? 0 : 16; }
    const bf16 *SA, *SC; bf16* MG;
    __device__ __forceinline__ const float* bias_row(const Unit&) const { return nullptr; }
    __device__ __forceinline__ const float* aux_row(const Unit&) const { return nullptr; }
    __device__ __forceinline__ void operator()(f32x4 (&acc)[2][2][4][2], const Unit& u, int wr, int wc, int fr, int fq, const LAS float*) const {
        const int row0 = u.pm * 256 + wr * 64 + fr, col0 = u.pn * 256 + wc * 32 + 8 * fq;
        const bf16* G = u.aux == 0 ? SA : SC;
        v4u gv[2][4][2];
#pragma unroll
        for (int ai = 0; ai < 2; ++ai)
#pragma unroll
            for (int m = 0; m < 4; ++m)
#pragma unroll
                for (int bj = 0; bj < 2; ++bj) gv[ai][m][bj] = *(const v4u*)(G + (size_t)(row0 + ai * 128 + m * 16) * 1024 + col0 + bj * 128);
#pragma unroll
        for (int ai = 0; ai < 2; ++ai)
#pragma unroll
            for (int m = 0; m < 4; ++m)
#pragma unroll
                for (int bj = 0; bj < 2; ++bj) { const v4u c = gv[ai][m][bj];
                    const f32x4 c0 = {bf_lo(c.x), bf_hi(c.x), bf_lo(c.y), bf_hi(c.y)}, c1 = {bf_lo(c.z), bf_hi(c.z), bf_lo(c.w), bf_hi(c.w)};
                    const f32x4 v0 = acc[ai][bj][m][0] * c0, v1 = acc[ai][bj][m][1] * c1;
                    if (u.aux == 0) { acc[ai][bj][m][0] = v0; acc[ai][bj][m][1] = v1; }
                    else { v4u w; w.x = cvt_pk_bf16(v0[0], v0[1]); w.y = cvt_pk_bf16(v0[2], v0[3]); w.z = cvt_pk_bf16(v1[0], v1[1]); w.w = cvt_pk_bf16(v1[2], v1[3]);
                        *(v4u*)(MG + (size_t)(row0 + ai * 128 + m * 16) * 1024 + col0 + bj * 128) = w; } }
    }
};
struct EpiRes {
    static constexpr bool PERM = true;
    __device__ static __forceinline__ int nstores(const Unit&) { return 16; }
    bf16* DL;
    __device__ __forceinline__ const float* bias_row(const Unit&) const { return nullptr; }
    __device__ __forceinline__ const float* aux_row(const Unit&) const { return nullptr; }
    __device__ __forceinline__ void operator()(const f32x4 (&acc)[2][2][4][2], const Unit& u, int wr, int wc, int fr, int fq, const LAS float*) const {
        const int row0 = u.pm * 256 + wr * 64 + fr, col0 = u.pn * 256 + wc * 32 + 8 * fq;
        if (FUSE_RES) {
            v4u xv[2][4][2];
#pragma unroll
            for (int ai = 0; ai < 2; ++ai)
#pragma unroll
                for (int m = 0; m < 4; ++m)
#pragma unroll
                    for (int bj = 0; bj < 2; ++bj) xv[ai][m][bj] = *(const v4u*)(DL + (size_t)(row0 + ai * 128 + m * 16) * 1024 + col0 + bj * 128);
#pragma unroll
            for (int ai = 0; ai < 2; ++ai)
#pragma unroll
                for (int m = 0; m < 4; ++m)
#pragma unroll
                    for (int bj = 0; bj < 2; ++bj) { const v4u c = xv[ai][m][bj];
                        const f32x4 c0 = {bf_lo(c.x), bf_hi(c.x), bf_lo(c.y), bf_hi(c.y)}, c1 = {bf_lo(c.z), bf_hi(c.z), bf_lo(c.w), bf_hi(c.w)};
                        const f32x4 v0 = acc[ai][bj][m][0] + c0, v1 = acc[ai][bj][m][1] + c1;
                        v4u w; w.x = cvt_pk_bf16(v0[0], v0[1]); w.y = cvt_pk_bf16(v0[2], v0[3]); w.z = cvt_pk_bf16(v1[0], v1[1]); w.w = cvt_pk_bf16(v1[2], v1[3]);
                        *(v4u*)(DL + (size_t)(row0 + ai * 128 + m * 16) * 1024 + col0 + bj * 128) = w; }
            return;
        }
#pragma unroll
        for (int ai = 0; ai < 2; ++ai)
#pragma unroll
            for (int m = 0; m < 4; ++m) { bf16* rp = DL + (size_t)(row0 + ai * 128 + m * 16) * 1024 + col0;
#pragma unroll
                for (int bj = 0; bj < 2; ++bj) { const f32x4 v0 = acc[ai][bj][m][0], v1 = acc[ai][bj][m][1];
                    v4u w; w.x = cvt_pk_bf16(v0[0], v0[1]); w.y = cvt_pk_bf16(v0[2], v0[3]); w.z = cvt_pk_bf16(v1[0], v1[1]); w.w = cvt_pk_bf16(v1[2], v1[3]);
                    *(v4u*)(rp + bj * 128) = w; } }
    }
};
struct EpiGU {
    static constexpr bool PERM = true;
    __device__ static __forceinline__ int nstores(const Unit&) { return 16; }
    bf16* ACT; const float* bgu; const float* rstdrel; const LAS int* tst;
    __device__ __forceinline__ const float* bias_row(const Unit& u) const { return bgu + (size_t)u.e * 2048 + u.pn * 256; }
    __device__ __forceinline__ const float* aux_row(const Unit& u) const { return P5_MFMA ? rstdrel + (size_t)u.e * SLOTCAP + (u.pm - tst[u.e]) * 256 : nullptr; }
    __device__ __forceinline__ void operator()(const f32x4 (&acc)[2][2][4][2], const Unit& u, int wr, int wc, int fr, int fq, const LAS float* bl) const {
        const int row0 = u.pm * 256 + wr * 64 + fr, cl0 = u.pn * 256 + wc * 32 + 8 * fq;
        const LAS float* bb = bl + wc * 32 + 8 * fq;
        f32x4 bv[2][2];
#pragma unroll
        for (int bj = 0; bj < 2; ++bj)
#pragma unroll
            for (int n = 0; n < 2; ++n) bv[bj][n] = *(const LAS f32x4*)(bb + bj * 128 + 4 * n);
        if (HALF_PAIR && !MOE_MERGED) {
#pragma unroll
            for (int ai = 0; ai < 2; ++ai)
#pragma unroll
                for (int m = 0; m < 4; ++m) { bf16* rp = ACT + (size_t)(row0 + ai * 128 + m * 16) * 1024 + u.pn * 128 + wc * 32 + 8 * fq;
                    const float rs = P5_MFMA ? bl[256 + wr * 64 + fr + ai * 128 + m * 16] : 1.0f; f32x4 o[2];
#pragma unroll
                    for (int n = 0; n < 2; ++n) { const f32x4 g4 = acc[ai][0][m][n] * rs + bv[0][n], u4 = acc[ai][1][m][n] * rs + bv[1][n];
#pragma unroll
                        for (int q = 0; q < 4; ++q) { const float g = __builtin_amdgcn_fmed3f(g4[q], -3.0e38f, 7.0f), uu = __builtin_amdgcn_fmed3f(u4[q], -7.0f, 7.0f);
                            o[n][q] = g * __builtin_amdgcn_rcpf(1.0f + __builtin_amdgcn_exp2f(g * -2.4554669595930157f)) * (uu + 1.0f); } }
                    v4u w; w.x = cvt_pk_bf16(o[0][0], o[0][1]); w.y = cvt_pk_bf16(o[0][2], o[0][3]); w.z = cvt_pk_bf16(o[1][0], o[1][1]); w.w = cvt_pk_bf16(o[1][2], o[1][3]);
                    *(v4u*)rp = w; }
            return;
        }
#pragma unroll
        for (int ai = 0; ai < 2; ++ai)
#pragma unroll
            for (int m = 0; m < 4; ++m) { bf16* rp = ACT + (size_t)(row0 + ai * 128 + m * 16) * 1024 + (cl0 >> 1);
                const float rs = P5_MFMA ? bl[256 + wr * 64 + fr + ai * 128 + m * 16] : 1.0f;
#pragma unroll
                for (int bj = 0; bj < 2; ++bj) { const f32x4 g4 = acc[ai][bj][m][0] * rs + bv[bj][0], u4 = acc[ai][bj][m][1] * rs + bv[bj][1]; f32x4 o;
#pragma unroll
                    for (int q = 0; q < 4; ++q) { const float g = __builtin_amdgcn_fmed3f(g4[q], -3.0e38f, 7.0f), uu = __builtin_amdgcn_fmed3f(u4[q], -7.0f, 7.0f);
                        o[q] = g * __builtin_amdgcn_rcpf(1.0f + __builtin_amdgcn_exp2f(g * -2.4554669595930157f)) * (uu + 1.0f); }
                    if (MOE_MERGED) { const unsigned long long w = (unsigned long long)cvt_pk_bf16(o[0], o[1]) | ((unsigned long long)cvt_pk_bf16(o[2], o[3]) << 32);
                        __hip_atomic_store((unsigned long long*)(rp + bj * 64), w, __ATOMIC_RELAXED, __HIP_MEMORY_SCOPE_AGENT); }
                    else { v2u w; w.x = cvt_pk_bf16(o[0], o[1]); w.y = cvt_pk_bf16(o[2], o[3]); *(v2u*)(rp + bj * 64) = w; } } }
    }
};
struct EpiDown {
    static constexpr bool PERM = true;
    __device__ static __forceinline__ int nstores(const Unit&) { return 16; }
    bf16* Y; const float* bd;
    __device__ __forceinline__ const float* bias_row(const Unit& u) const { return bd + (size_t)u.e * 1024 + u.pn * 256; }
    __device__ __forceinline__ const float* aux_row(const Unit&) const { return nullptr; }
    __device__ __forceinline__ void operator()(const f32x4 (&acc)[2][2][4][2], const Unit& u, int wr, int wc, int fr, int fq, const LAS float* bl) const {
        constexpr int WCS = ADJ_DOWN ? 64 : 32, BJS = ADJ_DOWN ? 32 : 128;
        const int row0 = u.pm * 256 + wr * 64 + fr, cl0 = u.pn * 256 + wc * WCS + 8 * fq;
        const LAS float* bb = bl + wc * WCS + 8 * fq;
        f32x4 bv[2][2];
#pragma unroll
        for (int bj = 0; bj < 2; ++bj)
#pragma unroll
            for (int n = 0; n < 2; ++n) bv[bj][n] = *(const LAS f32x4*)(bb + bj * BJS + 4 * n);
#pragma unroll
        for (int ai = 0; ai < 2; ++ai)
#pragma unroll
            for (int m = 0; m < 4; ++m) { bf16* rp = Y + (size_t)(row0 + ai * 128 + m * 16) * 1024 + cl0;
#pragma unroll
                for (int bj = 0; bj < 2; ++bj) { const f32x4 v0 = acc[ai][bj][m][0] + bv[bj][0], v1 = acc[ai][bj][m][1] + bv[bj][1];
                    v4u w; w.x = cvt_pk_bf16(v0[0], v0[1]); w.y = cvt_pk_bf16(v0[2], v0[3]); w.z = cvt_pk_bf16(v1[0], v1[1]); w.w = cvt_pk_bf16(v1[2], v1[3]);
                    *(v4u*)(rp + bj * BJS) = w; } }
    }
    __device__ __forceinline__ void half(const f32x4 (&acc)[2][2][4][2], const Unit& u, int wr, int wc, int fr, int fq, const LAS float* bl) const {
        constexpr int WCS = ADJ_DOWN ? 64 : 32, BJS = ADJ_DOWN ? 32 : 128;
        const int row0 = u.pm * 256 + u.rofs + wr * 64 + fr, cl0 = u.pn * 256 + wc * WCS + 8 * fq;
        const LAS float* bb = bl + wc * WCS + 8 * fq;
        f32x4 bv[2][2];
#pragma unroll
        for (int bj = 0; bj < 2; ++bj)
#pragma unroll
            for (int n = 0; n < 2; ++n) bv[bj][n] = *(const LAS f32x4*)(bb + bj * BJS + 4 * n);
#pragma unroll
        for (int m = 0; m < 4; ++m) { bf16* rp = Y + (size_t)(row0 + m * 16) * 1024 + cl0;
#pragma unroll
            for (int bj = 0; bj < 2; ++bj) { const f32x4 v0 = acc[0][bj][m][0] + bv[bj][0], v1 = acc[0][bj][m][1] + bv[bj][1];
                v4u w; w.x = cvt_pk_bf16(v0[0], v0[1]); w.y = cvt_pk_bf16(v0[2], v0[3]); w.z = cvt_pk_bf16(v1[0], v1[1]); w.w = cvt_pk_bf16(v1[2], v1[3]);
                *(v4u*)(rp + bj * BJS) = w; } }
    }
};
struct EpiDownX {
    static constexpr bool PERM = true;
    __device__ static __forceinline__ int nstores(const Unit&) { return 0; }
    EpiDown dn;
    __device__ __forceinline__ const float* bias_row(const Unit& u) const { return dn.bias_row(u); }
    __device__ __forceinline__ const float* aux_row(const Unit&) const { return nullptr; }
    __device__ __forceinline__ void operator()(const f32x4 (&acc)[2][2][4][2], const Unit& u, int wr, int wc, int fr, int fq, const LAS float* bl) const { if (u.aux == 4) dn.half(acc, u, wr, wc, fr, fq, bl); else dn(acc, u, wr, wc, fr, fq, bl); }
};
struct EpiMoe {
    static constexpr bool PERM = true;
    __device__ static __forceinline__ int nstores(const Unit&) { return MOE_MERGED ? 0 : 16; }
    EpiGU gu; EpiDown dn;
    __device__ __forceinline__ const float* bias_row(const Unit& u) const { return u.aux == 2 ? gu.bias_row(u) : dn.bias_row(u); }
    __device__ __forceinline__ const float* aux_row(const Unit& u) const { return u.aux == 2 ? gu.aux_row(u) : nullptr; }
    __device__ __forceinline__ void operator()(const f32x4 (&acc)[2][2][4][2], const Unit& u, int wr, int wc, int fr, int fq, const LAS float* bl) const { if (u.aux == 2) gu(acc, u, wr, wc, fr, fq, bl); else if (u.aux == 4) dn.half(acc, u, wr, wc, fr, fq, bl); else dn(acc, u, wr, wc, fr, fq, bl); }
};

namespace att {
constexpr int KS_STRIDE = 144, VT_STRIDE = 520;
constexpr int L_KS = 0, L_VT = 36864, L_ST = 70144, L_SC = 102912, L_END = 103936;
static_assert(L_VT == 256 * KS_STRIDE && L_ST == L_VT + 64 * VT_STRIDE && L_END <= RING_BYTES, "attention LDS map");
__device__ __forceinline__ int crow(int r, int hi) { return (r & 3) + 8 * (r >> 2) + 4 * hi; }

struct KVRegs { v4u k[4], v[4]; };
__device__ __forceinline__ void attn_load(KVRegs& R, int uu, const bf16* Kb, const bf16* Vb) {
    const int tid = threadIdx.x, n = uu & 63, kvh = (uu >> 6) & 3, b = uu >> 8, tokbase = b * SEQ, r0 = 128 * (n - 1);
#pragma unroll
    for (int it = 0; it < 4; ++it) { const int p = tid + 512 * it, row = p >> 3, ch = p & 7; int pos = r0 + row; pos = pos < 0 ? 0 : pos;
        R.k[it] = *(const v4u*)(Kb + (size_t)(tokbase + pos) * KVW + kvh * 64 + ch * 8); }
#pragma unroll
    for (int it = 0; it < 4; ++it) { const int p = tid + 512 * it, key = p & 255, c = p >> 8; int pos = r0 + key; pos = pos < 0 ? 0 : pos;
        R.v[it] = *(const v4u*)(Vb + (size_t)(tokbase + pos) * KVW + kvh * 64 + c * 8); }
}
__device__ __forceinline__ void attn_store(const KVRegs& R, LAS unsigned char* lds) {
    const int tid = threadIdx.x;
#pragma unroll
    for (int it = 0; it < 4; ++it) { const int p = tid + 512 * it, row = p >> 3, ch = p & 7; *(LAS v4u*)(lds + L_KS + row * KS_STRIDE + ch * 16) = R.k[it]; }
#pragma unroll
    for (int it = 0; it < 4; ++it) { const int p = tid + 512 * it, key = p & 255, c = p >> 8; const v4u v = R.v[it];
        LAS unsigned short* vt = (LAS unsigned short*)(lds + L_VT + (8 * c) * VT_STRIDE + key * 2);
        vt[0 * (VT_STRIDE / 2)] = (unsigned short)(v.x & 0xffffu); vt[1 * (VT_STRIDE / 2)] = (unsigned short)(v.x >> 16);
        vt[2 * (VT_STRIDE / 2)] = (unsigned short)(v.y & 0xffffu); vt[3 * (VT_STRIDE / 2)] = (unsigned short)(v.y >> 16);
        vt[4 * (VT_STRIDE / 2)] = (unsigned short)(v.z & 0xffffu); vt[5 * (VT_STRIDE / 2)] = (unsigned short)(v.z >> 16);
        vt[6 * (VT_STRIDE / 2)] = (unsigned short)(v.w & 0xffffu); vt[7 * (VT_STRIDE / 2)] = (unsigned short)(v.w >> 16); }
}
struct ConvCtx { const bf16* Ub; bf16* CB; const LAS float* w; int c0, row; bool on; v4u um2, um1; };
struct ConvB { v4u u[4], cb[4]; };
__device__ __forceinline__ void conv_issue(ConvB& B, const ConvCtx& C) {
#pragma unroll
    for (int r = 0; r < 4; ++r) { const size_t off = (size_t)(C.row + r) * 1024 + C.c0; B.u[r] = *(const v4u*)(C.Ub + off); B.cb[r] = *(const v4u*)(C.CB + off); }
}
__device__ __forceinline__ void conv_finish(const ConvB& B, ConvCtx& C) {
    float w0[8], w1[8], w2[8];
    { const f32x4 a0 = *(const LAS f32x4*)(C.w + C.c0), a1 = *(const LAS f32x4*)(C.w + C.c0 + 4), b0 = *(const LAS f32x4*)(C.w + 1024 + C.c0), b1 = *(const LAS f32x4*)(C.w + 1024 + C.c0 + 4),
                  c0_ = *(const LAS f32x4*)(C.w + 2048 + C.c0), c1_ = *(const LAS f32x4*)(C.w + 2048 + C.c0 + 4);
#pragma unroll
      for (int q = 0; q < 4; ++q) { w0[q] = a0[q]; w0[q + 4] = a1[q]; w1[q] = b0[q]; w1[q + 4] = b1[q]; w2[q] = c0_[q]; w2[q + 4] = c1_[q]; } }
#pragma unroll
    for (int r = 0; r < 4; ++r) { const v4u u0 = B.u[r], cb = B.cb[r], um2 = C.um2, um1 = C.um1; v4u o;
#define CONV2(F, qa) cvt_pk_bf16(bf_lo(cb.F) * (w0[qa] * bf_lo(um2.F) + w1[qa] * bf_lo(um1.F) + w2[qa] * bf_lo(u0.F)), bf_hi(cb.F) * (w0[qa + 1] * bf_hi(um2.F) + w1[qa + 1] * bf_hi(um1.F) + w2[qa + 1] * bf_hi(u0.F)))
        o.x = CONV2(x, 0); o.y = CONV2(y, 2); o.z = CONV2(z, 4); o.w = CONV2(w, 6);
#undef CONV2
        if (C.on) { *(v4u*)(C.CB + (size_t)(C.row + r) * 1024 + C.c0) = o; C.um2 = um1; C.um1 = u0; } }
    if (C.on) C.row += 4;
}
template <int SUB> __device__ __forceinline__ void attn_sub(LAS unsigned char* lds, int uu, int un, KVRegs& R, const bf16* Q, const bf16* Kb, const bf16* Vb, bf16* O, float sinkv, int hq, ConvCtx& CV) {
    const int tid = threadIdx.x, lane = tid & 63, r32 = lane & 31, hi = lane >> 5, wid = __builtin_amdgcn_readfirstlane(tid >> 6);
    const int n = uu & 63, b = uu >> 8, tokbase = b * SEQ;
    LAS float* scr = (LAS float*)(lds + L_SC + wid * 128);
    LAS unsigned short* stg = (LAS unsigned short*)(lds + L_ST + wid * 4096);
    {
        const int q0 = 64 * (wid & 1) + 32 * SUB, tb = q0 >> 5;
        const size_t qtok = (size_t)tokbase + 128 * n + q0;
        bf16x8 qf[4];
#pragma unroll
        for (int s = 0; s < 4; ++s) qf[s] = *(const bf16x8*)(Q + (qtok + r32) * 1024 + hq * 64 + 16 * s + 8 * hi);
        if constexpr (SUB == 0) { if (KV_PREFETCH) attn_load(R, un, Kb, Vb); }
        ConvB CBt; conv_issue(CBt, CV);
        f32x16 sc[5];
#pragma unroll
        for (int i = 0; i < 5; ++i) { f32x16 a = {};
#pragma unroll
            for (int s = 0; s < 4; ++s) { const bf16x8 kf = *(const LAS bf16x8*)(lds + L_KS + (32 * (tb + i) + r32) * KS_STRIDE + (16 * s + 8 * hi) * 2);
                a = __builtin_amdgcn_mfma_f32_32x32x16_bf16(kf, qf[s], a, 0, 0, 0); }
            sc[i] = a; }
#pragma unroll
        for (int r = 0; r < 16; ++r) { const int kl = crow(r, hi);
            if (!(kl > r32)) sc[0][r] = -INFINITY;
            if (!(kl <= r32)) sc[4][r] = -INFINITY; }
        if (n == 0) {
#pragma unroll
            for (int i = 0; i < 4; ++i) if (tb + i < 4) {
#pragma unroll
                for (int r = 0; r < 16; ++r) sc[i][r] = -INFINITY; } }
        float mx = sinkv;
#pragma unroll
        for (int i = 0; i < 5; ++i)
#pragma unroll
            for (int r = 0; r < 16; ++r) mx = fmaxf(mx, sc[i][r]);
        mx = fmaxf(mx, __shfl_xor(mx, 32));
        float sum = 0.f;
#pragma unroll
        for (int i = 0; i < 5; ++i)
#pragma unroll
            for (int r = 0; r < 16; ++r) { const float p = __builtin_amdgcn_exp2f(sc[i][r] - mx); sc[i][r] = p; sum += p; }
        sum += __shfl_xor(sum, 32);
        const float denom = sum + __builtin_amdgcn_exp2f(sinkv - mx);
        if (hi == 0) scr[r32] = __builtin_amdgcn_rcpf(denom);
        f32x16 o[2]; o[0] = f32x16{}; o[1] = f32x16{};
#pragma unroll
        for (int i = 0; i < 5; ++i)
#pragma unroll
            for (int s2 = 0; s2 < 2; ++s2) {
                v4u pw; pw.x = cvt_pk_bf16(sc[i][8 * s2 + 0], sc[i][8 * s2 + 1]); pw.y = cvt_pk_bf16(sc[i][8 * s2 + 2], sc[i][8 * s2 + 3]);
                pw.z = cvt_pk_bf16(sc[i][8 * s2 + 4], sc[i][8 * s2 + 5]); pw.w = cvt_pk_bf16(sc[i][8 * s2 + 6], sc[i][8 * s2 + 7]);
                const bf16x8 pa = __builtin_bit_cast(bf16x8, pw);
                const int key0 = 32 * (tb + i) + 16 * s2 + 4 * hi;
#pragma unroll
                for (int dh = 0; dh < 2; ++dh) { const LAS unsigned char* vp = lds + L_VT + (32 * dh + r32) * VT_STRIDE + key0 * 2;
                    const s16x4 lo = *(const LAS s16x4*)vp, h4 = *(const LAS s16x4*)(vp + 16);
                    const bf16x8 vb = {lo[0], lo[1], lo[2], lo[3], h4[0], h4[1], h4[2], h4[3]};
                    o[dh] = __builtin_amdgcn_mfma_f32_32x32x16_bf16(pa, vb, o[dh], 0, 0, 0); } }
#pragma unroll
        for (int r = 0; r < 16; ++r) { const int orow = crow(r, hi); const float rl = scr[orow];
#pragma unroll
            for (int dh = 0; dh < 2; ++dh) stg[orow * 64 + dh * 32 + r32] = (unsigned short)(cvt_pk_bf16(o[dh][r] * rl, 0.f) & 0xffffu); }
        bf16* Ow = O + qtok * 1024 + hq * 64;
#pragma unroll
        for (int i = 0; i < 4; ++i) { const int row = i * 8 + (lane >> 3), ch = lane & 7; const v4u v = *(const LAS v4u*)(stg + row * 64 + ch * 8); *(v4u*)(Ow + (size_t)row * 1024 + ch * 8) = v; }
        conv_finish(CBt, CV);
    }
}
__device__ __forceinline__ void attn_compute(LAS unsigned char* lds, int uu, int un, KVRegs& R, const bf16* Q, const bf16* Kb, const bf16* Vb, bf16* O, const float* sinks, ConvCtx& CV) {
    const int wid = __builtin_amdgcn_readfirstlane(threadIdx.x >> 6), kvh = (uu >> 6) & 3, hq = 4 * kvh + (wid >> 1);
    const float sinkv = sinks[hq] * LOG2E;
    attn_sub<0>(lds, uu, un, R, Q, Kb, Vb, O, sinkv, hq, CV);
    attn_sub<1>(lds, uu, un, R, Q, Kb, Vb, O, sinkv, hq, CV);
    __syncthreads();
}
}

struct Args { const float* in[19]; float* out; unsigned char* ws; int ph_lo, ph_hi, li, pad; };

__global__ void __launch_bounds__(NWAVES * 64, 2) fwd_kernel(Args args) {
    extern __shared__ __attribute__((aligned(16))) unsigned char lds_raw[];
    LAS unsigned char* lds = (LAS unsigned char*)lds_raw;
    volatile LAS unsigned* MISC = (volatile LAS unsigned*)(lds + MISC_OFF);
    const int tid = threadIdx.x, lane = tid & 63, wave = __builtin_amdgcn_readfirstlane(tid >> 6);
    const int G = gridDim.x; const int bx = blockIdx.x; const int vcu = (G % 8 == 0) ? (bx % 8) * (G / 8) + bx / 8 : bx;
    unsigned char* ws = args.ws;
    gu32* ctl = (gu32*)(ws + WS_CTL);
    const float* x = args.in[0]; const float* g_mix = args.in[1]; const float* w_in = args.in[2]; const float* b_in = args.in[3]; const float* sinks = args.in[4];
    const float* w_conv = args.in[5]; const float* w_attn_o = args.in[6]; const float* w_conv_o = args.in[7]; const float* w_out = args.in[8]; const float* g_ffn = args.in[9];
    const float* w_router = args.in[10]; const float* b_router = args.in[11]; const float* w_gate = args.in[12]; const float* b_gate = args.in[13]; const float* w_up = args.in[14];
    const float* b_up = args.in[15]; const float* w_down = args.in[16]; const float* b_down = args.in[17]; const float* g_final = args.in[18];
    float* out = args.out;
    float* rstd0 = (float*)(ws + WS_RSTD0); float* binp = (float*)(ws + WS_BINP); float* bgu = (float*)(ws + WS_BGU); float* cosT = (float*)(ws + WS_COS); float* sinT = (float*)(ws + WS_SIN);
    bf16* Win_t = (bf16*)(ws + WS_WIN); bf16* Wao_t = (bf16*)(ws + WS_WAO); bf16* Wco_t = (bf16*)(ws + WS_WCO); bf16* Wout_t = (bf16*)(ws + WS_WOUT);
    bf16* XN = (bf16*)(ws + WS_XN); bf16* Qb = (bf16*)(ws + WS_Q); bf16* Kb = (bf16*)(ws + WS_K); bf16* Vb = (bf16*)(ws + WS_V); bf16* CB = (bf16*)(ws + WS_CB);
    bf16* MG = (bf16*)(ws + WS_MG); bf16* Ub = (bf16*)(ws + WS_U); bf16* SA = (bf16*)(ws + WS_SA); bf16* SC = (bf16*)(ws + WS_SC);
    bf16* Wgu_t = (bf16*)(ws + WS_WGU); bf16* Wd_t = (bf16*)(ws + WS_WD);
    int* tokrel = (int*)(ws + WS_TOKREL); float* rstdrel = (float*)(ws + WS_RSTDREL); unsigned* route = (unsigned*)(ws + WS_ROUTE); float* routew = (float*)(ws + WS_ROUTEW);
    bf16* ACT = (bf16*)(ws + WS_ACT); bf16* Yb = (bf16*)(ws + WS_Y); bf16* DLb = (bf16*)(ws + WS_DL);

    for (int u = tid; u < (LDS_BYTES - LDSCTL_OFF) / 4; u += NWAVES * 64) ((LAS unsigned*)(lds + LDSCTL_OFF))[u] = 0u;
    __syncthreads();
    XcdBarrier bar; bar.bar = (unsigned*)(ctl + CW_BAR); bar.x = 0; bar.st = nullptr;
    if (N_LAUNCHES != PER_PHASE) bar = xcd_barrier_post((unsigned*)(ctl + CW_BAR), MISC + 8);
#define GRID_BAR(seam) do { if (N_LAUNCHES == PER_PHASE) { if (tid == 0) __hip_atomic_store(ctl + CW_TMO, 0xBADBA0u | (unsigned)(seam), RLX_AGENT); } else { xcd_barrier(bar); } } while (0)
    const int lo = args.ph_lo, hi = args.ph_hi;
#define IN(k) (lo <= (k) && (k) < hi)
#define BOTH(k) (IN(k) && IN((k) + 1))
    const int gw = vcu * NWAVES + wave, NGW = G * NWAVES;
#define DBG_SPAN_BEGIN(id) unsigned dbg_sp_##id = 0; do { if (DBG_SPAN_ID == (id) && bx == DBG_BLK) dbg_sp_##id = (unsigned)__builtin_amdgcn_s_memrealtime(); } while (0)
#define DBG_SPAN_END(id) do { if (DBG_SPAN_ID == (id) && bx == DBG_BLK) { __syncthreads(); if (tid == 0) { __hip_atomic_store(ctl + CW_TS + 16, 0u, RLX_AGENT); __hip_atomic_store(ctl + CW_TS + 17, (unsigned)__builtin_amdgcn_s_memrealtime() - dbg_sp_##id, RLX_AGENT); } } } while (0)
#define BUSY_ON(k) (DBG_BUSY_PH == (k) && (DBG_SPAN_ID == 11 || DBG_SPAN_ID == 12))
#define BUSY_T0(k) const unsigned dbg_busy_##k = BUSY_ON(k) ? (unsigned)__builtin_amdgcn_s_memrealtime() : 0u
#define BUSY_END(k) do { if (BUSY_ON(k) && (DBG_SPAN_ID == 11 || bx == DBG_BLK) && tid == 0) __hip_atomic_fetch_max(ctl + CW_TS + 18, (((unsigned)__builtin_amdgcn_s_memrealtime() - dbg_busy_##k) << 9) | (unsigned)bx, RLX_AGENT); } while (0)
#define BUSY_READ(k) do { if (BUSY_ON(k) && bx == 0 && tid == 0) { const unsigned v = __hip_atomic_load(ctl + CW_TS + 18, RLX_AGENT); __hip_atomic_store(ctl + CW_TS + 16, 0u, RLX_AGENT); __hip_atomic_store(ctl + CW_TS + 17, (DBG_SPAN_ID == 11 && DBG_BLK) ? (v & 511u) * 100u : (v >> 9), RLX_AGENT); } } while (0)
#define STAMP(k) do { if ((DBG_TIME_PH >= 0 || DBG_RVR_PH >= 0) && (k) < 16 && bx == 0 && tid == 0) __hip_atomic_store(ctl + CW_TS + (k), (unsigned)__builtin_amdgcn_s_memrealtime(), RLX_AGENT); } while (0)
    STAMP(0);

    LAS unsigned long long* ptab = (LAS unsigned long long*)(lds + TAB_OFF + 1600);
    if (tid == 0) { ptab[0] = (unsigned long long)w_attn_o; ptab[1] = (unsigned long long)w_conv_o; ptab[2] = (unsigned long long)w_out; ptab[3] = (unsigned long long)w_gate; ptab[4] = (unsigned long long)w_up; ptab[5] = (unsigned long long)w_down;
        ptab[6] = (unsigned long long)Wao_t; ptab[7] = (unsigned long long)Wco_t; ptab[8] = (unsigned long long)Wout_t; ptab[9] = (unsigned long long)Wgu_t; ptab[10] = (unsigned long long)Wgu_t; ptab[11] = (unsigned long long)Wd_t; }
    __syncthreads();
    LAS float* gffl = (LAS float*)(lds + RING_OFF + 69632);
    const CvtSrc CS{w_in, Win_t, ptab, gffl};
    const int HELP = (HELPER_CUS > 0 && G == 256 && N_LAUNCHES == 1) ? HELPER_CUS : 0;
    if (IN(0)) {
        LAS unsigned char* scr = lds + RING_OFF + wave * 8704;
        for (int i = tid; i < 512; i += 512) *(LAS f32x4*)(gffl + 4 * i) = i < 256 ? *(const f32x4*)(g_ffn + 4 * i) : *(const f32x4*)(g_mix + 4 * (i - 256));
        __syncthreads();
        if (FUSE_RES && P5_MFMA && bx < 8) {
            const int f = wave, k0 = 128 * bx + 32 * (f >> 1) + 16 * (lane >> 5) + 8 * (f & 1); float wv[8];
#pragma unroll
            for (int j = 0; j < 8; ++j) wv[j] = w_router[(size_t)(k0 + j) * 32 + (lane & 31)] * g_ffn[k0 + j];
            v4u hw, lw;
#define SPLIT2(dsth, dstl, a_, b_) do { const unsigned h_ = cvt_pk_bf16(a_, b_); dsth = h_; dstl = cvt_pk_bf16((a_) - bf_lo(h_), (b_) - bf_hi(h_)); } while (0)
            SPLIT2(hw.x, lw.x, wv[0], wv[1]); SPLIT2(hw.y, lw.y, wv[2], wv[3]); SPLIT2(hw.z, lw.z, wv[4], wv[5]); SPLIT2(hw.w, lw.w, wv[6], wv[7]);
#undef SPLIT2
            v4u* rf = (v4u*)(ws + WS_RFRAG); rf[(bx * 8 + f) * 64 + lane] = hw; rf[4096 + (bx * 8 + f) * 64 + lane] = lw; }
        cvt_run<0>(CS, gw, NGW, CVT_IN_ITEMS, scr, lane);
        if (HELP == 0) cvt_run<1>(CS, gw, NGW, CVT_P0_ITEMS, scr, lane);
        const int gt = vcu * (NWAVES * 64) + tid, NGT = G * NWAVES * 64;
        for (int c = gt; c < NIN; c += NGT) binp[win_dest(c)] = b_in[c];
        for (int i = gt; i < NEXP * DFF; i += NGT) { const int e = i >> 10, c = i & 1023; bgu[e * 2048 + map_dest(2, c)] = b_gate[i]; bgu[e * 2048 + map_dest(3, c)] = b_up[i]; }
        for (int i = gt; i < SEQ * 32; i += NGT) { const int pos = i >> 5, f = i & 31;
            const double inv = exp2(-(double)f * (13.287712379549449 / 32.0));
            const double rev = (double)pos * inv * 0.15915494309189535; const float fr = (float)(rev - rint(rev));
            cosT[i] = __builtin_amdgcn_cosf(fr); sinT[i] = __builtin_amdgcn_sinf(fr); }
        if (FOLD_GMIX) { for (int m = gw; m < M; m += NGW) { const GAS f32x4* xr = (const GAS f32x4*)(x + (size_t)m * D) + lane; f32x4 v[4]; float s_ = 0.f;
#pragma unroll
                for (int j = 0; j < 4; ++j) { v[j] = __builtin_nontemporal_load(xr + 64 * j); s_ += (v[j].x * v[j].x + v[j].y * v[j].y) + (v[j].z * v[j].z + v[j].w * v[j].w); }
                GAS v2u* o8 = (GAS v2u*)(XN + (size_t)m * D) + lane;
#pragma unroll
                for (int j = 0; j < 4; ++j) { v2u w; w.x = cvt_pk_bf16(v[j].x, v[j].y); w.y = cvt_pk_bf16(v[j].z, v[j].w); o8[64 * j] = w; }
                const float rs_ = 1.f / sqrtf(wave_sum(s_) * (1.f / D) + RMS_EPS); if (lane == 0) rstd0[m] = rs_; } }
        else for (int m = gw; m < M; m += NGW) rms_row_to_bf16(x + (size_t)m * D, g_mix, XN + (size_t)m * D, lane);
        if (BOTH(0)) GRID_BAR(0); STAMP(1);
    }

#define STAGGER(S_, total_units) do { if (STAGGER_US > 0) { int nu_ = 0; pg8::Unit u_; while (S_.next(nu_, u_)) ++nu_; const int mx_ = ((total_units) + G - 1) / G; \
        if (nu_ < mx_) { const unsigned long long t0_ = __builtin_amdgcn_s_memrealtime(); while (__builtin_amdgcn_s_memrealtime() - t0_ < (unsigned long long)(STAGGER_US * 100)) __builtin_amdgcn_s_sleep(16); } } } while (0)
    if (IN(1)) {
        BUSY_T0(1);
        if (bx < G - HELP) {
            DenseOrder S{M / 256, NIN / 256, G - HELP, bx, D, (const char*)XN, (const char*)Win_t};
            EpiInProj E{Qb, Kb, Vb, CB, Ub, SA, SC, binp, cosT, sinT, rstd0};
            if (HELP == 0) STAGGER(S, (M / 256) * (NIN / 256));
            for (int i = tid; i < 512; i += 512) *(LAS f32x4*)(gffl + 4 * i) = i < 256 ? *(const f32x4*)(g_ffn + 4 * i) : *(const f32x4*)(g_mix + 4 * (i - 256));
            __syncthreads();
            DBG_SPAN_BEGIN(1);
            if (HELP == 0) slack_convert(CS, (M / 256) * (NIN / 256), G, bx, CVT_P0_ITEMS, SLACK_P1A_ITEMS, lds + RING_OFF + wave * 8704, wave, lane);
            DBG_SPAN_END(1);
            __syncthreads();
            pg8::gemm_phase<EpiInProj, DenseOrder, true, false>(lds + RING_OFF, D, S, E, (DBG_KLOOP_PH == 1 && bx == DBG_BLK) ? (unsigned*)(ctl + CW_TS + 16) : nullptr);
            if (HELP == 0 && SLACK_P1B_ITEMS > 0) {
                for (int i = tid; i < 512; i += 512) *(LAS f32x4*)(gffl + 4 * i) = i < 256 ? *(const f32x4*)(g_ffn + 4 * i) : *(const f32x4*)(g_mix + 4 * (i - 256));
                __syncthreads();
                DBG_SPAN_BEGIN(2);
                if (POOL_CVT && POOL_P1) cvt_run_pool(CS, (unsigned*)(ctl + CW_POOL + 32 * (bx & 7)), bx & 7, 8, SLACK_P1B_ITEMS, lds + RING_OFF + wave * 8704, lane, CVT_P0_ITEMS + SLACK_P1A_ITEMS);
                else slack_convert(CS, (M / 256) * (NIN / 256), G, bx, CVT_P0_ITEMS + SLACK_P1A_ITEMS, SLACK_P1B_ITEMS, lds + RING_OFF + wave * 8704, wave, lane, true);
                DBG_SPAN_END(2);
            }
        } else {
            cvt_run<1>(CS, (bx - (G - HELP)) * NWAVES + wave, HELP * NWAVES, CVT_REST_ITEMS, lds + RING_OFF + wave * 8704, lane);
        }
        BUSY_END(1);
        if (BOTH(1)) GRID_BAR(1); STAMP(2);
        BUSY_READ(1);
    }

    if (IN(2)) {
        const bool cinl = CONV_INLINE && G == 256 && BATCH * NKVH * (SEQ / 128) == 512;
        { constexpr int NU = BATCH * NKVH * (SEQ / 128); att::KVRegs R; int uu = vcu;
            LAS float* wcl = (LAS float*)(lds + RING_OFF + 104448);
            for (int i = tid; i < 768; i += 512) *(LAS f32x4*)(wcl + 4 * i) = *(const f32x4*)(w_conv + 4 * i);
            __syncthreads();
            att::ConvCtx CV; CV.Ub = Ub; CV.CB = CB; CV.w = wcl; CV.c0 = (tid & 127) * 8; CV.row = (cinl ? vcu : 0) * 64 + (tid >> 7) * 16; CV.on = cinl; CV.um2 = (v4u){0u, 0u, 0u, 0u}; CV.um1 = (v4u){0u, 0u, 0u, 0u};
            if (cinl && (CV.row & (SEQ - 1)) >= 2) { CV.um2 = *(const v4u*)(Ub + (size_t)(CV.row - 2) * 1024 + CV.c0); CV.um1 = *(const v4u*)(Ub + (size_t)(CV.row - 1) * 1024 + CV.c0); }
            if (KV_PREFETCH && uu < NU) att::attn_load(R, uu, Kb, Vb);
            while (uu < NU) { if (!KV_PREFETCH) att::attn_load(R, uu, Kb, Vb); att::attn_store(R, lds + RING_OFF); __syncthreads(); const int un = uu + G < NU ? uu + G : uu;
                att::attn_compute(lds + RING_OFF, uu, un, R, Qb, Kb, Vb, Qb, sinks, CV); uu += G; } }
        if (!cinl)
        for (int ch = vcu; ch < M / 64; ch += G) {
            const int c0 = (tid & 127) * 8, row0 = ch * 64 + (tid >> 7) * 16, pos0 = row0 & (SEQ - 1);
            float w0[8], w1[8], w2[8];
#pragma unroll
            for (int q = 0; q < 8; ++q) { w0[q] = w_conv[c0 + q]; w1[q] = w_conv[1024 + c0 + q]; w2[q] = w_conv[2048 + c0 + q]; }
            v4u um2 = {0u, 0u, 0u, 0u}, um1 = {0u, 0u, 0u, 0u};
            if (pos0 >= 2) { um2 = *(const v4u*)(Ub + (size_t)(row0 - 2) * 1024 + c0); um1 = *(const v4u*)(Ub + (size_t)(row0 - 1) * 1024 + c0); }
#pragma unroll 4
            for (int r = 0; r < 16; ++r) { const size_t off = (size_t)(row0 + r) * 1024 + c0;
                const v4u u0 = *(const v4u*)(Ub + off), cb = *(const v4u*)(CB + off); v4u o;
#define CONV2(F, qa) cvt_pk_bf16(bf_lo(cb.F) * (w0[qa] * bf_lo(um2.F) + w1[qa] * bf_lo(um1.F) + w2[qa] * bf_lo(u0.F)), bf_hi(cb.F) * (w0[qa + 1] * bf_hi(um2.F) + w1[qa + 1] * bf_hi(um1.F) + w2[qa + 1] * bf_hi(u0.F)))
                o.x = CONV2(x, 0); o.y = CONV2(y, 2); o.z = CONV2(z, 4); o.w = CONV2(w, 6);
#undef CONV2
                *(v4u*)(CB + off) = o; um2 = um1; um1 = u0; }
        }
        if (BOTH(2)) GRID_BAR(2); STAMP(3);
    }

    if (IN(3)) {
        MergeOrder S{M / 256, D / 256, G, bx, D, (const char*)Qb, (const char*)Wao_t, (const char*)CB, (const char*)Wco_t};
        EpiMerge E{SA, SC, MG};
        pg8::gemm_phase<EpiMerge, MergeOrder, true, false>(lds + RING_OFF, D, S, E, (DBG_KLOOP_PH == 3 && bx == DBG_BLK) ? (unsigned*)(ctl + CW_TS + 16) : nullptr);
        if (BOTH(3)) GRID_BAR(3); STAMP(4);
    }

    if (IN(4)) {
        DenseOrder S{M / 256, D / 256, G, bx, D, (const char*)MG, (const char*)Wout_t};
        EpiRes E{FUSE_RES ? XN : DLb};
        pg8::gemm_phase<EpiRes, DenseOrder, false, false>(lds + RING_OFF, D, S, E, (DBG_KLOOP_PH == 4 && bx == DBG_BLK) ? (unsigned*)(ctl + CW_TS + 16) : nullptr);
        if (BOTH(4)) GRID_BAR(4); STAMP(5);
    }

#if P5_MFMA
    if (IN(5)) {
        LAS float* GL = (LAS float*)(lds + RING_OFF);
#define P5_BL_LDS (FOLD_GMIX && FOLD_G && !FUSE_RES)
        LAS float* PL = (LAS float*)(lds + RING_OFF + (P5_BL_LDS ? 65536 : 4096));
        LAS float* PS = P5_BL_LDS ? (LAS float*)(lds + TOK_OFF + 8192) : (LAS float*)(lds + RING_OFF + 4096 + 65536);
        LAS unsigned char* BLs = lds + RING_OFF + wave * 8192 + lane * 16;
        LAS int* lcnt = (LAS int*)(lds + TOK_OFF); LAS int* lbase = lcnt + 32; LAS unsigned* ce = (LAS unsigned*)(lds + TOK_OFF + 256); LAS int* cr = (LAS int*)(lds + TOK_OFF + 256 + 1024); LAS float* cw = (LAS float*)(lds + TOK_OFF + 256 + 2048);
        LAS float* crs = (LAS float*)(lds + TOK_OFF + 256 + 3072);
        if (!FUSE_RES) { for (int i = tid; i < 256; i += 512) *(LAS f32x4*)(GL + 4 * i) = *(const f32x4*)(g_ffn + 4 * i);
            __syncthreads(); }
        const int r32 = lane & 31, kh = lane >> 5, kb = 128 * wave;
        const float brt = b_router[r32];
        bf16x8 Bh[8], Bl[8];
        if (FUSE_RES) { const v4u* rf = (const v4u*)(ws + WS_RFRAG) + wave * 512 + lane;
#pragma unroll
            for (int f = 0; f < 8; ++f) { Bh[f] = __builtin_bit_cast(bf16x8, rf[f * 64]); Bl[f] = __builtin_bit_cast(bf16x8, rf[4096 + f * 64]); } }
        else
#pragma unroll
        for (int f = 0; f < 8; ++f) { const int k0 = kb + 32 * (f >> 1) + 16 * kh + 8 * (f & 1);
            const f32x4 g0 = *(const LAS f32x4*)(GL + k0), g1 = *(const LAS f32x4*)(GL + k0 + 4);
            float wv[8];
#pragma unroll
            for (int j = 0; j < 8; ++j) wv[j] = w_router[(size_t)(k0 + j) * 32 + r32] * (j < 4 ? g0[j] : g1[j - 4]);
            v4u hw, lw;
#define SPLIT2(dsth, dstl, a_, b_) do { const unsigned h_ = cvt_pk_bf16(a_, b_); dsth = h_; dstl = cvt_pk_bf16((a_) - bf_lo(h_), (b_) - bf_hi(h_)); } while (0)
            SPLIT2(hw.x, lw.x, wv[0], wv[1]); SPLIT2(hw.y, lw.y, wv[2], wv[3]); SPLIT2(hw.z, lw.z, wv[4], wv[5]); SPLIT2(hw.w, lw.w, wv[6], wv[7]);
            Bh[f] = __builtin_bit_cast(bf16x8, hw); Bl[f] = __builtin_bit_cast(bf16x8, lw); }
        if (P5_BL_LDS) { __syncthreads();
#pragma unroll
            for (int f = 0; f < 8; ++f) *(LAS bf16x8*)(BLs + f * 1024) = Bl[f]; }
#define P5_BLF(f_) (P5_BL_LDS ? *(const LAS bf16x8*)(BLs + (f_) * 1024) : Bl[f_])
        for (int ch = vcu; ch < M / 64; ch += G) {
            if (tid < 32) lcnt[tid] = 0;
            f32x16 acc[2]; acc[0] = f32x16{}; acc[1] = f32x16{}; float ss[2] = {0.f, 0.f};
            if (FUSE_RES) {
                v4u xr[2][4][2];
#pragma unroll
                for (int mt = 0; mt < 2; ++mt)
#pragma unroll
                    for (int S = 0; S < 4; ++S)
#pragma unroll
                        for (int q = 0; q < 2; ++q) xr[mt][S][q] = *(const v4u*)(XN + (size_t)(ch * 64 + 32 * mt + r32) * D + kb + 16 * kh + 32 * S + 8 * q);
#pragma unroll
                for (int mt = 0; mt < 2; ++mt)
#pragma unroll
                    for (int S = 0; S < 4; ++S)
#pragma unroll
                        for (int q = 0; q < 2; ++q) { const v4u r = xr[mt][S][q]; const bf16x8 Ah = __builtin_bit_cast(bf16x8, r);
                            acc[mt] = __builtin_amdgcn_mfma_f32_32x32x16_bf16(Ah, Bh[2 * S + q], acc[mt], 0, 0, 0);
                            acc[mt] = __builtin_amdgcn_mfma_f32_32x32x16_bf16(Ah, P5_BLF(2 * S + q), acc[mt], 0, 0, 0);
                            float s_ = ss[mt];
                            s_ = __builtin_amdgcn_fdot2_f32_bf16(__builtin_bit_cast(bf16x2, r.x), __builtin_bit_cast(bf16x2, r.x), s_, false); s_ = __builtin_amdgcn_fdot2_f32_bf16(__builtin_bit_cast(bf16x2, r.y), __builtin_bit_cast(bf16x2, r.y), s_, false);
                            s_ = __builtin_amdgcn_fdot2_f32_bf16(__builtin_bit_cast(bf16x2, r.z), __builtin_bit_cast(bf16x2, r.z), s_, false); s_ = __builtin_amdgcn_fdot2_f32_bf16(__builtin_bit_cast(bf16x2, r.w), __builtin_bit_cast(bf16x2, r.w), s_, false);
                            ss[mt] = s_; }
            } else
#define P5M_LOADG(XQ, DQ, mt_, sp_) do { const size_t ro_ = (size_t)(ch * 64 + 32 * (mt_) + r32) * D + kb + 16 * kh + 64 * (sp_); \
                _Pragma("unroll") for (int S_ = 0; S_ < 2; ++S_) { \
                    if (FOLD_GMIX) { XQ##r[S_][0] = *(const v4u*)(XN + ro_ + 32 * S_); XQ##r[S_][1] = *(const v4u*)(XN + ro_ + 32 * S_ + 8); }     \
                    else { _Pragma("unroll") for (int q = 0; q < 4; ++q) XQ[S_][q] = *(const f32x4*)(x + ro_ + 32 * S_ + 4 * q); } \
                    DQ[S_][0] = *(const v4u*)(DLb + ro_ + 32 * S_); DQ[S_][1] = *(const v4u*)(DLb + ro_ + 32 * S_ + 8); } } while (0)
#define P5M_PROC(XQ, DQ, mt_, sp_) do { const size_t ro_ = (size_t)(ch * 64 + 32 * (mt_) + r32) * D + kb + 16 * kh + 64 * (sp_); \
                _Pragma("unroll") for (int S_ = 0; S_ < 2; ++S_) { const int S = 2 * (sp_) + S_; float x1[16]; \
                    if (FOLD_GMIX) { _Pragma("unroll") for (int h = 0; h < 2; ++h) { const v4u b_ = XQ##r[S_][h]; \
                            x1[8 * h + 0] = bf_lo(b_.x); x1[8 * h + 1] = bf_hi(b_.x); x1[8 * h + 2] = bf_lo(b_.y); x1[8 * h + 3] = bf_hi(b_.y); x1[8 * h + 4] = bf_lo(b_.z); x1[8 * h + 5] = bf_hi(b_.z); x1[8 * h + 6] = bf_lo(b_.w); x1[8 * h + 7] = bf_hi(b_.w); } } \
                    else { _Pragma("unroll") for (int q = 0; q < 4; ++q) { x1[4 * q] = XQ[S_][q].x; x1[4 * q + 1] = XQ[S_][q].y; x1[4 * q + 2] = XQ[S_][q].z; x1[4 * q + 3] = XQ[S_][q].w; } } \
                    _Pragma("unroll") for (int h = 0; h < 2; ++h) { const v4u d = DQ[S_][h]; \
                        x1[8 * h + 0] += bf_lo(d.x); x1[8 * h + 1] += bf_hi(d.x); x1[8 * h + 2] += bf_lo(d.y); x1[8 * h + 3] += bf_hi(d.y); \
                        x1[8 * h + 4] += bf_lo(d.z); x1[8 * h + 5] += bf_hi(d.z); x1[8 * h + 6] += bf_lo(d.w); x1[8 * h + 7] += bf_hi(d.w); } \
                    float s_ = 0.f; \
                    _Pragma("unroll") for (int j = 0; j < 16; ++j) s_ += x1[j] * x1[j]; \
                    ss[mt_] += s_; \
                    const int kk = kb + 32 * S + 16 * kh; v4u o0, o1; \
                    { const f32x4 g0 = *(const LAS f32x4*)(GL + kk), g1 = *(const LAS f32x4*)(GL + kk + 4), g2 = *(const LAS f32x4*)(GL + kk + 8), g3 = *(const LAS f32x4*)(GL + kk + 12); \
                      if (FOLD_G) { o0.x = cvt_pk_bf16(x1[0], x1[1]); o0.y = cvt_pk_bf16(x1[2], x1[3]); o0.z = cvt_pk_bf16(x1[4], x1[5]); o0.w = cvt_pk_bf16(x1[6], x1[7]); \
                                    o1.x = cvt_pk_bf16(x1[8], x1[9]); o1.y = cvt_pk_bf16(x1[10], x1[11]); o1.z = cvt_pk_bf16(x1[12], x1[13]); o1.w = cvt_pk_bf16(x1[14], x1[15]); } else { \
                      o0.x = cvt_pk_bf16(x1[0] * g0.x, x1[1] * g0.y); o0.y = cvt_pk_bf16(x1[2] * g0.z, x1[3] * g0.w); o0.z = cvt_pk_bf16(x1[4] * g1.x, x1[5] * g1.y); o0.w = cvt_pk_bf16(x1[6] * g1.z, x1[7] * g1.w); \
                      o1.x = cvt_pk_bf16(x1[8] * g2.x, x1[9] * g2.y); o1.y = cvt_pk_bf16(x1[10] * g2.z, x1[11] * g2.w); o1.z = cvt_pk_bf16(x1[12] * g3.x, x1[13] * g3.y); o1.w = cvt_pk_bf16(x1[14] * g3.z, x1[15] * g3.w); } } \
                    *(v4u*)(XN + ro_ + 32 * S_) = o0; *(v4u*)(XN + ro_ + 32 * S_ + 8) = o1; \
                    _Pragma("unroll") for (int q = 0; q < 2; ++q) { v4u hw, lw; \
                        SPLIT2(hw.x, lw.x, x1[8 * q + 0], x1[8 * q + 1]); SPLIT2(hw.y, lw.y, x1[8 * q + 2], x1[8 * q + 3]); SPLIT2(hw.z, lw.z, x1[8 * q + 4], x1[8 * q + 5]); SPLIT2(hw.w, lw.w, x1[8 * q + 6], x1[8 * q + 7]); \
                        const bf16x8 Ah = __builtin_bit_cast(bf16x8, hw), Al = __builtin_bit_cast(bf16x8, lw); \
                        acc[mt_] = __builtin_amdgcn_mfma_f32_32x32x16_bf16(Ah, Bh[2 * S + q], acc[mt_], 0, 0, 0); \
                        acc[mt_] = __builtin_amdgcn_mfma_f32_32x32x16_bf16(Al, Bh[2 * S + q], acc[mt_], 0, 0, 0); \
                        acc[mt_] = __builtin_amdgcn_mfma_f32_32x32x16_bf16(Ah, P5_BLF(2 * S + q), acc[mt_], 0, 0, 0); } } } while (0)
            { f32x4 xa_[2][4], xb_[2][4]; v4u xa_r[2][2], xb_r[2][2]; v4u da_[2][2], db_[2][2];
#define SB_ __builtin_amdgcn_sched_barrier(0)
              P5M_LOADG(xa_, da_, 0, 0); P5M_LOADG(xb_, db_, 0, 1); SB_;
              P5M_PROC(xa_, da_, 0, 0); SB_; P5M_LOADG(xa_, da_, 1, 0); SB_;
              P5M_PROC(xb_, db_, 0, 1); SB_; P5M_LOADG(xb_, db_, 1, 1); SB_;
              P5M_PROC(xa_, da_, 1, 0); SB_; P5M_PROC(xb_, db_, 1, 1); }
#undef SB_
#undef P5_BLF
#undef P5M_LOADG
#undef P5M_PROC
#undef SPLIT2
#pragma unroll
            for (int mt = 0; mt < 2; ++mt) { const float st = ss[mt] + __shfl_xor(ss[mt], 32); if (kh == 0) PS[wave * 64 + 32 * mt + r32] = st;
#pragma unroll
                for (int r = 0; r < 16; ++r) PL[(wave * 64 + 32 * mt + ((r & 3) + 8 * (r >> 2) + 4 * kh)) * 32 + r32] = acc[mt][r]; }
            __syncthreads();
#define P5_ROWPOST(lgin, tl_) do { float lg = lgin; int te[4]; float tlg[4]; \
                _Pragma("unroll") for (int k = 0; k < 4; ++k) { const float mx = half_max_dpp(lg); const unsigned long long bm = __ballot(lg == mx); const int sel = __builtin_ctzll(bm); te[k] = sel; tlg[k] = mx; if ((lane & 31) == sel) lg = -INFINITY; } \
                const float e1 = __expf(tlg[1] - tlg[0]), e2 = __expf(tlg[2] - tlg[0]), e3 = __expf(tlg[3] - tlg[0]), inv = 1.0f / (1.0f + e1 + e2 + e3); \
                if (lane < 4) { const int ek = lane == 0 ? te[0] : lane == 1 ? te[1] : lane == 2 ? te[2] : te[3]; const float wk = (lane == 0 ? 1.0f : lane == 1 ? e1 : lane == 2 ? e2 : e3) * inv; \
                    const int r = atomicAdd((int*)(lcnt + ek), 1); ce[(tl_) * 4 + lane] = (unsigned)ek; cr[(tl_) * 4 + lane] = r; cw[(tl_) * 4 + lane] = wk; } } while (0)
#pragma unroll 2
            for (int rr = 0; rr < 8; ++rr) { const int tl = wave * 8 + rr; float lgs = 0.f, sq = 0.f;
#pragma unroll
                for (int w2 = 0; w2 < 8; ++w2) { lgs += PL[(w2 * 64 + tl) * 32 + r32]; sq += PS[w2 * 64 + tl]; }
                const float rstd = FUSE_RES ? __builtin_amdgcn_rsqf(sq * (1.f / D) + RMS_EPS) : 1.f / sqrtf(sq * (1.f / D) + RMS_EPS);
                if (lane == 0) crs[tl] = rstd;
                P5_ROWPOST(lgs * rstd + brt, tl); }
#undef P5_ROWPOST
            __syncthreads();
            if (tid < 32) lbase[tid] = (int)__hip_atomic_fetch_add(ctl + CW_CURSOR + 64 * tid, (unsigned)lcnt[tid], RLX_AGENT);
            __syncthreads();
            if (tid < 256) { const int t = ch * 64 + (tid >> 2); const unsigned e = ce[tid]; const int rel = lbase[e] + cr[tid];
                tokrel[e * SLOTCAP + rel] = t; rstdrel[e * SLOTCAP + rel] = crs[tid >> 2]; route[t * 4 + (tid & 3)] = e | ((unsigned)rel << 8); routew[t * 4 + (tid & 3)] = cw[tid]; }
            __syncthreads();
        }
        if (BOTH(5)) GRID_BAR(5); STAMP(6);
    }
#else
    if (IN(5)) {
        LAS float* wT = (LAS float*)(lds + RING_OFF);
        { f32x4 wv[16];
#pragma unroll
          for (int k = 0; k < 16; ++k) { const int idx = tid + 512 * k, c = idx & 1023, e4 = idx >> 10; wv[k] = *(const f32x4*)(w_router + (size_t)c * 32 + e4 * 4); }
#pragma unroll
          for (int k = 0; k < 16; ++k) { const int idx = tid + 512 * k, c = idx & 1023, e4 = idx >> 10;
            wT[(e4 * 4 + 0) * 1024 + c] = wv[k].x; wT[(e4 * 4 + 1) * 1024 + c] = wv[k].y; wT[(e4 * 4 + 2) * 1024 + c] = wv[k].z; wT[(e4 * 4 + 3) * 1024 + c] = wv[k].w; } }
        LAS int* lcnt = (LAS int*)(lds + TOK_OFF); LAS int* lbase = lcnt + 32; LAS unsigned* ce = (LAS unsigned*)(lds + TOK_OFF + 256); LAS int* cr = (LAS int*)(lds + TOK_OFF + 256 + 1024); LAS float* cw = (LAS float*)(lds + TOK_OFF + 256 + 2048);
        const int psrc = 4 * ((lane & 48) | ((lane & 1) << 3) | ((lane & 2) << 1) | ((lane & 4) >> 1) | ((lane & 8) >> 3));
        const float brt = b_router[lane & 31];
        f32x4 gf[4];
#pragma unroll
        for (int j = 0; j < 4; ++j) gf[j] = *(const f32x4*)(g_ffn + 4 * lane + 256 * j);
        for (int ch = vcu; ch < M / 64; ch += G) {
            if (tid < 32) lcnt[tid] = 0;
            __syncthreads();
#define P5_LOADROW(dst, dd, t_) _Pragma("unroll") for (int j = 0; j < 4; ++j) { dst[j] = *(const f32x4*)(x + (size_t)(t_) * D + 4 * lane + 256 * j); dd[j] = *(const v2u*)(DLb + (size_t)(t_) * D + 4 * lane + 256 * j); }
#define P5_ADDD(dst, dd) _Pragma("unroll") for (int j = 0; j < 4; ++j) { dst[j].x += bf_lo(dd[j].x); dst[j].y += bf_hi(dd[j].x); dst[j].z += bf_lo(dd[j].y); dst[j].w += bf_hi(dd[j].y); }
#define P5_BFLY(v, NV, MK) _Pragma("unroll") for (int i = 0; i < NV; ++i) { const bool up = (lane & MK) != 0; const float send = up ? v[i] : v[i + NV], keep = up ? v[i + NV] : v[i]; v[i] = keep + __shfl_xor(send, MK); }
#define P5_ROWPOST(lgin, tl_) do { float lg = __builtin_bit_cast(float, __builtin_amdgcn_ds_bpermute(psrc, __builtin_bit_cast(int, lgin))) + brt; int te[4]; float tlg[4];     \
                _Pragma("unroll") for (int k = 0; k < 4; ++k) { const float mx = half_max_dpp(lg); const unsigned long long bm = __ballot(lg == mx); const int sel = __builtin_ctzll(bm); te[k] = sel; tlg[k] = mx; if ((lane & 31) == sel) lg = -INFINITY; } \
                const float e1 = __expf(tlg[1] - tlg[0]), e2 = __expf(tlg[2] - tlg[0]), e3 = __expf(tlg[3] - tlg[0]), inv = 1.0f / (1.0f + e1 + e2 + e3); \
                if (lane < 4) { const int ek = lane == 0 ? te[0] : lane == 1 ? te[1] : lane == 2 ? te[2] : te[3]; const float wk = (lane == 0 ? 1.0f : lane == 1 ? e1 : lane == 2 ? e2 : e3) * inv; \
                    const int r = atomicAdd((int*)(lcnt + ek), 1); ce[(tl_) * 4 + lane] = (unsigned)ek; cr[(tl_) * 4 + lane] = r; cw[(tl_) * 4 + lane] = wk; } } while (0)
            f32x4 xa[4], xb[4]; v2u da[4], db[4];
            P5_LOADROW(xa, da, ch * 64 + wave * 8); P5_LOADROW(xb, db, ch * 64 + wave * 8 + 1);
#pragma unroll 1
            for (int pp = 0; pp < 4; ++pp) {
                const int tl = wave * 8 + 2 * pp, t = ch * 64 + tl, tn = pp < 3 ? t + 2 : t;
                f32x4 na[4], nb[4]; v2u nda[4], ndb[4];
                P5_LOADROW(na, nda, tn); P5_LOADROW(nb, ndb, tn + 1);
                P5_ADDD(xa, da); P5_ADDD(xb, db);
                float sa = 0.f, sb = 0.f;
#pragma unroll
                for (int j = 0; j < 4; ++j) { sa += (xa[j].x * xa[j].x + xa[j].y * xa[j].y) + (xa[j].z * xa[j].z + xa[j].w * xa[j].w); sb += (xb[j].x * xb[j].x + xb[j].y * xb[j].y) + (xb[j].z * xb[j].z + xb[j].w * xb[j].w); }
                const float rstda = 1.f / sqrtf(wave_sum_dpp(sa) * (1.f / D) + RMS_EPS), rstdb = 1.f / sqrtf(wave_sum_dpp(sb) * (1.f / D) + RMS_EPS);
#pragma unroll
                for (int j = 0; j < 4; ++j) { xa[j] = xa[j] * rstda * gf[j]; xb[j] = xb[j] * rstdb * gf[j];
                    v2u w; w.x = cvt_pk_bf16(xa[j].x, xa[j].y); w.y = cvt_pk_bf16(xa[j].z, xa[j].w); *(v2u*)(XN + (size_t)t * D + 4 * lane + 256 * j) = w;
                    v2u w2; w2.x = cvt_pk_bf16(xb[j].x, xb[j].y); w2.y = cvt_pk_bf16(xb[j].z, xb[j].w); *(v2u*)(XN + (size_t)(t + 1) * D + 4 * lane + 256 * j) = w2; }
                f32x2 x2[4][4];
#pragma unroll
                for (int j = 0; j < 4; ++j) { x2[j][0] = (f32x2){xa[j].x, xb[j].x}; x2[j][1] = (f32x2){xa[j].y, xb[j].y}; x2[j][2] = (f32x2){xa[j].z, xb[j].z}; x2[j][3] = (f32x2){xa[j].w, xb[j].w}; }
                float lga, lgb;
                { float h0a, h0b, h1a, h1b;
#define P5_HALF(E0, ra, rb) do { float va[16], vb[16]; \
                    _Pragma("unroll") for (int e = 0; e < 16; ++e) { f32x2 a2 = {0.f, 0.f}, c2 = {0.f, 0.f};     \
                        _Pragma("unroll") for (int j = 0; j < 4; ++j) { const f32x4 w4 = *(const LAS f32x4*)(wT + ((E0) + e) * 1024 + 4 * lane + 256 * j); \
                            a2 += x2[j][0] * (f32x2){w4.x, w4.x}; c2 += x2[j][1] * (f32x2){w4.y, w4.y}; a2 += x2[j][2] * (f32x2){w4.z, w4.z}; c2 += x2[j][3] * (f32x2){w4.w, w4.w}; } \
                        a2 += c2; va[e] = a2.x; vb[e] = a2.y; } \
                    P5_BFLY(va, 8, 1) P5_BFLY(va, 4, 2) P5_BFLY(va, 2, 4) P5_BFLY(va, 1, 8) P5_BFLY(vb, 8, 1) P5_BFLY(vb, 4, 2) P5_BFLY(vb, 2, 4) P5_BFLY(vb, 1, 8) \
                    float ta = va[0] + __shfl_xor(va[0], 16), tb = vb[0] + __shfl_xor(vb[0], 16); ra = ta + __shfl_xor(ta, 32); rb = tb + __shfl_xor(tb, 32); } while (0)
                  P5_HALF(0, h0a, h0b); __builtin_amdgcn_sched_barrier(0); P5_HALF(16, h1a, h1b); __builtin_amdgcn_sched_barrier(0);
#undef P5_HALF
                  lga = (lane & 16) ? h1a : h0a; lgb = (lane & 16) ? h1b : h0b; }
                P5_ROWPOST(lga, tl); __builtin_amdgcn_sched_barrier(0); P5_ROWPOST(lgb, tl + 1);
#pragma unroll
                for (int j = 0; j < 4; ++j) { xa[j] = na[j]; xb[j] = nb[j]; da[j] = nda[j]; db[j] = ndb[j]; }
            }
#undef P5_LOADROW
#undef P5_ADDD
#undef P5_BFLY
#undef P5_ROWPOST
            __syncthreads();
            if (tid < 32) lbase[tid] = (int)__hip_atomic_fetch_add(ctl + CW_CURSOR + 64 * tid, (unsigned)lcnt[tid], RLX_AGENT);
            __syncthreads();
            if (tid < 256) { const int t = ch * 64 + (tid >> 2); const unsigned e = ce[tid]; const int rel = lbase[e] + cr[tid];
                tokrel[e * SLOTCAP + rel] = t; route[t * 4 + (tid & 3)] = e | ((unsigned)rel << 8); routew[t * 4 + (tid & 3)] = cw[tid]; }
            __syncthreads();
        }
        if (BOTH(5)) GRID_BAR(5); STAMP(6);
    }
#endif


    BUSY_T0(6);
    LAS int* t_cnt = (LAS int*)(lds + TAB_CNT); LAS int* t_start = (LAS int*)(lds + TAB_TSTART); LAS int* t_tile = (LAS int*)(lds + TAB_TILEE);
    if (IN(6) || IN(7) || IN(8)) {
        if (tid < 32) t_cnt[tid] = (int)__hip_atomic_load(ctl + CW_CURSOR + 64 * tid, RLX_AGENT);
        __syncthreads();
        if (tid == 0) { int s = 0; for (int e = 0; e < 32; ++e) { t_start[e] = s; s += (t_cnt[e] + 255) >> 8; } t_start[32] = s; }
        __syncthreads();
        for (int i = tid; i < 320; i += 512) { int e = 0; for (int k = 1; k < 32; ++k) if (i >= t_start[k]) e = k; t_tile[i] = e; }
        __syncthreads();
    }
    const int MT = (IN(6) || IN(7) || IN(8)) ? t_start[32] : 0;

    if (IN(6)) {
        LAS unsigned* tokt = (LAS unsigned*)(lds + TOK_OFF);
        MoeOrder S{MT, G, bx, (const char*)XN, (const char*)ACT, (const char*)Wgu_t, (const char*)Wd_t, t_tile, tokt, (unsigned*)(ctl + CW_MT), (unsigned*)(ctl + CW_TMO), MOE_MERGED ? 0 : 1, 0};
        for (int i0 = 0; i0 < MAXU; i0 += 2) { const int i = i0 + (tid >> 8), r = tid & 255; pg8::Unit u;
            if (i < MAXU && S.next(i, u) && u.aux == 2) { const int e = u.e, rel = (u.pm - t_start[e]) * 256 + r; const int tok = rel < t_cnt[e] ? tokrel[e * SLOTCAP + rel] : 0; tokt[i * 256 + r] = (unsigned)tok * 2048u; } }
        __syncthreads();
        EpiMoe E{EpiGU{ACT, bgu, rstdrel, t_start}, EpiDown{Yb, b_down}};
        if (!MOE_MERGED) STAGGER(S, MT * 8);
        for (int i = tid; i < 512; i += 512) *(LAS f32x4*)(gffl + 4 * i) = i < 256 ? *(const f32x4*)(g_ffn + 4 * i) : *(const f32x4*)(g_mix + 4 * (i - 256));
        __syncthreads();
        DBG_SPAN_BEGIN(6);
        slack_convert(CS, MT * 8, G, bx, CVT_REST_ITEMS - SLACK_P6_ITEMS, POOL_CVT ? SLACK_P6A_ITEMS : SLACK_P6_ITEMS, lds + RING_OFF + wave * 8704, wave, lane);
        DBG_SPAN_END(6);
        __syncthreads();
        if (MOE_MERGED) pg8::gemm_phase<EpiMoe, MoeOrder, true, true>(lds + RING_OFF, D, S, E, (DBG_KLOOP_PH == 6 && bx == DBG_BLK) ? (unsigned*)(ctl + CW_TS + 16) : nullptr);
        else { EpiGU Eg{ACT, bgu, rstdrel, t_start}; pg8::gemm_phase<EpiGU, MoeOrder, true, true, false, PF_P6 != 0>(lds + RING_OFF, D, S, Eg, (DBG_KLOOP_PH == 6 && bx == DBG_BLK) ? (unsigned*)(ctl + CW_TS + 16) : nullptr); }
        if (POOL_CVT && !MOE_MERGED && SLACK_P6_ITEMS - SLACK_P6A_ITEMS > 0)
            cvt_run_pool(CS, (unsigned*)(ctl + CW_POOL + 32 * (8 + (bx & 7))), bx & 7, 8, SLACK_P6_ITEMS - SLACK_P6A_ITEMS, lds + RING_OFF + wave * 8704, lane, CVT_REST_ITEMS - SLACK_P6_ITEMS + SLACK_P6A_ITEMS);
        BUSY_END(6);
        if (MOE_MERGED ? IN(8) : BOTH(6)) GRID_BAR(6); STAMP(7);
        BUSY_READ(6);
    }
    if (IN(7)) {
        BUSY_T0(7);
        if (!MOE_MERGED) {
            const int U7 = MT * 4, full7 = (U7 / G) * G, ntail = U7 - full7; const bool split = HALF_TAIL && ntail > 0 && 2 * ntail <= G;
            MoeOrder S{MT, G, bx, (const char*)XN, (const char*)ACT, (const char*)Wgu_t, (const char*)Wd_t, t_tile, (const LAS unsigned*)(lds + TOK_OFF), (unsigned*)(ctl + CW_MT), (unsigned*)(ctl + CW_TMO), 2, split ? full7 : U7};
            EpiMoe E{EpiGU{ACT, bgu, rstdrel, t_start}, EpiDown{Yb, b_down}};
            STAGGER(S, MT * 4);
            EpiDownX Ed{EpiDown{Yb, b_down}};
            pg8::gemm_phase<EpiDownX, MoeOrder, true, false, false, PF_P7 != 0>(lds + RING_OFF, D, S, Ed, (DBG_KLOOP_PH == 7 && bx == DBG_BLK) ? (unsigned*)(ctl + CW_TS + 16) : nullptr);
            if (split && bx < 2 * ntail) { TailOrder T{MT, full7, bx, (const char*)ACT, (const char*)Wd_t, t_tile};
                pg8::gemm_phase<EpiDownX, TailOrder, false, false, true>(lds + RING_OFF, D, T, Ed); }
            BUSY_END(7);
            if (BOTH(7)) GRID_BAR(7);
            BUSY_READ(7);
        }
        STAMP(8);
    }

    if (IN(8)) {
        f32x4 gf[4];
        float dbg_scale = 1.0f;
        if (DBG_RVR_PH >= 0) { const unsigned t0 = __hip_atomic_load(ctl + CW_TS + (DBG_RVR_PH >= 0 ? DBG_RVR_PH : 0), RLX_AGENT), t1 = __hip_atomic_load(ctl + CW_TS + (DBG_RVR_PH >= 0 ? DBG_RVR_PH : 0) + 1, RLX_AGENT);
            const float fr_ = fminf((float)(t1 - t0) * (0.01f / DBG_RVR_US), 1.0f); dbg_scale = 1.0f + sqrtf(0.0035f * fr_); }
#pragma unroll
        for (int j = 0; j < 4; ++j) gf[j] = *(const f32x4*)(g_final + 4 * lane + 256 * j);
        for (int t = gw; t < M; t += NGW) {
            f32x4 a[4];
#pragma unroll
            for (int j = 0; j < 4; ++j) {
                if (FOLD_G) { const v2u xv = *(const v2u*)(XN + (size_t)t * D + 4 * lane + 256 * j); a[j] = (f32x4){bf_lo(xv.x), bf_hi(xv.x), bf_lo(xv.y), bf_hi(xv.y)}; }
                else { const f32x4 xv = *(const f32x4*)(x + (size_t)t * D + 4 * lane + 256 * j); const v2u dv = *(const v2u*)(DLb + (size_t)t * D + 4 * lane + 256 * j);
                    a[j] = (f32x4){xv.x + bf_lo(dv.x), xv.y + bf_hi(dv.x), xv.z + bf_lo(dv.y), xv.w + bf_hi(dv.y)}; } }
#pragma unroll
            for (int k = 0; k < 4; ++k) { const unsigned rt = route[t * 4 + k]; const float w = routew[t * 4 + k]; const int e = rt & 255u, rel = rt >> 8;
                const bf16* yr = Yb + ((size_t)t_start[e] * 256 + rel) * 1024 + 4 * lane;
#pragma unroll
                for (int j = 0; j < 4; ++j) { const v2u y = *(const v2u*)(yr + 256 * j); a[j].x += w * bf_lo(y.x); a[j].y += w * bf_hi(y.x); a[j].z += w * bf_lo(y.y); a[j].w += w * bf_hi(y.y); } }
            float s = 0.f;
#pragma unroll
            for (int j = 0; j < 4; ++j) s += (a[j].x * a[j].x + a[j].y * a[j].y) + (a[j].z * a[j].z + a[j].w * a[j].w);
            const float rstd = 1.f / sqrtf(wave_sum(s) * (1.f / D) + RMS_EPS);
#pragma unroll
            for (int j = 0; j < 4; ++j) *(f32x4*)(out + (size_t)t * D + 4 * lane + 256 * j) = a[j] * (rstd * dbg_scale) * gf[j];
        }
        STAMP(9);
        if (DBG_TIME_PH >= 0 && bx == 0 && tid == 0) { const unsigned t0 = __hip_atomic_load(ctl + CW_TS + DBG_TIME_PH, RLX_AGENT), t1 = __hip_atomic_load(ctl + CW_TS + DBG_TIME_PH + 1, RLX_AGENT);
            const unsigned span = 4u * (t1 - t0); const unsigned ts = (unsigned)__builtin_amdgcn_s_memrealtime(); while ((unsigned)__builtin_amdgcn_s_memrealtime() - ts < span) __builtin_amdgcn_s_sleep(8); }
    }
#undef IN
#undef BOTH
#undef GRID_BAR
}

extern "C" void kernel_launch(void* const* d_in, const int* in_sizes, int n_in, void* d_out, int out_size, void* d_ws, size_t ws_size, hipStream_t stream) {
    static int grid = 0;
    if (grid == 0) {
        if (n_in != 19 || in_sizes[0] != M * D || out_size != M * D || ws_size < WS_END) { fprintf(stderr, "kernel_launch: unexpected shapes (n_in %d, in0 %d, out %d, ws %zu)\n", n_in, n_in > 0 ? in_sizes[0] : -1, out_size, ws_size); grid = -1; return; }
        int dev = 0, cus = 0, per_cu = 0;
        if (hipGetDevice(&dev) != hipSuccess || hipDeviceGetAttribute(&cus, hipDeviceAttributeMultiprocessorCount, dev) != hipSuccess) { grid = -1; return; }
        if (hipFuncSetAttribute((const void*)fwd_kernel, hipFuncAttributeMaxDynamicSharedMemorySize, LDS_BYTES) != hipSuccess) { fprintf(stderr, "kernel_launch: hipFuncSetAttribute failed\n"); grid = -1; return; }
        if (hipOccupancyMaxActiveBlocksPerMultiprocessor(&per_cu, (const void*)fwd_kernel, NWAVES * 64, LDS_BYTES) != hipSuccess || per_cu < 1)
            fprintf(stderr, "kernel_launch: note: occupancy query reports %d workgroups per CU\n", per_cu);
        (void)hipGetLastError();
        grid = cus;
    }
    if (grid < 0) return;
    if (hipMemsetAsync((char*)d_ws + WS_CTL, 0, CTL_ZERO_BYTES, stream) != hipSuccess) { fprintf(stderr, "kernel_launch: hipMemsetAsync failed\n"); return; }
    Args a{};
    for (int i = 0; i < 19; ++i) a.in[i] = (const float*)d_in[i];
    a.out = (float*)d_out; a.ws = (unsigned char*)d_ws;
    for (int li = 0; li < N_LAUNCHES; ++li) {
        a.ph_lo = (N_LAUNCHES == PER_PHASE) ? li : 0; a.ph_hi = (N_LAUNCHES == PER_PHASE) ? li + 1 : PER_PHASE; a.li = li;
        hipLaunchKernelGGL(fwd_kernel, dim3(grid), dim3(NWAVES * 64), LDS_BYTES, stream, a);
        const hipError_t le = hipPeekAtLastError();
        if (le != hipSuccess) { fprintf(stderr, "kernel_launch: launch %d failed: %s\n", li, hipGetErrorName(le)); break; }
    }
}
```
